# Optimizing an MI355X kernel written in HIP

```python
import math
import jax
import jax.numpy as jnp
from jax import lax
import numpy as np

D_MODEL = 1024
BATCH = 16
SEQ = 4096
DEPTH = 4

GRID_W = 64
CTX_LEN = 256

LRU_WIDTH = 256
LRU_BLOCKS = 4
LRU_BLOCK = LRU_WIDTH // LRU_BLOCKS
CONV_W = 4
LRU_C = 8.0
DA_HEADS = 6
DA_QK = 32
DA_V = 2 * DA_QK
DA_WIDTH = DA_HEADS * DA_V
MLA_HEADS = 6
MLA_NOPE = 64
MLA_ROPE = 32
MLA_V = 64
MLA_WIDTH = MLA_HEADS * MLA_V
Q_RANK = 256
KV_RANK = 128
MLA_SCALE = (MLA_NOPE + MLA_ROPE) ** -0.5

D_MIX = LRU_WIDTH + DA_WIDTH + MLA_WIDTH
IN_SPLITS = (LRU_WIDTH, LRU_WIDTH, DA_HEADS * 2 * DA_QK, DA_HEADS * 2 * DA_QK, DA_WIDTH, Q_RANK, KV_RANK, MLA_ROPE)
D_IN = sum(IN_SPLITS)

N_EXPERTS = 16
N_GROUPS = 4
EXPERTS_PER_GROUP = N_EXPERTS // N_GROUPS
TOP_K = 2
D_EXPERT = 256

ROPE_THETA = 10000.0
Q_BLOCK = 128
LN_EPS = 1e-5
RMS_EPS = 1e-6
DEEPNORM_ALPHA = (2 * DEPTH) ** 0.25
DEEPNORM_BETA = (8 * DEPTH) ** -0.25

kernel_name = "hybrid_lru_diffattn_mla_moe_dit"


def layer_norm(x, g, b):
    xf = x.astype(jnp.float32)
    mu = jnp.mean(xf, axis=-1, keepdims=True)
    var = jnp.mean(jnp.square(xf - mu), axis=-1, keepdims=True)
    return ((xf - mu) * lax.rsqrt(var + LN_EPS)).astype(x.dtype) * g + b


def rms_norm(x, g):
    xf = x.astype(jnp.float32)
    return (xf * lax.rsqrt(jnp.mean(xf * xf, axis=-1, keepdims=True) + RMS_EPS)).astype(x.dtype) * g


def axial_rotary(n, dim):
    rows = n // GRID_W
    row = jnp.repeat(jnp.arange(rows), GRID_W).astype(jnp.float32)
    col = jnp.tile(jnp.arange(GRID_W), rows).astype(jnp.float32)
    n_freq = dim // 4
    inv = ROPE_THETA ** (-jnp.arange(n_freq, dtype=jnp.float32) / n_freq)
    ang = jnp.concatenate([row[:, None] * inv, col[:, None] * inv], axis=-1)
    return jnp.cos(ang), jnp.sin(ang)


def apply_rotary(t, cos, sin):
    t1, t2 = jnp.split(t, 2, axis=-1)
    cos = cos.astype(t.dtype)
    sin = sin.astype(t.dtype)
    return jnp.concatenate([t1 * cos - t2 * sin, t1 * sin + t2 * cos], axis=-1)


def split_in(p):
    idx = [int(v) for v in np.cumsum(IN_SPLITS)[:-1]]
    return jnp.split(p, idx, axis=-1)


def sweep_query_blocks(fn, *qs):
    bsz, h, s, _ = qs[0].shape
    nb = s // Q_BLOCK
    blocks = tuple(q.reshape(bsz, h, nb, Q_BLOCK, q.shape[-1]).transpose(2, 0, 1, 3, 4) for q in qs)
    out = lax.map(lambda blk: fn(*blk), blocks)
    return out.transpose(1, 2, 0, 3, 4).reshape(bsz, h, s, out.shape[-1])


def short_conv(x, w, b):
    n = x.shape[1]
    left = CONV_W // 2
    xp = jnp.pad(x, ((0, 0), (left, CONV_W - 1 - left), (0, 0)))
    y = b + xp[:, 0:n] * w[0]
    for k in range(1, CONV_W):
        y = y + xp[:, k:k + n] * w[k]
    return y


def lru_coeffs(y, wa, ba, wi, bi, lam):
    bsz, n, _ = y.shape
    yb = y.reshape(bsz, n, LRU_BLOCKS, LRU_BLOCK)
    r = jax.nn.sigmoid(jnp.einsum('bnhi,hij->bnhj', yb, wa).reshape(bsz, n, LRU_WIDTH) + ba)
    i = jax.nn.sigmoid(jnp.einsum('bnhi,hij->bnhj', yb, wi).reshape(bsz, n, LRU_WIDTH) + bi)
    log_a = -LRU_C * jax.nn.softplus(-lam.astype(jnp.float32)) * r.astype(jnp.float32)
    a = jnp.exp(log_a)
    u = jnp.sqrt(-jnp.expm1(2.0 * log_a)) * (i * y).astype(jnp.float32)
    return a, u


def linear_scan(a, u, reverse):
    def combine(lhs, rhs):
        a_l, u_l = lhs
        a_r, u_r = rhs
        return a_l * a_r, a_r * u_l + u_r
    return lax.associative_scan(combine, (a, u), reverse=reverse, axis=1)


def rglru_mixer(x_l, g_l, x_c, g_c, conv_w, conv_b, wa, ba, wi, bi, lam, need_ctx):
    y_l = short_conv(x_l, conv_w, conv_b)
    y_c = short_conv(x_c, conv_w, conv_b)
    h_l, h_c = [], []
    for d, rev in enumerate((False, True)):
        a_c, u_c = lru_coeffs(y_c, wa[d], ba[d], wi[d], bi[d], lam[d])
        _, s_c = linear_scan(a_c, u_c, rev)
        h0 = s_c[:, 0] if rev else s_c[:, -1]
        a_l, u_l = lru_coeffs(y_l, wa[d], ba[d], wi[d], bi[d], lam[d])
        cum_a, s_l = linear_scan(a_l, u_l, rev)
        h_l.append(cum_a * h0[:, None, :] + s_l)
        h_c.append(s_c)
    out_l = (h_l[0] + h_l[1]).astype(x_l.dtype) * jax.nn.gelu(g_l)
    out_c = (h_c[0] + h_c[1]).astype(x_c.dtype) * jax.nn.gelu(g_c) if need_ctx else None
    return out_l, out_c


def diff_core(q1, q2, k1, k2, v, lam):
    scale = DA_QK ** -0.5
    p1 = jax.nn.softmax(jnp.einsum('bhqd,bhkd->bhqk', q1, k1).astype(jnp.float32) * scale, axis=-1)
    p2 = jax.nn.softmax(jnp.einsum('bhqd,bhkd->bhqk', q2, k2).astype(jnp.float32) * scale, axis=-1)
    return jnp.einsum('bhqk,bhkd->bhqd', (p1 - lam * p2).astype(v.dtype), v)


def diff_attention(q_l, k_l, v_l, q_c, k_c, v_c, lam_vecs, norm_g, lam_init, cos, sin, need_ctx):
    lv = lam_vecs.astype(jnp.float32)
    lam = jnp.exp(jnp.sum(lv[0] * lv[1])) - jnp.exp(jnp.sum(lv[2] * lv[3])) + lam_init

    def split_qk(t, rotate):
        bsz, n, _ = t.shape
        t = t.reshape(bsz, n, DA_HEADS, 2, DA_QK)
        t1, t2 = t[..., 0, :], t[..., 1, :]
        if rotate:
            t1 = apply_rotary(t1, cos[:, None], sin[:, None])
            t2 = apply_rotary(t2, cos[:, None], sin[:, None])
        return t1.transpose(0, 2, 1, 3), t2.transpose(0, 2, 1, 3)

    def split_v(t):
        bsz, n, _ = t.shape
        return t.reshape(bsz, n, DA_HEADS, DA_V).transpose(0, 2, 1, 3)

    def finish(o):
        bsz, _, n, _ = o.shape
        o = rms_norm(o, norm_g) * (1.0 - lam_init)
        return o.transpose(0, 2, 1, 3).reshape(bsz, n, DA_WIDTH)

    q1c, q2c = split_qk(q_c, False)
    k1c, k2c = split_qk(k_c, False)
    vc = split_v(v_c)
    q1l, q2l = split_qk(q_l, True)
    k1l, k2l = split_qk(k_l, True)
    vl = split_v(v_l)
    k1 = jnp.concatenate([k1c, k1l], axis=2)
    k2 = jnp.concatenate([k2c, k2l], axis=2)
    v = jnp.concatenate([vc, vl], axis=2)
    o_l = sweep_query_blocks(lambda a, b: diff_core(a, b, k1, k2, v, lam), q1l, q2l)
    o_c = finish(diff_core(q1c, q2c, k1c, k2c, vc, lam)) if need_ctx else None
    return finish(o_l), o_c


def mla_core(q_nope, q_rope, k_nope, k_rope, v):
    s = jnp.einsum('bhqd,bhkd->bhqk', q_nope, k_nope) + jnp.einsum('bhqr,bkr->bhqk', q_rope, k_rope)
    p = jax.nn.softmax(s.astype(jnp.float32) * MLA_SCALE, axis=-1)
    return jnp.einsum('bhqk,bhkd->bhqd', p.astype(v.dtype), v)


def mla_attention(cq_l, ckv_l, kr_l, cq_c, ckv_c, kr_c, q_norm, kv_norm, w_uq, w_ukv, cos, sin, need_ctx):
    def project(cq, ckv):
        bsz, n, _ = cq.shape
        q = (rms_norm(cq, q_norm) @ w_uq).reshape(bsz, n, MLA_HEADS, MLA_NOPE + MLA_ROPE)
        kv = (rms_norm(ckv, kv_norm) @ w_ukv).reshape(bsz, n, MLA_HEADS, MLA_NOPE + MLA_V)
        return q[..., :MLA_NOPE], q[..., MLA_NOPE:], kv[..., :MLA_NOPE], kv[..., MLA_NOPE:]

    def heads_first(t):
        return t.transpose(0, 2, 1, 3)

    bsz, n, _ = cq_l.shape
    qn_l, qr_l, kn_l, v_l = project(cq_l, ckv_l)
    qr_l = apply_rotary(qr_l, cos[:, None], sin[:, None])
    kr_l = apply_rotary(kr_l, cos, sin)
    qn_c, qr_c, kn_c, v_c = project(cq_c, ckv_c)
    kn_all = jnp.concatenate([heads_first(kn_c), heads_first(kn_l)], axis=2)
    v_all = jnp.concatenate([heads_first(v_c), heads_first(v_l)], axis=2)
    kr_all = jnp.concatenate([kr_c, kr_l], axis=1)
    o_l = sweep_query_blocks(lambda a, b: mla_core(a, b, kn_all, kr_all, v_all), heads_first(qn_l), heads_first(qr_l))
    out_l = o_l.transpose(0, 2, 1, 3).reshape(bsz, n, MLA_WIDTH)
    out_c = None
    if need_ctx:
        o_c = mla_core(heads_first(qn_c), heads_first(qr_c), heads_first(kn_c), kr_c, heads_first(v_c))
        out_c = o_c.transpose(0, 2, 1, 3).reshape(bsz, cq_c.shape[1], MLA_WIDTH)
    return out_l, out_c


def moe_ffn(t, router_w, router_b, w1, w3, w2):
    scores = jax.nn.sigmoid((t @ router_w).astype(jnp.float32))
    sel = scores + router_b.astype(jnp.float32)
    grp_score = jnp.sum(lax.top_k(sel.reshape(-1, N_GROUPS, EXPERTS_PER_GROUP), TOP_K)[0], axis=-1)
    best = jnp.argmax(grp_score, axis=-1)
    in_group = (jnp.arange(N_EXPERTS) // EXPERTS_PER_GROUP)[None, :] == best[:, None]
    _, idx = lax.top_k(jnp.where(in_group, sel, -jnp.inf), TOP_K)
    w = jnp.take_along_axis(scores, idx, axis=-1)
    w = w / jnp.sum(w, axis=-1, keepdims=True)
    gates = jnp.sum(jax.nn.one_hot(idx, N_EXPERTS, dtype=jnp.float32) * w[..., None], axis=1).astype(t.dtype)
    y = jnp.zeros_like(t)
    for e in range(N_EXPERTS):
        h = jax.nn.silu(t @ w1[e]) * (t @ w3[e])
        y = y + gates[:, e:e + 1] * (h @ w2[e])
    return y


def setup_inputs(seed: int = 0) -> dict:
    key = jax.random.key(seed)
    ks = jax.random.split(key, 32)

    def nrm(i, shape, scale):
        return jax.random.normal(ks[i], shape, jnp.float32) * scale

    def gain(i, shape):
        return 1.0 + nrm(i, shape, 0.02)

    u = jax.random.uniform(ks[14], (DEPTH, 2, LRU_WIDTH), jnp.float32, 0.9, 0.999)
    s = u ** (1.0 / LRU_C)
    lru_lambda = jnp.log(s) - jnp.log1p(-s)
    return {
        "x": nrm(0, (BATCH, SEQ, D_MODEL), 1.0),
        "c": nrm(1, (BATCH, D_MODEL), 1.0),
        "ctx": nrm(2, (BATCH, CTX_LEN, D_MODEL), 1.0),
        "c_ctx": nrm(3, (D_MODEL,), 1.0),
        "w_mod": nrm(4, (DEPTH, D_MODEL, 6 * D_MODEL), 0.5 * D_MODEL ** -0.5),
        "b_mod": nrm(5, (DEPTH, 6 * D_MODEL), 0.02),
        "w_in": nrm(6, (DEPTH, D_MODEL, D_IN), D_MODEL ** -0.5),
        "w_out": nrm(7, (DEPTH, D_MIX, D_MODEL), DEEPNORM_BETA * D_MIX ** -0.5),
        "conv_w": nrm(8, (DEPTH, CONV_W, LRU_WIDTH), CONV_W ** -0.5),
        "conv_b": nrm(9, (DEPTH, LRU_WIDTH), 0.02),
        "lru_wa": nrm(10, (DEPTH, 2, LRU_BLOCKS, LRU_BLOCK, LRU_BLOCK), LRU_BLOCK ** -0.5),
        "lru_ba": nrm(11, (DEPTH, 2, LRU_WIDTH), 0.02),
        "lru_wi": nrm(12, (DEPTH, 2, LRU_BLOCKS, LRU_BLOCK, LRU_BLOCK), LRU_BLOCK ** -0.5),
        "lru_bi": nrm(13, (DEPTH, 2, LRU_WIDTH), 0.02),
        "lru_lambda": lru_lambda,
        "diff_lambda": nrm(15, (DEPTH, 4, DA_QK), 0.1),
        "diff_norm": gain(16, (DEPTH, DA_V)),
        "mla_q_norm": gain(17, (DEPTH, Q_RANK)),
        "mla_kv_norm": gain(18, (DEPTH, KV_RANK)),
        "mla_w_uq": nrm(19, (DEPTH, Q_RANK, MLA_HEADS * (MLA_NOPE + MLA_ROPE)), Q_RANK ** -0.5),
        "mla_w_ukv": nrm(20, (DEPTH, KV_RANK, MLA_HEADS * (MLA_NOPE + MLA_V)), KV_RANK ** -0.5),
        "ln1_g": gain(21, (DEPTH, D_MODEL)),
        "ln1_b": nrm(22, (DEPTH, D_MODEL), 0.02),
        "ln2_g": gain(23, (DEPTH, D_MODEL)),
        "ln2_b": nrm(24, (DEPTH, D_MODEL), 0.02),
        "router_w": nrm(25, (D_MODEL, N_EXPERTS), D_MODEL ** -0.5),
        "router_b": nrm(26, (N_EXPERTS,), 0.01),
        "exp_w1": nrm(27, (DEPTH, N_EXPERTS, D_MODEL, D_EXPERT), D_MODEL ** -0.5),
        "exp_w3": nrm(28, (DEPTH, N_EXPERTS, D_MODEL, D_EXPERT), D_MODEL ** -0.5),
        "exp_w2": nrm(29, (DEPTH, N_EXPERTS, D_EXPERT, D_MODEL), DEEPNORM_BETA * D_EXPERT ** -0.5),
    }


def reference(x, c, ctx, c_ctx, w_mod, b_mod, w_in, w_out, conv_w, conv_b,
              lru_wa, lru_ba, lru_wi, lru_bi, lru_lambda, diff_lambda, diff_norm,
              mla_q_norm, mla_kv_norm, mla_w_uq, mla_w_ukv,
              ln1_g, ln1_b, ln2_g, ln2_b, router_w, router_b, exp_w1, exp_w3, exp_w2):
    bsz, n, d = x.shape
    ctx_len = ctx.shape[1]
    cos_da, sin_da = axial_rotary(n, DA_QK)
    cos_mla, sin_mla = axial_rotary(n, MLA_ROPE)
    s_lat = jax.nn.silu(c)
    s_ctx = jax.nn.silu(c_ctx)
    x_l, x_c = x, ctx
    for l in range(DEPTH):
        need_ctx = l < DEPTH - 1
        mod_l = jnp.split((s_lat @ w_mod[l] + b_mod[l])[:, None, :], 6, axis=-1)
        mod_c = jnp.split(s_ctx @ w_mod[l] + b_mod[l], 6, axis=-1)
        u_l = x_l * (1.0 + mod_l[1]) + mod_l[0]
        u_c = x_c * (1.0 + mod_c[1]) + mod_c[0]
        p_l = split_in(u_l @ w_in[l])
        p_c = split_in(u_c @ w_in[l])
        a_l, a_c = rglru_mixer(p_l[0], p_l[1], p_c[0], p_c[1], conv_w[l], conv_b[l],
                               lru_wa[l], lru_ba[l], lru_wi[l], lru_bi[l], lru_lambda[l], need_ctx)
        lam_init = 0.8 - 0.6 * math.exp(-0.3 * l)
        b_l, b_c = diff_attention(p_l[2], p_l[3], p_l[4], p_c[2], p_c[3], p_c[4],
                                  diff_lambda[l], diff_norm[l], lam_init, cos_da, sin_da, need_ctx)
        m_l, m_c = mla_attention(p_l[5], p_l[6], p_l[7], p_c[5], p_c[6], p_c[7],
                                 mla_q_norm[l], mla_kv_norm[l], mla_w_uq[l], mla_w_ukv[l],
                                 cos_mla, sin_mla, need_ctx)
        o_l = jnp.concatenate([a_l, b_l, m_l], axis=-1) @ w_out[l]
        x_l = layer_norm(DEEPNORM_ALPHA * x_l + mod_l[2] * o_l, ln1_g[l], ln1_b[l])
        v_l = x_l * (1.0 + mod_l[4]) + mod_l[3]
        if need_ctx:
            o_c = jnp.concatenate([a_c, b_c, m_c], axis=-1) @ w_out[l]
            x_c = layer_norm(DEEPNORM_ALPHA * x_c + mod_c[2] * o_c, ln1_g[l], ln1_b[l])
            v_c = x_c * (1.0 + mod_c[4]) + mod_c[3]
            f = moe_ffn(jnp.concatenate([v_l.reshape(-1, d), v_c.reshape(-1, d)], axis=0),
                        router_w, router_b, exp_w1[l], exp_w3[l], exp_w2[l])
            f_l = f[: bsz * n].reshape(bsz, n, d)
            f_c = f[bsz * n:].reshape(bsz, ctx_len, d)
            x_c = layer_norm(DEEPNORM_ALPHA * x_c + mod_c[5] * f_c, ln2_g[l], ln2_b[l])
        else:
            f_l = moe_ffn(v_l.reshape(-1, d), router_w, router_b, exp_w1[l], exp_w3[l], exp_w2[l]).reshape(bsz, n, d)
        x_l = layer_norm(DEEPNORM_ALPHA * x_l + mod_l[5] * f_l, ln2_g[l], ln2_b[l])
    return x_l
```

```cpp
#include <hip/hip_runtime.h>
#include <cstdio>
#include <cstdint>

#define LAS __attribute__((address_space(3)))
#define GAS __attribute__((address_space(1)))
typedef unsigned short bf16_t;
typedef short bf16x8 __attribute__((ext_vector_type(8)));
typedef short s16x4 __attribute__((ext_vector_type(4)));
typedef float f32x2 __attribute__((ext_vector_type(2)));
typedef float f32x4 __attribute__((ext_vector_type(4)));
typedef float f32x16 __attribute__((ext_vector_type(16)));
typedef unsigned u32x2 __attribute__((ext_vector_type(2)));
typedef unsigned u32x4 __attribute__((ext_vector_type(4)));
typedef GAS unsigned gu32;

constexpr int DM = 1024, NBATCH = 16, SEQ = 4096, DEPTH = 4, CTXL = 256;
constexpr int NLAT = NBATCH * SEQ, NCTX = NBATCH * CTXL, NTOK = NLAT + NCTX;
constexpr int D_IN = 2080, NIN_PAD = 2304;
constexpr int NEXP = 16, DEXP = 256;
constexpr int NWAVES = 8, NTHREADS = 512;
constexpr float LN_EPS = 1e-5f, RMS_EPS = 1e-6f;
constexpr float DN_ALPHA = 1.6817928305074292f;
constexpr float LOG2E = 1.4426950408889634f;
constexpr float DA_QSCALE = 0.17677669529663687f * LOG2E;
constexpr float MLA_QSCALE = 0.10206207261596577f * LOG2E;
constexpr int NCHUNK_LAT = NLAT / 32, NCHUNK = NTOK / 32;

constexpr size_t MiB = 1u << 20;
constexpr size_t WS_CTL = 0, CTL_ZERO_BYTES = 1 * MiB;
constexpr size_t WS_MOD = 1 * MiB;
constexpr size_t WS_ROT = 3 * MiB;
constexpr size_t WS_SSQ = 4 * MiB;
constexpr size_t WS_ROUTE = 7 * MiB;
constexpr size_t WS_LIST = 154 * MiB;
constexpr size_t WS_LSUM = 14 * MiB;
constexpr size_t WS_LCAR = 23 * MiB;
constexpr size_t WS_WG = 28 * MiB;
constexpr size_t WS_WUQ = 29 * MiB;
constexpr size_t WS_WUKV = 31 * MiB;
constexpr size_t WS_WIN = 32 * MiB;
constexpr size_t WS_WOUT = 50 * MiB;
constexpr size_t WS_W13 = 58 * MiB;
constexpr size_t WS_W2 = 122 * MiB;
constexpr size_t WS_XC = 154 * MiB;
constexpr size_t WS_R1 = 170 * MiB;
constexpr size_t WS_R2 = 306 * MiB;
constexpr size_t WS_R3 = 442 * MiB;
constexpr size_t WS_R4 = 578 * MiB;
constexpr size_t WS_U = WS_R1, WS_MIX = WS_R1;
constexpr size_t WS_O = WS_R2, WS_F0 = WS_R2, WS_QD = WS_R2, WS_KD = WS_R2 + 51 * MiB, WS_XL = WS_R2 + 102 * MiB;
constexpr size_t WS_V = WS_R3, WS_F1 = WS_R3, WS_VD = WS_R3, WS_KN = WS_R3 + 51 * MiB, WS_GG = WS_R3 + 102 * MiB;
constexpr size_t WS_VM = WS_R4, WS_QM = WS_R4 + 51 * MiB, WS_CQ = WS_R4 + 128 * MiB, WS_CKV = WS_R4 + 162 * MiB, WS_KR = WS_R4 + 179 * MiB, WS_H = WS_R4;
constexpr size_t WS_XB = WS_R4 + 184 * MiB;
constexpr size_t WS_SSP = WS_XB + 136 * MiB;
constexpr size_t WS_END = WS_SSP + 4 * MiB;
static_assert((size_t)NTOK * 384 * 2 <= 51 * MiB && (size_t)NTOK * 256 * 2 <= 34 * MiB && (size_t)NTOK * 576 * 2 <= 77 * MiB && (size_t)NTOK * 1024 * 2 == 136 * MiB, "ws map");
static_assert((size_t)(2 * NTOK + 256) * 256 * 2 <= 128 * MiB, "H overlay");
constexpr int CW_BAR = 4096;
constexpr int CW_CNT = 2048;

constexpr int RING_BYTES = 155648;
constexpr int ROT_OFF = RING_BYTES;
constexpr int MISC_OFF = ROT_OFF + 4096;

constexpr int LDS_BYTES = 163840;

#define LDS_WAIT() asm volatile("s_waitcnt lgkmcnt(0)" ::: "memory")
#define VM_WAIT() asm volatile("s_waitcnt vmcnt(0)" ::: "memory")
__device__ __forceinline__ unsigned f2bf(float f) { unsigned u = __builtin_bit_cast(unsigned, f); return (u + 0x7fffu + ((u >> 16) & 1u)) >> 16; }
__device__ __forceinline__ unsigned pk2(float lo, float hi) { return f2bf(lo) | (f2bf(hi) << 16); }
typedef float f32x2_t __attribute__((ext_vector_type(2))); typedef __bf16 bf16x2_t __attribute__((ext_vector_type(2)));
__device__ __forceinline__ unsigned cvt_pk_bf16(float lo, float hi) { f32x2_t v = {lo, hi}; bf16x2_t b = __builtin_convertvector(v, bf16x2_t); return __builtin_bit_cast(unsigned, b); }
__device__ __forceinline__ float bf2f(unsigned h) { return __uint_as_float(h << 16); }
__device__ __forceinline__ float bflo(unsigned w) { return __uint_as_float(w << 16); }
__device__ __forceinline__ float bfhi(unsigned w) { return __uint_as_float(w & 0xffff0000u); }
template <int CTRL> __device__ __forceinline__ float dpp_f(float v) { return __builtin_bit_cast(float, __builtin_amdgcn_update_dpp(0, __builtin_bit_cast(int, v), CTRL, 0xF, 0xF, true)); }
__device__ __forceinline__ float wave_sum(float v) {
    v += dpp_f<0xB1>(v); v += dpp_f<0x4E>(v); v += dpp_f<0x124>(v); v += dpp_f<0x128>(v);
    { auto rr = __builtin_amdgcn_permlane16_swap(__float_as_uint(v), __float_as_uint(v), false, false); v = __uint_as_float(rr[0]) + __uint_as_float(rr[1]); }
    { auto rr = __builtin_amdgcn_permlane32_swap(__float_as_uint(v), __float_as_uint(v), false, false); v = __uint_as_float(rr[0]) + __uint_as_float(rr[1]); }
    return v;
}
__device__ __forceinline__ float fast_exp2(float x) { return __builtin_amdgcn_exp2f(x); }
__device__ __forceinline__ float fast_rcp(float x) { return __builtin_amdgcn_rcpf(x); }
__device__ __forceinline__ float sigmoidf_(float x) { return fast_rcp(1.0f + fast_exp2(-LOG2E * x)); }
__device__ __forceinline__ float gelu_tanh(float x) { const float z = 0.7978845608028654f * (x + 0.044715f * x * x * x); return x * fast_rcp(1.0f + fast_exp2(-2.0f * LOG2E * z)); }
constexpr int WIDTAB_OFF = 159744 + 512;
__device__ __forceinline__ int otid() {
    const unsigned hw = (unsigned)__builtin_amdgcn_s_getreg((5 << 11) | (0 << 6) | 4) & 63u;
    int w = ((const LAS int*)(size_t)WIDTAB_OFF)[hw];
    int t = (w << 6) | (int)__builtin_amdgcn_mbcnt_hi(~0u, __builtin_amdgcn_mbcnt_lo(~0u, 0u));
    asm volatile("" : "+v"(t)); return t; }
__device__ __forceinline__ int crow(int r, int hi) { return (r & 3) + 8 * (r >> 2) + 4 * hi; }
__device__ __forceinline__ f32x16 mfma32(bf16x8 a, bf16x8 b, f32x16 c) { return __builtin_amdgcn_mfma_f32_32x32x16_bf16(a, b, c, 0, 0, 0); }

#define XB_TMO      128
#define XB_XCNT(j)  (256  + 64 * (j))
#define XB_XSUB(j)  (1280 + 64 * (j))
#define XB_XGEN(j)  (2304 + 64 * (j))
#define XB_TOP      3328
#define XB_TOPGEN   3392
#define XCD_BAR_WORDS 3456
#define XB_SPIN_CAP (1u << 18)

__device__ __forceinline__ unsigned xb_ld(unsigned* p)              { return __hip_atomic_load(p, __ATOMIC_RELAXED, __HIP_MEMORY_SCOPE_AGENT); }
__device__ __forceinline__ unsigned xb_add(unsigned* p, unsigned v) { return __hip_atomic_fetch_add(p, v, __ATOMIC_RELAXED, __HIP_MEMORY_SCOPE_AGENT); }
__device__ __forceinline__ unsigned xb_xcc_id() { return (unsigned)__builtin_amdgcn_s_getreg((3 << 11) | 20) & 0xFu; }
#define XB_SPIN(cond, bar) do { unsigned _sp = 0; while (cond) { __builtin_amdgcn_s_sleep(1); \
    if ((++_sp & 255u) == 0u) { if (xb_ld(&(bar)[XB_TMO])) break; if (_sp > XB_SPIN_CAP) { atomicAdd(&(bar)[XB_TMO], 1u); break; } } } } while (0)

struct XcdBarrier {
    unsigned* bar; unsigned x;
    volatile LAS unsigned* st;
};

__device__ __forceinline__ XcdBarrier xcd_barrier_post(unsigned* bar, volatile LAS unsigned* st) {
    XcdBarrier b; b.bar = bar; b.x = xb_xcc_id(); b.st = st;
    if (threadIdx.x == 0) (void)xb_add(&bar[XB_XCNT(b.x)], 1u);
    return b;
}
__device__ __forceinline__ void xcd_barrier_complete(unsigned* bar, unsigned x, unsigned& nloc, unsigned& nx) {
    const unsigned G = gridDim.x * gridDim.y * gridDim.z;
    unsigned sum, cnt, mine, sp = 0u;
    for (;;) {
        sum = 0u; cnt = 0u; mine = 0u;
#pragma unroll
        for (unsigned j = 0; j < 16; ++j) { const unsigned c = xb_ld(&bar[XB_XCNT(j)]); sum += c; cnt += (c > 0u) ? 1u : 0u; mine = (j == x) ? c : mine; }
        if (sum == G) break;
        __builtin_amdgcn_s_sleep(1);
        if ((++sp & 255u) == 0u) { if (xb_ld(&bar[XB_TMO])) break; if (sp > XB_SPIN_CAP) { atomicAdd(&bar[XB_TMO], 1u); break; } }
    }
    nloc = mine > 0u ? mine : 1u; nx = cnt > 0u ? cnt : 1u;
}

__device__ __forceinline__ void xcd_barrier(const XcdBarrier& b) {
    asm volatile("s_waitcnt vmcnt(0)" ::: "memory");
    __syncthreads();
    if (otid() == 0) {
        unsigned* bar = b.bar; unsigned bx_ = b.x; asm volatile("" : "+s"(bar), "+s"(bx_));
        __builtin_amdgcn_s_waitcnt(0);
        unsigned nloc = b.st[0], nx = b.st[1];
        if (nloc == 0u) { xcd_barrier_complete(bar, bx_, nloc, nx); b.st[0] = nloc; b.st[1] = nx; }
        const unsigned old = xb_add(&bar[XB_XSUB(bx_)], 1u);
        const unsigned gen = old / nloc;
        if (old + 1u == (gen + 1u) * nloc) {
            __builtin_amdgcn_fence(__ATOMIC_RELEASE, "agent");
            asm volatile("s_waitcnt vmcnt(0)" ::: "memory");
            const unsigned og = xb_add(&bar[XB_TOP], 1u);
            const unsigned tg = og / nx;
            if (og + 1u == (tg + 1u) * nx) xb_add(&bar[XB_TOPGEN], 1u);
            else XB_SPIN(xb_ld(&bar[XB_TOPGEN]) == tg, bar);
            __builtin_amdgcn_fence(__ATOMIC_ACQUIRE, "agent");
            xb_add(&bar[XB_XGEN(bx_)], 1u);
            asm volatile("s_waitcnt vmcnt(0)" ::: "memory");
        } else {
            XB_SPIN(xb_ld(&bar[XB_XGEN(bx_)]) == gen, bar);
            __builtin_amdgcn_fence(__ATOMIC_ACQUIRE, "agent");
            asm volatile("s_waitcnt vmcnt(0)" ::: "memory");
        }
    }
    __syncthreads();
}

namespace pg8 {
constexpr int BM = 256, BK = 64, HALF = 128, HTB = HALF * BK * 2  , STAGE_BYTES = 8 * HTB, NXCD = 8, WGM = 8;
__host__ __device__ __forceinline__ int lds_byte(int r, int c) { const int st = (r >> 4) * 2 + (c >> 5), rr = r & 15, cc = c & 31, ob = rr * 64 + cc * 2; return st * 1024 + (ob ^ (((ob >> 9) & 1) << 5)); }
__host__ __device__ __forceinline__ void stage_rc(int b, int& R, int& C) { const int st = b / 1024, sb = b % 1024, swz = sb ^ (((sb >> 9) & 1) << 5); R = (st >> 1) * 16 + swz / 64; C = (st & 1) * 32 + (swz % 64) / 2; }
__host__ __device__ __forceinline__ int perm32(int rho) { const int n = rho >> 4, i = rho & 15; return 8 * (i >> 2) + 4 * n + (i & 3); }

struct Unit { int arow, brow, pm, pn, e, nvalid; };

struct StaticOrder {
    int nM, nN, nwg, G, c;
    __device__ void init(int M, int N, int G_, int c_) { nM = M / BM; nN = N / BM; nwg = nM * nN; G = G_; c = c_; }
    __device__ bool next(int i, Unit& u) const {
        const long L = (long)i * G + c; if (L >= nwg) return false;
        int wgid = (int)L; { const int q = nwg / NXCD, r = nwg % NXCD, xcd = wgid % NXCD, off = wgid / NXCD; wgid = (xcd < r ? xcd * (q + 1) : r * (q + 1) + (xcd - r) * q) + off; }
        const int nig = WGM * nN, gid = wgid / nig, fm = gid * WGM, gsz = (nM - fm) < WGM ? (nM - fm) : WGM;
        u.pm = fm + ((wgid % nig) % gsz); u.pn = (wgid % nig) / gsz; u.arow = u.pm * BM; u.brow = u.pn * BM; u.e = 0; u.nvalid = BM; return true;
    }
    __device__ __forceinline__ unsigned goff(const Unit&, int) const { return 0u; }
};

template <class Epi, class Sched, bool GATHER>
__device__ __forceinline__ void gemm_phase(LAS unsigned char* lds, const bf16_t* Ag, const bf16_t* Btg, const int K_, const Sched& S, const Epi& E) {
    int K = K_; asm volatile("" : "+s"(K));
    const int tid = otid(), wid = __builtin_amdgcn_readfirstlane(tid >> 6), lane = tid & 63, wr = wid >> 2, wc = wid & 3, fr = lane & 15, fq = lane >> 4;
    const int nt = K / BK;
    unsigned voffA[2], voffB[2];
#pragma unroll
    for (int i = 0; i < 2; ++i) { int R, C; stage_rc(tid * 16 + i * 8192, R, C); const int Rb = (R & ~31) + perm32(R & 31);
        voffA[i] = (unsigned)(R * K + C) * 2u; voffB[i] = (unsigned)(Rb * K + C) * 2u; }
    const size_t kstep = (size_t)(BK * 2);
    const size_t hstep = (size_t)HALF * K * 2;
    const unsigned ldsw = (unsigned)wid * 1024u;
    const int aoff = lds_byte(wr * 64 + fr, fq * 8), boff = lds_byte(wc * 32 + fr, fq * 8);
    unsigned vAc[2][2], vAn[2][2];
#define PG8_SA(b, h) (((b) * 2 + (h)) * HTB)
#define PG8_SB(b, h) ((4 + (b) * 2 + (h)) * HTB)
#define PG8_STAGE(bufoff, gbase, voff) do { _Pragma("unroll") for (int _i = 0; _i < 2; ++_i) \
        __builtin_amdgcn_global_load_lds((const unsigned*)((const char*)(gbase) + (voff)[_i]), (LAS unsigned*)(lds + (bufoff) + ldsw + _i * 8192), 16, 0, 0); } while (0)
#define PG8_STAGE_A(bufoff, base, h, nx) do { if constexpr (GATHER) { _Pragma("unroll") for (int _i = 0; _i < 2; ++_i) \
        __builtin_amdgcn_global_load_lds((const unsigned*)((const char*)(base) + ((nx) ? vAn[h][_i] : vAc[h][_i])), (LAS unsigned*)(lds + (bufoff) + ldsw + _i * 8192), 16, 0, 0); } \
        else { PG8_STAGE(bufoff, (const char*)(base) + (h) * hstep, voffA); } } while (0)
#define PG8_LDA(dst, b, h) do { _Pragma("unroll") for (int m = 0; m < 4; ++m) _Pragma("unroll") for (int k = 0; k < 2; ++k) dst[m][k] = *(const LAS bf16x8*)(lds + PG8_SA(b, h) + aoff + m * 2048 + k * 1024); } while (0)
#define PG8_LDB(dst, b, h) do { _Pragma("unroll") for (int n = 0; n < 2; ++n) _Pragma("unroll") for (int k = 0; k < 2; ++k) dst[n][k] = *(const LAS bf16x8*)(lds + PG8_SB(b, h) + boff + n * 2048 + k * 1024); } while (0)
#define PG8_MMA(ai, bj, At, Bt) do { __builtin_amdgcn_s_setprio(1); _Pragma("unroll") for (int m = 0; m < 4; ++m) _Pragma("unroll") for (int n = 0; n < 2; ++n) _Pragma("unroll") for (int k = 0; k < 2; ++k) \
        acc[ai][bj][m][n] = __builtin_amdgcn_mfma_f32_16x16x32_bf16(Bt[n][k], At[m][k], acc[ai][bj][m][n], 0, 0, 0); __builtin_amdgcn_s_setprio(0); } while (0)
#define PG8_WAIT_V(n) asm volatile("s_waitcnt vmcnt(" #n ")" ::: "memory")
#define PG8_WAIT_L(n) asm volatile("s_waitcnt lgkmcnt(" #n ")" ::: "memory")
#define PG8_BAR __builtin_amdgcn_s_barrier()
#define PG8_SCHED __builtin_amdgcn_sched_barrier(0)
#define PG8_GOFF(u, v) do { if constexpr (GATHER) { const int _t = otid(); _Pragma("unroll") for (int _i = 0; _i < 2; ++_i) { int _R, _C; stage_rc(_t * 16 + _i * 8192, _R, _C); \
        _Pragma("unroll") for (int _h = 0; _h < 2; ++_h) v[_h][_i] = (S.goff(u, _h * HALF + _R) + (unsigned)_C) * 2u; } } } while (0)
    Unit cur, nxt; int ui = 0;
    if (!S.next(0, cur)) return;
    f32x4 acc[2][2][4][2];
#pragma unroll
    for (int a = 0; a < 2; ++a)
#pragma unroll
        for (int b = 0; b < 2; ++b)
#pragma unroll
            for (int m = 0; m < 4; ++m)
#pragma unroll
                for (int n = 0; n < 2; ++n) acc[a][b][m][n] = (f32x4){0.f, 0.f, 0.f, 0.f};
    bf16x8 At[4][2], B0[2][2], B1[2][2];
    PG8_GOFF(cur, vAc);
#pragma unroll
    for (int _h = 0; _h < 2; ++_h)
#pragma unroll
        for (int _i = 0; _i < 2; ++_i) vAn[_h][_i] = vAc[_h][_i];
    const char* cA = GATHER ? (const char*)Ag : (const char*)Ag + (size_t)cur.arow * K * 2; const char* cB = (const char*)Btg + (size_t)cur.brow * K * 2;
    PG8_STAGE(PG8_SB(0, 0), cB, voffB); PG8_STAGE(PG8_SB(0, 1), cB + hstep, voffB); PG8_STAGE_A(PG8_SA(0, 0), cA, 0, false); PG8_STAGE_A(PG8_SA(0, 1), cA, 1, false);
    if (wr == 1) PG8_BAR;
    PG8_WAIT_V(2); PG8_BAR;
    PG8_STAGE(PG8_SB(1, 0), cB + kstep, voffB); PG8_STAGE_A(PG8_SA(1, 0), cA + kstep, 0, false); PG8_STAGE(PG8_SB(1, 1), cB + hstep + kstep, voffB);
    PG8_WAIT_V(6); PG8_BAR;
    for (;;) {
        const bool has_next = S.next(ui + 1, nxt);
        if (has_next) { PG8_GOFF(nxt, vAn); }
        const char* nA = GATHER ? (const char*)Ag : (has_next ? (const char*)Ag + (size_t)nxt.arow * K * 2 : cA); const char* nB = has_next ? (const char*)Btg + (size_t)nxt.brow * K * 2 : cB;
#pragma nounroll
        for (int t = 0; t < nt; t += 2) {
            const bool last = (t == nt - 2);
            const char* a1 = cA + (size_t)(t + 1) * kstep;
            const char* a2 = last ? nA : cA + (size_t)(t + 2) * kstep; const char* b2 = last ? nB : cB + (size_t)(t + 2) * kstep;
            const char* a3 = a2 + kstep; const char* b3 = b2 + kstep;
            PG8_LDB(B0, 0, 0); PG8_LDB(B1, 0, 1); PG8_SCHED; PG8_LDA(At, 0, 0); PG8_STAGE_A(PG8_SA(1, 1), a1, 1, false);
            PG8_WAIT_V(8); PG8_WAIT_L(0); PG8_BAR; PG8_MMA(0, 0, At, B0); PG8_MMA(0, 1, At, B1); PG8_BAR; PG8_SCHED;
            PG8_LDA(At, 0, 1); PG8_STAGE(PG8_SB(0, 0), b2, voffB); PG8_STAGE(PG8_SB(0, 1), b2 + hstep, voffB); PG8_STAGE_A(PG8_SA(0, 0), a2, 0, last);
            PG8_WAIT_V(8); PG8_WAIT_L(0); PG8_BAR; PG8_MMA(1, 0, At, B0); PG8_MMA(1, 1, At, B1); PG8_BAR; PG8_SCHED;
            PG8_LDB(B0, 1, 0); PG8_LDB(B1, 1, 1); PG8_SCHED; PG8_LDA(At, 1, 0); PG8_STAGE_A(PG8_SA(0, 1), a2, 1, last);
            PG8_WAIT_V(8); PG8_WAIT_L(0); PG8_BAR; PG8_MMA(0, 0, At, B0); PG8_MMA(0, 1, At, B1); PG8_BAR; PG8_SCHED;
            PG8_LDA(At, 1, 1); PG8_STAGE(PG8_SB(1, 0), b3, voffB); PG8_STAGE(PG8_SB(1, 1), b3 + hstep, voffB); PG8_STAGE_A(PG8_SA(1, 0), a3, 0, last);
            PG8_WAIT_V(8); PG8_WAIT_L(0); PG8_BAR; PG8_MMA(1, 0, At, B0); PG8_MMA(1, 1, At, B1); PG8_BAR; PG8_SCHED;
        }
        if (wr == 0) PG8_BAR;
        E(acc, cur, wr, wc, fr, fq);
        if (!has_next) break;
#pragma unroll
        for (int a = 0; a < 2; ++a)
#pragma unroll
            for (int b = 0; b < 2; ++b)
#pragma unroll
                for (int m = 0; m < 4; ++m)
#pragma unroll
                    for (int n = 0; n < 2; ++n) acc[a][b][m][n] = (f32x4){0.f, 0.f, 0.f, 0.f};
        cur = nxt; cA = nA; cB = nB; ++ui;
#pragma unroll
        for (int _h = 0; _h < 2; ++_h)
#pragma unroll
            for (int _i = 0; _i < 2; ++_i) vAc[_h][_i] = vAn[_h][_i];
        if (wr == 1) PG8_BAR;
    }
    PG8_WAIT_V(0);
    PG8_BAR;
#undef PG8_SA
#undef PG8_SB
#undef PG8_STAGE
#undef PG8_STAGE_A
#undef PG8_LDA
#undef PG8_LDB
#undef PG8_MMA
#undef PG8_WAIT_V
#undef PG8_WAIT_L
#undef PG8_BAR
#undef PG8_SCHED
#undef PG8_GOFF
}
}

using pg8::Unit;
__device__ __forceinline__ void st16(bf16_t* p, f32x4 v0, f32x4 v1) { u32x4 w; w.x = cvt_pk_bf16(v0[0], v0[1]); w.y = cvt_pk_bf16(v0[2], v0[3]); w.z = cvt_pk_bf16(v1[0], v1[1]); w.w = cvt_pk_bf16(v1[2], v1[3]); *(u32x4*)p = w; }
__device__ __forceinline__ void st8(bf16_t* p, f32x4 v) { u32x2 w; w.x = cvt_pk_bf16(v[0], v[1]); w.y = cvt_pk_bf16(v[2], v[3]); *(u32x2*)p = w; }

__device__ __forceinline__ void rot4(f32x4& x1, f32x4& x2, const LAS float* rot, int row, int fq) {
    const int t = row & (SEQ - 1), pos = (fq < 2) ? (t >> 6) : (t & 63);
    const f32x4 c = *(const LAS f32x4*)(rot + pos * 8 + 4 * (fq & 1)), s = *(const LAS f32x4*)(rot + 512 + pos * 8 + 4 * (fq & 1));
    const f32x4 a = x1 * c - x2 * s, b = x1 * s + x2 * c; x1 = a; x2 = b;
}

struct EpiInProj {
    bf16_t *XL, *GG, *QD, *KD, *VD, *CQ, *CKV, *KR; float* ssq; const LAS float* rot;
    __device__ __forceinline__ void operator()(const f32x4 (&acc)[2][2][4][2], const Unit& u, int wr, int wc, int fr, int fq) const {
#pragma unroll
        for (int bj = 0; bj < 2; ++bj) {
            const int g = u.pn * 8 + bj * 4 + wc;
            if (g >= 65) continue;
            bf16_t* dst; int pitch, gl, kind = 0, sq = -1; float sc = 1.0f;
            if (g < 8) { dst = XL; pitch = 256; gl = g; }
            else if (g < 16) { dst = GG; pitch = 256; gl = g - 8; kind = 1; }
            else if (g < 28) { dst = QD; pitch = 384; gl = g - 16; kind = 2; sc = DA_QSCALE; }
            else if (g < 40) { dst = KD; pitch = 384; gl = g - 28; kind = 2; }
            else if (g < 52) { dst = VD; pitch = 384; gl = g - 40; }
            else if (g < 60) { dst = CQ; pitch = 256; gl = g - 52; sq = 0; }
            else if (g < 64) { dst = CKV; pitch = 128; gl = g - 60; sq = 1; }
            else { dst = KR; pitch = 32; gl = 0; kind = 2; }
#pragma unroll
            for (int ai = 0; ai < 2; ++ai)
#pragma unroll
                for (int m = 0; m < 4; ++m) {
                    const int row = u.pm * 256 + ai * 128 + wr * 64 + m * 16 + fr;
                    f32x4 v0 = acc[ai][bj][m][0], v1 = acc[ai][bj][m][1];
                    bf16_t* rp = dst + (size_t)row * pitch + gl * 32;
                    if (kind == 2) {
                        if (row < NLAT) rot4(v0, v1, rot, row, fq);
                        v0 = v0 * sc; v1 = v1 * sc;
                        st8(rp + 4 * fq, v0); st8(rp + 16 + 4 * fq, v1);
                    } else {
                        if (kind == 1) {
#pragma unroll
                            for (int j = 0; j < 4; ++j) { v0[j] = gelu_tanh(v0[j]); v1[j] = gelu_tanh(v1[j]); }
                        }
                        if (sq >= 0) {
                            float s = (v0[0] * v0[0] + v0[1] * v0[1]) + (v0[2] * v0[2] + v0[3] * v0[3]) + (v1[0] * v1[0] + v1[1] * v1[1]) + (v1[2] * v1[2] + v1[3] * v1[3]);
                            s += __shfl_xor(s, 16); s += __shfl_xor(s, 32);
                            if (fq == 0) ssq[(size_t)row * 12 + (g - 52)] = s;
                        }
                        st16(rp + 8 * fq, v0, v1);
                    }
                }
        }
    }
};

struct EpiExpQ {
    bf16_t* QM; const float* ssq; const LAS float* rot;
    __device__ __forceinline__ void operator()(const f32x4 (&acc)[2][2][4][2], const Unit& u, int wr, int wc, int fr, int fq) const {
        float rs[2][4];
#pragma unroll
        for (int ai = 0; ai < 2; ++ai)
#pragma unroll
            for (int m = 0; m < 4; ++m) { const int row = u.pm * 256 + ai * 128 + wr * 64 + m * 16 + fr; const f32x4 pa_ = *(const f32x4*)(ssq + (size_t)row * 12), pb_ = *(const f32x4*)(ssq + (size_t)row * 12 + 4);
                rs[ai][m] = rsqrtf((((pa_[0] + pa_[1]) + (pa_[2] + pa_[3])) + ((pb_[0] + pb_[1]) + (pb_[2] + pb_[3]))) * (1.0f / 256.0f) + RMS_EPS) * MLA_QSCALE; }
#pragma unroll
        for (int bj = 0; bj < 2; ++bj) {
            const int g = u.pn * 8 + bj * 4 + wc;
            if (g >= 18) continue;
            const int head = g / 3, part = g % 3;
#pragma unroll
            for (int ai = 0; ai < 2; ++ai)
#pragma unroll
                for (int m = 0; m < 4; ++m) {
                    const int row = u.pm * 256 + ai * 128 + wr * 64 + m * 16 + fr;
                    f32x4 v0 = acc[ai][bj][m][0] * rs[ai][m], v1 = acc[ai][bj][m][1] * rs[ai][m];
                    bf16_t* rp = QM + (size_t)row * 576 + head * 96 + part * 32;
                    if (part == 2) { if (row < NLAT) rot4(v0, v1, rot, row, fq); st8(rp + 4 * fq, v0); st8(rp + 16 + 4 * fq, v1); }
                    else st16(rp + 8 * fq, v0, v1);
                }
        }
    }
};
struct EpiExpKV {
    bf16_t *KN, *VM; const float* ssq;
    __device__ __forceinline__ void operator()(const f32x4 (&acc)[2][2][4][2], const Unit& u, int wr, int wc, int fr, int fq) const {
        float rs[2][4];
#pragma unroll
        for (int ai = 0; ai < 2; ++ai)
#pragma unroll
            for (int m = 0; m < 4; ++m) { const int row = u.pm * 256 + ai * 128 + wr * 64 + m * 16 + fr; const f32x4 pc_ = *(const f32x4*)(ssq + (size_t)row * 12 + 8);
                rs[ai][m] = rsqrtf(((pc_[0] + pc_[1]) + (pc_[2] + pc_[3])) * (1.0f / 128.0f) + RMS_EPS); }
#pragma unroll
        for (int bj = 0; bj < 2; ++bj) {
            const int g = u.pn * 8 + bj * 4 + wc;
            const int head = g >> 2, part = g & 3;
            bf16_t* base = (part < 2 ? KN : VM) + head * 64 + (part & 1) * 32 + 8 * fq;
#pragma unroll
            for (int ai = 0; ai < 2; ++ai)
#pragma unroll
                for (int m = 0; m < 4; ++m) {
                    const int row = u.pm * 256 + ai * 128 + wr * 64 + m * 16 + fr;
                    st16(base + (size_t)row * 384, acc[ai][bj][m][0] * rs[ai][m], acc[ai][bj][m][1] * rs[ai][m]);
                }
        }
    }
};
struct EpiPlain {
    bf16_t* O; int ldc;
    __device__ __forceinline__ void operator()(const f32x4 (&acc)[2][2][4][2], const Unit& u, int wr, int wc, int fr, int fq) const {
#pragma unroll
        for (int ai = 0; ai < 2; ++ai)
#pragma unroll
            for (int m = 0; m < 4; ++m) {
                bf16_t* rp = O + (size_t)(u.pm * 256 + ai * 128 + wr * 64 + m * 16 + fr) * ldc + u.pn * 256 + wc * 32 + 8 * fq;
#pragma unroll
                for (int bj = 0; bj < 2; ++bj) st16(rp + bj * 128, acc[ai][bj][m][0], acc[ai][bj][m][1]);
            }
    }
};

struct MoeSched {
    const LAS int* tb;
    const unsigned* list;
    int G, c, ncol;
    __device__ bool next(int i, Unit& u) const {
        const int L = i * G + c, T = tb[33 + 16];
        if (L >= T * ncol) return false;
        const int tl = L / ncol; u.pn = L % ncol;
        int e = 0;
#pragma unroll
        for (int k = 1; k < 16; ++k) e += (tl >= tb[33 + k]) ? 1 : 0;
        u.e = e; u.pm = tl - tb[33 + e]; u.nvalid = tb[e] - u.pm * 256; if (u.nvalid > 256) u.nvalid = 256;
        u.arow = tb[16 + e] + u.pm * 256; u.brow = (e * ncol + u.pn) * 256;
        return true;
    }
    __device__ __forceinline__ unsigned goff(const Unit& u, int r) const {
        const int rc = r < u.nvalid ? r : u.nvalid - 1; const unsigned ent = list[((size_t)u.e * NTOK + u.pm * 256 + rc) * 2];
        return (ent >> 1) * 1024u;
    }
};
struct EpiMoeUp {
    bf16_t* H;
    __device__ __forceinline__ void operator()(const f32x4 (&acc)[2][2][4][2], const Unit& u, int wr, int wc, int fr, int fq) const {
#pragma unroll
        for (int ai = 0; ai < 2; ++ai)
#pragma unroll
            for (int m = 0; m < 4; ++m) {
                const int r = ai * 128 + wr * 64 + m * 16 + fr;
                if (r < u.nvalid) {
                    bf16_t* rp = H + (size_t)(u.arow + r) * 256 + (u.pn & 1) * 128 + wc * 16 + 4 * fq;
#pragma unroll
                    for (int bj = 0; bj < 2; ++bj) { const f32x4 a = acc[ai][bj][m][0], b = acc[ai][bj][m][1]; f32x4 h;
#pragma unroll
                        for (int j = 0; j < 4; ++j) h[j] = a[j] * sigmoidf_(a[j]) * b[j];
                        st8(rp + bj * 64, h); }
                }
            }
    }
};
struct EpiMoeDown {
    bf16_t *F0, *F1; const unsigned* list; const float* route;
    __device__ __forceinline__ void operator()(const f32x4 (&acc)[2][2][4][2], const Unit& u, int wr, int wc, int fr, int fq) const {
        const u32x2* lp = (const u32x2*)list + (size_t)u.e * NTOK + u.pm * 256;
#pragma unroll
        for (int ai = 0; ai < 2; ++ai) {
            u32x2 ew[4];
#pragma unroll
            for (int m = 0; m < 4; ++m) { const int r = ai * 128 + wr * 64 + m * 16 + fr; const int rc = r < u.nvalid ? r : u.nvalid - 1; ew[m] = lp[rc]; }
#pragma unroll
            for (int m = 0; m < 4; ++m) {
                const int r = ai * 128 + wr * 64 + m * 16 + fr;
                if (r < u.nvalid) {
                    const unsigned tok = ew[m].x >> 1, kk = ew[m].x & 1u; const float ww = __uint_as_float(ew[m].y);
                    bf16_t* rp = F0 + (size_t)kk * (size_t)(F1 - F0) + (size_t)tok * 1024 + u.pn * 256 + wc * 32 + 8 * fq;
#pragma unroll
                    for (int bj = 0; bj < 2; ++bj) st16(rp + bj * 128, acc[ai][bj][m][0] * ww, acc[ai][bj][m][1] * ww);
                }
            }
            asm volatile("" ::: "memory");
        }
    }
};


__device__ __forceinline__ unsigned cvtpk_s(float lo, float hi) { f32x2_t v = {lo, hi}; bf16x2_t b = __builtin_convertvector(v, bf16x2_t); return __builtin_bit_cast(unsigned, b); }
__device__ __forceinline__ float max3f(float a, float b, float c) { float r; asm("v_max3_f32 %0, %1, %2, %3" : "=v"(r) : "v"(a), "v"(b), "v"(c)); return r; }
__device__ __forceinline__ float max2f(float a, float b) { float r; asm("v_max_f32_e32 %0, %1, %2" : "=v"(r) : "v"(a), "v"(b)); return r; }
__device__ __forceinline__ float mx2(float a, float b) { return __builtin_elementwise_maximum(a, b); }
__device__ __forceinline__ float rowmax32_fast(f32x16& p0, f32x16& p1) {
    float a = mx2(mx2(p0[0], p0[1]), p1[0]), b = mx2(mx2(p0[2], p0[3]), p1[1]); a = mx2(mx2(a, p1[2]), p1[3]);
#pragma unroll
    for (int r = 4; r < 16; r += 4) { a = mx2(mx2(a, p0[r]), p0[r + 1]); b = mx2(mx2(b, p0[r + 2]), p0[r + 3]); a = mx2(mx2(a, p1[r]), p1[r + 1]); b = mx2(mx2(b, p1[r + 2]), p1[r + 3]); }
    const float m = mx2(a, b);
    auto rr = __builtin_amdgcn_permlane32_swap(__float_as_uint(m), __float_as_uint(m), false, false);
    return mx2(__uint_as_float(rr[0]), __uint_as_float(rr[1]));
}
__device__ __forceinline__ bf16x8 pack8(const f32x16& p, const int b) { u32x4 w; w.x = cvtpk_s(p[b], p[b + 1]); w.y = cvtpk_s(p[b + 2], p[b + 3]); w.z = cvtpk_s(p[b + 4], p[b + 5]); w.w = cvtpk_s(p[b + 6], p[b + 7]); return __builtin_bit_cast(bf16x8, w); }
#define VTR_RD(dst, addr, off) asm volatile("ds_read_b64_tr_b16 %0, %1 offset:%c2" : "=&v"(dst) : "v"(addr), "i"(off) : "memory")
#define PV_BLOCK(vb_, db_, BODY) do { s16x4 lo_[4], hi_[4]; \
    _Pragma("unroll") for (int ks = 0; ks < 4; ++ks) { VTR_RD(lo_[ks], vb_, (db_) * 4096 + ks * 1024); VTR_RD(hi_[ks], vb_, (db_) * 4096 + ks * 1024 + 512); } \
    asm volatile("s_waitcnt lgkmcnt(0)" ::: "memory"); __builtin_amdgcn_sched_barrier(0); \
    _Pragma("unroll") for (int ks = 0; ks < 4; ++ks) { const bf16x8 vf = (bf16x8){lo_[ks][0], lo_[ks][1], lo_[ks][2], lo_[ks][3], hi_[ks][0], hi_[ks][1], hi_[ks][2], hi_[ks][3]}; BODY; } } while (0)
namespace attd {
typedef short v4i16_t __attribute__((ext_vector_type(4)));
constexpr float THR = 6.0f;
__device__ __forceinline__ float rowmax32(f32x16& p0, f32x16& p1) { return rowmax32_fast(p0, p1); }
struct Sm { float mhat, l; };
__device__ __forceinline__ void softmax_tile(f32x16& p0, f32x16& p1, Sm& st, f32x16 (&o)[2], const bool first, LAS float* wsf, const int r32, const int hi, bf16x8 (&pa)[4], f32x16& negm) {
    const float rm = rowmax32(p0, p1);
    if (first || __any(rm > THR)) {
        const float dl = first ? rm : fmaxf(rm, 0.f);
        st.mhat += dl;
#pragma unroll
        for (int r = 0; r < 16; ++r) { p0[r] -= dl; p1[r] -= dl; negm[r] = -st.mhat; }
        const float f = fminf(fast_exp2(-dl), 3.0e38f); st.l *= f;
        if (hi == 0) wsf[r32] = f;
        LDS_WAIT();
#pragma unroll
        for (int r = 0; r < 16; ++r) { const float fr_ = wsf[crow(r, hi)]; o[0][r] *= fr_; o[1][r] *= fr_; }
    }
    float s = 0.f;
#pragma unroll
    for (int r = 0; r < 16; ++r) { p0[r] = fast_exp2(p0[r]); p1[r] = fast_exp2(p1[r]); s = (s + p0[r]) + p1[r]; }
    st.l += s;
    pa[0] = pack8(p0, 0); pa[1] = pack8(p0, 8); pa[2] = pack8(p1, 0); pa[3] = pack8(p1, 8);
}
__device__ __forceinline__ void glds16(const bf16_t* src, LAS unsigned char* dst) { __builtin_amdgcn_global_load_lds((const unsigned*)src, (LAS unsigned*)dst, 16, 0, 0); }

#define KRD16(dst, addr, off) asm volatile("ds_read_b128 %0, %1 offset:%c2" : "=&v"(dst) : "v"(addr), "i"(off) : "memory")
#define MFMA_C(D, A, B, C) asm("v_mfma_f32_32x32x16_bf16 %0, %1, %2, %3" : "=&v"(D) : "v"(A), "v"(B), "v"(C))
struct Tens {
    const bf16_t* Q; int qpitch, qcol;
    const bf16_t* K; const bf16_t* KR; const bf16_t* V; int kvcol;
    bf16_t* O; int ocol;
    float lam, onem; const float* dn;
};
template <int MODE>
__device__ __forceinline__ void attn_unit(LAS unsigned char* lds, const Tens& T, const int b, const bool ctxq, const int qb) {
    constexpr int NCH = MODE ? 12 : 8, KSLOT = NCH * 1024, SLOT = KSLOT + 8192, NSLOT = 6;
    constexpr int WS_OFF = NSLOT * SLOT, OST_OFF = 0, QS_OFF = WS_OFF + 8 * 512;
    static_assert((MODE == 1 ? WS_OFF + 8 * 512 : QS_OFF + 8 * 4096) <= RING_BYTES && 8 * 8192 <= WS_OFF, "attention LDS");
    const int tid = otid(), lane = tid & 63, r32 = lane & 31, hi = lane >> 5, wid = __builtin_amdgcn_readfirstlane(tid >> 6);
    const int NT = ctxq ? 4 : 68;
    const int krow_ctx = NLAT + b * CTXL, krow_lat = b * SEQ;
    const int qrow0 = (ctxq ? krow_ctx : krow_lat + qb * 256) + wid * 32;
    LAS float* wsf = (LAS float*)(lds + WS_OFF + wid * 512);
    LAS float* stg = (LAS float*)(lds + OST_OFF + wid * 8192);
    static_assert(MODE == 0, "attd: differential attention only");
    const int kswz = (4 * (wid & 1) + (lane >> 4)) & 7;
#define ATT_ISSUE(t_) do { const int kr_ = ((t_) < 4) ? krow_ctx + 64 * (t_) : krow_lat + 64 * ((t_) - 4); const int so_ = ((t_) % NSLOT) * SLOT; \
        glds16(T.K + (size_t)(kr_ + 8 * wid + (lane >> 3)) * 384 + T.kvcol + (((lane & 7) ^ kswz) << 3), lds + so_ + wid * 1024); \
        glds16(T.V + (size_t)(kr_ + 16 * (wid & 3) + (lane >> 2)) * 384 + T.kvcol + (wid >> 2) * 32 + (lane & 3) * 8, lds + so_ + KSLOT + wid * 1024); } while (0)
    constexpr int NQ = MODE ? 6 : 4;
    bf16x8 qr[NQ];
    { const bf16_t* qp = T.Q + (size_t)(qrow0 + r32) * T.qpitch + T.qcol + hi * 8;
#pragma unroll
      for (int d0 = 0; d0 < NQ; ++d0) { const bf16x8 q = *(const bf16x8*)(qp + d0 * 16); if (MODE == 1) qr[d0] = q; else *(LAS bf16x8*)(lds + QS_OFF + wid * 4096 + d0 * 1024 + lane * 16) = q; } }
    const LAS unsigned char* ql = lds + QS_OFF + wid * 4096 + lane * 16;
    ATT_ISSUE(0); ATT_ISSUE(1); ATT_ISSUE(2); ATT_ISSUE(3);
    Sm st1{0.f, 0.f}, st2{0.f, 0.f};
    f32x16 o1[2], o2[2];
#pragma unroll
    for (int r = 0; r < 16; ++r) { o1[0][r] = 0.f; o1[1][r] = 0.f; o2[0][r] = 0.f; o2[1][r] = 0.f; }
    const int vlane = ((lane >> 4) & 1) * 32 + (lane & 3) * 8 + (4 * hi + ((lane & 15) >> 2)) * 64;
    f32x16 negm1, negm2;
#pragma unroll
    for (int r = 0; r < 16; ++r) { negm1[r] = 0.f; negm2[r] = 0.f; }
    for (int tp = 0; tp < NT; tp += 2) {
        if (tp + 2 < NT) { if (MODE == 1 && wid < 4) asm volatile("s_waitcnt vmcnt(6)" ::: "memory"); else asm volatile("s_waitcnt vmcnt(4)" ::: "memory"); }
        else asm volatile("s_waitcnt vmcnt(0)" ::: "memory");
        LDS_WAIT(); __builtin_amdgcn_s_barrier(); asm volatile("" ::: "memory");
        if (tp + 4 < NT) { ATT_ISSUE(tp + 4); ATT_ISSUE(tp + 5); }
#pragma unroll 1
      for (int t = tp; t < tp + 2; ++t) {
        const int s_cur = (t % NSLOT) * SLOT;
        const unsigned ka0 = (unsigned)(size_t)lds + s_cur + r32 * 128 + (((((r32 >> 1) & 7) ^ hi)) << 4);
        const unsigned vb = (unsigned)(size_t)(lds + s_cur + KSLOT + vlane);
        bf16x8 pa1[4], pa2[4];
        {
            f32x16 p10, p11, p20, p21; s16x4 vlo[4], vhi[4];
            { bf16x8 kf[8], qf[4]; const unsigned qb_ = (unsigned)(size_t)ql;
#pragma unroll
              for (int d0 = 0; d0 < 4; ++d0) { const unsigned kb_ = ka0 ^ (d0 << 5); KRD16(kf[2 * d0], kb_, 0); KRD16(kf[2 * d0 + 1], kb_, 4096); KRD16(qf[d0], qb_, d0 * 1024); }
              asm volatile("s_waitcnt lgkmcnt(6)" ::: "memory"); __builtin_amdgcn_sched_barrier(0);
              MFMA_C(p10, kf[0], qf[0], negm1); MFMA_C(p11, kf[1], qf[0], negm1); p10 = mfma32(kf[2], qf[1], p10); p11 = mfma32(kf[3], qf[1], p11);
              __builtin_amdgcn_sched_barrier(0);
#pragma unroll
              for (int ks = 0; ks < 4; ++ks) { VTR_RD(vlo[ks], vb, ks * 1024); VTR_RD(vhi[ks], vb, ks * 1024 + 512); }
              asm volatile("s_waitcnt lgkmcnt(8)" ::: "memory"); __builtin_amdgcn_sched_barrier(0);
              MFMA_C(p20, kf[4], qf[2], negm2); MFMA_C(p21, kf[5], qf[2], negm2); p20 = mfma32(kf[6], qf[3], p20); p21 = mfma32(kf[7], qf[3], p21);
              asm volatile("s_waitcnt lgkmcnt(0)" ::: "memory"); __builtin_amdgcn_sched_barrier(0); }
            softmax_tile(p10, p11, st1, o1, t == 0, wsf, r32, hi, pa1, negm1);
            softmax_tile(p20, p21, st2, o2, t == 0, wsf + 32, r32, hi, pa2, negm2);
            __builtin_amdgcn_sched_barrier(0);
            { s16x4 wlo[4], whi[4];
#pragma unroll
              for (int ks = 0; ks < 4; ++ks) { VTR_RD(wlo[ks], vb, 4096 + ks * 1024); VTR_RD(whi[ks], vb, 4096 + ks * 1024 + 512); }
#pragma unroll
              for (int ks = 0; ks < 4; ++ks) { const bf16x8 vf = (bf16x8){vlo[ks][0], vlo[ks][1], vlo[ks][2], vlo[ks][3], vhi[ks][0], vhi[ks][1], vhi[ks][2], vhi[ks][3]};
                  o1[0] = mfma32(pa1[ks], vf, o1[0]); o2[0] = mfma32(pa2[ks], vf, o2[0]); }
              asm volatile("s_waitcnt lgkmcnt(0)" ::: "memory"); __builtin_amdgcn_sched_barrier(0);
#pragma unroll
              for (int ks = 0; ks < 4; ++ks) { const bf16x8 vf = (bf16x8){wlo[ks][0], wlo[ks][1], wlo[ks][2], wlo[ks][3], whi[ks][0], whi[ks][1], whi[ks][2], whi[ks][3]};
                  o1[1] = mfma32(pa1[ks], vf, o1[1]); o2[1] = mfma32(pa2[ks], vf, o2[1]); } }
        }
      }
    }
#undef ATT_ISSUE
    LDS_WAIT(); __builtin_amdgcn_s_barrier(); asm volatile("" ::: "memory");
    { const float l1 = st1.l + __shfl_xor(st1.l, 32), l2 = st2.l + __shfl_xor(st2.l, 32);
      if (hi == 0) { wsf[64 + r32] = l1; if (MODE == 0) wsf[96 + r32] = l2; }
      LDS_WAIT();
#pragma unroll
      for (int r = 0; r < 16; ++r) { const int q = crow(r, hi); const float rl1 = fast_rcp(wsf[64 + q]);
          if (MODE == 1) { stg[q * 64 + r32] = o1[0][r] * rl1; stg[q * 64 + 32 + r32] = o1[1][r] * rl1; }
          else { const float rl2 = T.lam * fast_rcp(wsf[96 + q]);
              stg[q * 64 + r32] = o1[0][r] * rl1 - o2[0][r] * rl2; stg[q * 64 + 32 + r32] = o1[1][r] * rl1 - o2[1][r] * rl2; } }
      LDS_WAIT();
      const int ch = lane & 7;
      f32x4 g0 = (f32x4){1.f, 1.f, 1.f, 1.f}, g1 = g0;
      if (MODE == 0) { g0 = *(const f32x4*)(T.dn + ch * 8) * T.onem; g1 = *(const f32x4*)(T.dn + ch * 8 + 4) * T.onem; }
#pragma unroll
      for (int i = 0; i < 4; ++i) { const int row = i * 8 + (lane >> 3);
          f32x4 a = *(const LAS f32x4*)(stg + row * 64 + ch * 8), c = *(const LAS f32x4*)(stg + row * 64 + ch * 8 + 4);
          if (MODE == 0) { float ss = (a[0] * a[0] + a[1] * a[1]) + (a[2] * a[2] + a[3] * a[3]) + (c[0] * c[0] + c[1] * c[1]) + (c[2] * c[2] + c[3] * c[3]);
              ss += __shfl_xor(ss, 1); ss += __shfl_xor(ss, 2); ss += __shfl_xor(ss, 4);
              const float rstd = rsqrtf(ss * (1.0f / 64.0f) + RMS_EPS); a = a * rstd * g0; c = c * rstd * g1; }
          st16(T.O + (size_t)(qrow0 + row) * 1024 + T.ocol + ch * 8, a, c); } }
    LDS_WAIT(); __builtin_amdgcn_s_barrier(); asm volatile("" ::: "memory");
}
}

namespace atts {
constexpr float THR = 6.0f;
#define SB0() __builtin_amdgcn_sched_barrier(0)
struct Sm { float mhat, l; };
__device__ __forceinline__ void exp_pack(f32x16& p0, f32x16& p1, Sm& st, bf16x8 (&pa)[4]) {
    float s = 0.f;
#pragma unroll
    for (int r = 0; r < 16; ++r) { p0[r] = fast_exp2(p0[r]); p1[r] = fast_exp2(p1[r]); s = (s + p0[r]) + p1[r]; }
    st.l += s;
    pa[0] = pack8(p0, 0); pa[1] = pack8(p0, 8); pa[2] = pack8(p1, 0); pa[3] = pack8(p1, 8);
}
__device__ __forceinline__ void exp_head(f32x16& p0, float& s) {
#pragma unroll
    for (int r = 0; r < 8; ++r) { p0[r] = fast_exp2(p0[r]); s += p0[r]; }
}
__device__ __forceinline__ void exp_tail(f32x16& p0, f32x16& p1, float& s, Sm& st, bf16x8 (&pa)[4]) {
#pragma unroll
    for (int r = 8; r < 16; ++r) { p0[r] = fast_exp2(p0[r]); s += p0[r]; }
#pragma unroll
    for (int r = 0; r < 16; ++r) { p1[r] = fast_exp2(p1[r]); s += p1[r]; }
    st.l += s;
    pa[0] = pack8(p0, 0); pa[1] = pack8(p0, 8); pa[2] = pack8(p1, 0); pa[3] = pack8(p1, 8);
}
__device__ __forceinline__ void rescale(f32x16& p0, f32x16& p1, Sm& st, f32x16 (&o)[2], const float rm, LAS float* wsf, const int r32, const int hi, f32x16& negm) {
    if (__any(rm > THR)) {
        const float dl = fmaxf(rm, 0.f);
        st.mhat += dl;
#pragma unroll
        for (int r = 0; r < 16; ++r) negm[r] = -st.mhat;
#pragma unroll
        for (int r = 0; r < 16; ++r) { p0[r] -= dl; p1[r] -= dl; }
        const float f = fast_exp2(-dl); st.l *= f;
        if (hi == 0) wsf[r32] = f;
        LDS_WAIT();
#pragma unroll
        for (int r = 0; r < 16; ++r) { const float fr_ = wsf[crow(r, hi)]; o[0][r] *= fr_; o[1][r] *= fr_; }
    }
}
__device__ __forceinline__ void glds16(const bf16_t* src, LAS unsigned char* dst) { __builtin_amdgcn_global_load_lds((const unsigned*)src, (LAS unsigned*)dst, 16, 0, 0); }
#ifndef KRD16
#define KRD16(dst, addr, off) asm volatile("ds_read_b128 %0, %1 offset:%c2" : "=&v"(dst) : "v"(addr), "i"(off) : "memory")
#endif
struct Src {
    const bf16_t* Q; int qpitch, qcol;
    const bf16_t* K; int kcol;
    const bf16_t* KR;
    const bf16_t* V; int vcol;
};
template <int KIND>
__device__ __forceinline__ void attn_pass(LAS unsigned char* lds, const Src& T, const int b, const bool ctxq, const int qb, f32x16 (&o1)[2], Sm& st1) {
    constexpr int NCH = KIND ? 12 : 4, NKW = KIND ? 8 : 4, ND = KIND ? 6 : 2, KSLOT = NCH * 1024, SLOT = KSLOT + 8192, NSLOT = 4;
    constexpr int WS_OFF = 90112;
    static_assert(NSLOT * SLOT <= WS_OFF && WS_OFF + 8 * 512 <= RING_BYTES, "attention LDS");
    const int tid = otid(), lane = tid & 63, r32 = lane & 31, hi = lane >> 5, wid = __builtin_amdgcn_readfirstlane(tid >> 6);
    const int NT = ctxq ? 4 : 68;
    const int krow_ctx = NLAT + b * CTXL, krow_lat = b * SEQ;
    const int qrow0 = (ctxq ? krow_ctx : krow_lat + qb * 256) + wid * 32;
    LAS float* wsf = (LAS float*)(lds + WS_OFF + wid * 512);
#define ATT_ISSUE(t_) do { const int kr_ = ((t_) < 4) ? krow_ctx + 64 * (t_) : krow_lat + 64 * ((t_) - 4); const int so_ = ((t_) & 3) * SLOT; \
        if (wid < NKW) glds16(T.K + (size_t)(kr_ + lane) * 384 + T.kcol + wid * 8, lds + so_ + wid * 1024); \
        if (KIND == 1 && wid < 4) glds16(T.KR + (size_t)(kr_ + lane) * 32 + wid * 8, lds + so_ + (8 + wid) * 1024); \
        glds16(T.V + (size_t)(kr_ + 16 * (wid & 3) + (lane >> 2)) * 384 + T.vcol + (wid >> 2) * 32 + (lane & 3) * 8, lds + so_ + KSLOT + wid * 1024); } while (0)
#define ATT_WAITN(n) do { const int np_ = (KIND == 1) ? (wid < 4 ? 3 : 2) : (wid < 4 ? 2 : 1); \
        if ((n) == 0) asm volatile("s_waitcnt vmcnt(0)" ::: "memory"); \
        else if (np_ * (n) == 1) asm volatile("s_waitcnt vmcnt(1)" ::: "memory"); else if (np_ * (n) == 2) asm volatile("s_waitcnt vmcnt(2)" ::: "memory"); \
        else if (np_ * (n) == 3) asm volatile("s_waitcnt vmcnt(3)" ::: "memory"); else if (np_ * (n) == 4) asm volatile("s_waitcnt vmcnt(4)" ::: "memory"); \
        else asm volatile("s_waitcnt vmcnt(6)" ::: "memory"); } while (0)
#define ATT_BAR() do { LDS_WAIT(); __builtin_amdgcn_s_barrier(); asm volatile("" ::: "memory"); } while (0)
    bf16x8 qr[ND];
    { const bf16_t* qp = T.Q + (size_t)(qrow0 + r32) * T.qpitch + T.qcol + hi * 8;
#pragma unroll
      for (int d0 = 0; d0 < ND; ++d0) qr[d0] = *(const bf16x8*)(qp + d0 * 16); }
    ATT_ISSUE(0); ATT_ISSUE(1); ATT_ISSUE(2);
    st1.mhat = 0.f; st1.l = 0.f;
#pragma unroll
    for (int r = 0; r < 16; ++r) { o1[0][r] = 0.f; o1[1][r] = 0.f; }
    const unsigned klane = (unsigned)(size_t)lds + hi * 1024 + r32 * 16;
    const unsigned vlane = (unsigned)(size_t)lds + KSLOT + ((lane >> 4) & 1) * 32 + (lane & 3) * 8 + (4 * hi + ((lane & 15) >> 2)) * 64;
    f32x16 a0, a1, n0, n1, negm1;
#define ATT_KRD(t_, kf) do { const unsigned kb_ = klane + ((t_) & 3) * SLOT; \
        _Pragma("unroll") for (int d = 0; d < ND; ++d) { KRD16(kf[2 * d], kb_, d * 2048); KRD16(kf[2 * d + 1], kb_, d * 2048 + 512); } } while (0)
#define ATT_MM(kf, P0, P1) do { asm volatile("s_waitcnt lgkmcnt(0)" ::: "memory"); SB0(); \
        P0 = mfma32(kf[0], qr[0], negm1); P1 = mfma32(kf[1], qr[0], negm1); \
        _Pragma("unroll") for (int d = 1; d < ND; ++d) { P0 = mfma32(kf[2 * d], qr[d], P0); P1 = mfma32(kf[2 * d + 1], qr[d], P1); } } while (0)
#define ATT_QK(t_, P0, P1) do { bf16x8 kf_[2 * ND]; ATT_KRD(t_, kf_); ATT_MM(kf_, P0, P1); } while (0)
#pragma unroll
    for (int r = 0; r < 16; ++r) negm1[r] = 0.f;
    ATT_WAITN(2); ATT_BAR();
    ATT_QK(0, a0, a1);
    { const float rm = rowmax32_fast(a0, a1); st1.mhat = rm;
#pragma unroll
      for (int r = 0; r < 16; ++r) { a0[r] -= rm; a1[r] -= rm; negm1[r] = -rm; } }
#define ATT_STEP(t_, A0, A1, N0, N1) do { const int tt = (t_); \
        if (tt + 2 < NT) ATT_WAITN(1); else ATT_WAITN(0); \
        ATT_BAR();                                                  \
        if (tt + 3 < NT) ATT_ISSUE(tt + 3); \
        const unsigned vb_ = vlane + (tt & 3) * SLOT; \
        bf16x8 pa1[4]; bf16x8 kf_[2 * ND]; float es_ = 0.f; \
        ATT_KRD(tt + 1, kf_); SB0(); \
        exp_head(A0, es_); SB0();                                    \
        ATT_MM(kf_, N0, N1); \
        exp_tail(A0, A1, es_, st1, pa1); \
        _Pragma("unroll") for (int sg = 0; sg < 2 * ND; ++sg) { __builtin_amdgcn_sched_group_barrier(0x8, 1, 0); __builtin_amdgcn_sched_group_barrier(0x2, KIND ? 6 : 16, 0); } \
        SB0(); \
        PV_BLOCK(vb_, 0, o1[0] = mfma32(pa1[ks], vf, o1[0])); PV_BLOCK(vb_, 1, o1[1] = mfma32(pa1[ks], vf, o1[1])); \
        const float rm1 = rowmax32_fast(N0, N1);                    \
        _Pragma("unroll") for (int sg = 0; sg < 4; ++sg) { __builtin_amdgcn_sched_group_barrier(0x8, 1, 0); __builtin_amdgcn_sched_group_barrier(0x2, 5, 0); } \
        SB0(); \
        rescale(N0, N1, st1, o1, rm1, wsf, r32, hi, negm1); } while (0)
    for (int t = 0; t < NT - 2; t += 2) {
        ATT_STEP(t, a0, a1, n0, n1);
        ATT_STEP(t + 1, n0, n1, a0, a1);
    }
    ATT_STEP(NT - 2, a0, a1, n0, n1);
    { bf16x8 pa1[4]; const unsigned vb_ = vlane + ((NT - 1) & 3) * SLOT;
      exp_pack(n0, n1, st1, pa1);
      PV_BLOCK(vb_, 0, o1[0] = mfma32(pa1[ks], vf, o1[0])); PV_BLOCK(vb_, 1, o1[1] = mfma32(pa1[ks], vf, o1[1])); }
    ATT_BAR();
#undef ATT_STEP
#undef ATT_QK
#undef ATT_ISSUE
#undef ATT_WAITN
}
template <bool DIFF>
__device__ __forceinline__ void attn_store(LAS unsigned char* lds, const f32x16 (&o1)[2], const Sm& st1, const f32x16 (&o2)[2], const Sm& st2, const float lam, const float onem, const float* dn,
        bf16_t* O, const int ocol, const int b, const bool ctxq, const int qb) {
    const int tid = otid(), lane = tid & 63, r32 = lane & 31, hi = lane >> 5, wid = __builtin_amdgcn_readfirstlane(tid >> 6);
    const int qrow0 = (ctxq ? NLAT + b * CTXL : b * SEQ + qb * 256) + wid * 32;
    LAS float* wsf = (LAS float*)(lds + 90112 + wid * 512);
    LAS float* stg = (LAS float*)(lds + wid * 8192);
    const float l1 = st1.l + __shfl_xor(st1.l, 32), l2 = DIFF ? st2.l + __shfl_xor(st2.l, 32) : 1.f;
    if (hi == 0) { wsf[64 + r32] = l1; if (DIFF) wsf[96 + r32] = l2; }
    LDS_WAIT();
#pragma unroll
    for (int r = 0; r < 16; ++r) { const int q = crow(r, hi); const float rl1 = fast_rcp(wsf[64 + q]);
        if (!DIFF) { stg[q * 64 + r32] = o1[0][r] * rl1; stg[q * 64 + 32 + r32] = o1[1][r] * rl1; }
        else { const float rl2 = lam * fast_rcp(wsf[96 + q]);
            stg[q * 64 + r32] = o1[0][r] * rl1 - o2[0][r] * rl2; stg[q * 64 + 32 + r32] = o1[1][r] * rl1 - o2[1][r] * rl2; } }
    LDS_WAIT();
    const int ch = lane & 7;
    f32x4 g0 = (f32x4){1.f, 1.f, 1.f, 1.f}, g1 = g0;
    if (DIFF) { g0 = *(const f32x4*)(dn + ch * 8) * onem; g1 = *(const f32x4*)(dn + ch * 8 + 4) * onem; }
#pragma unroll
    for (int i = 0; i < 4; ++i) { const int row = i * 8 + (lane >> 3);
        f32x4 a = *(const LAS f32x4*)(stg + row * 64 + ch * 8), c = *(const LAS f32x4*)(stg + row * 64 + ch * 8 + 4);
        if (DIFF) { float ss = (a[0] * a[0] + a[1] * a[1]) + (a[2] * a[2] + a[3] * a[3]) + (c[0] * c[0] + c[1] * c[1]) + (c[2] * c[2] + c[3] * c[3]);
            ss += __shfl_xor(ss, 1); ss += __shfl_xor(ss, 2); ss += __shfl_xor(ss, 4);
            const float rstd = rsqrtf(ss * (1.0f / 64.0f) + RMS_EPS); a = a * rstd * g0; c = c * rstd * g1; }
        st16(O + (size_t)(qrow0 + row) * 1024 + ocol + ch * 8, a, c); }
    LDS_WAIT(); __builtin_amdgcn_s_barrier(); asm volatile("" ::: "memory");
}
#undef ATT_BAR
#undef SB0
}

namespace attp {
typedef short v4i16_t __attribute__((ext_vector_type(4)));
constexpr float THR = 6.0f;
#define SB0() __builtin_amdgcn_sched_barrier(0)
__device__ __forceinline__ float rowmax32(f32x16& p0, f32x16& p1) { return rowmax32_fast(p0, p1); }
struct Sm { float mhat, l; };
__device__ __forceinline__ void exp_pack(f32x16& p0, f32x16& p1, Sm& st, bf16x8 (&pa)[4]) {
    float s = 0.f;
#pragma unroll
    for (int r = 0; r < 16; ++r) { p0[r] = fast_exp2(p0[r]); p1[r] = fast_exp2(p1[r]); s = (s + p0[r]) + p1[r]; }
    st.l += s;
    pa[0] = pack8(p0, 0); pa[1] = pack8(p0, 8); pa[2] = pack8(p1, 0); pa[3] = pack8(p1, 8);
}
__device__ __forceinline__ void rescale(f32x16& p0, f32x16& p1, Sm& st, f32x16 (&o)[2], const float rm, LAS float* wsf, const int r32, const int hi, f32x16& negm) {
    if (__any(rm > THR)) {
        const float dl = fmaxf(rm, 0.f);
        st.mhat += dl;
#pragma unroll
        for (int r = 0; r < 16; ++r) negm[r] = -st.mhat;
#pragma unroll
        for (int r = 0; r < 16; ++r) { p0[r] -= dl; p1[r] -= dl; }
        const float f = fast_exp2(-dl); st.l *= f;
        if (hi == 0) wsf[r32] = f;
        LDS_WAIT();
#pragma unroll
        for (int r = 0; r < 16; ++r) { const float fr_ = wsf[crow(r, hi)]; o[0][r] *= fr_; o[1][r] *= fr_; }
    }
}
__device__ __forceinline__ void glds16(const bf16_t* src, LAS unsigned char* dst) { __builtin_amdgcn_global_load_lds((const unsigned*)src, (LAS unsigned*)dst, 16, 0, 0); }

#define KRD16(dst, addr, off) asm volatile("ds_read_b128 %0, %1 offset:%c2" : "=&v"(dst) : "v"(addr), "i"(off) : "memory")
struct Tens {
    const bf16_t* Q; int qpitch, qcol;
    const bf16_t* K; const bf16_t* KR; const bf16_t* V; int kvcol;
    bf16_t* O; int ocol;
    float lam, onem; const float* dn;
};
template <int D0, int ND>
__device__ __forceinline__ void qk_tile(f32x16& p0, f32x16& p1, const LAS unsigned char* kp, const bf16x8* qr, const float mhat) {
    f32x16 c;
#pragma unroll
    for (int r = 0; r < 16; ++r) c[r] = -mhat;
#pragma unroll
    for (int d = 0; d < ND; ++d) { const bf16x8 k0 = *(const LAS bf16x8*)(kp + (D0 + d) * 2048), k1 = *(const LAS bf16x8*)(kp + (D0 + d) * 2048 + 512);
        if (d == 0) { p0 = mfma32(k0, qr[D0], c); p1 = mfma32(k1, qr[D0], c); } else { p0 = mfma32(k0, qr[D0 + d], p0); p1 = mfma32(k1, qr[D0 + d], p1); } }
}
template <int D0, int ND>
__device__ __forceinline__ void qk_tile_l(f32x16& p0, f32x16& p1, const LAS unsigned char* kp, const LAS unsigned char* ql, const float mhat) {
#pragma unroll
    for (int r = 0; r < 16; ++r) { p0[r] = -mhat; p1[r] = -mhat; }
#pragma unroll
    for (int d = 0; d < ND; ++d) { const bf16x8 k0 = *(const LAS bf16x8*)(kp + (D0 + d) * 2048), k1 = *(const LAS bf16x8*)(kp + (D0 + d) * 2048 + 512);
        const bf16x8 q = *(const LAS bf16x8*)(ql + (D0 + d) * 1024);
        p0 = mfma32(k0, q, p0); p1 = mfma32(k1, q, p1); }
}
template <int MODE>
__device__ __forceinline__ void attn_unit(LAS unsigned char* lds, const Tens& T, const int b, const bool ctxq, const int qb) {
    constexpr int NCH = MODE ? 12 : 8, KSLOT = NCH * 1024, SLOT = KSLOT + 8192, NSLOT = 4;
    constexpr int WS_OFF = NSLOT * SLOT, OST_OFF = 0, QS_OFF = WS_OFF + 8 * 512;
    static_assert(QS_OFF + 8 * 4096 <= RING_BYTES && 8 * 8192 <= WS_OFF, "attention LDS");
    const int tid = otid(), lane = tid & 63, r32 = lane & 31, hi = lane >> 5, wid = __builtin_amdgcn_readfirstlane(tid >> 6);
    const int NT = ctxq ? 4 : 68;
    const int krow_ctx = NLAT + b * CTXL, krow_lat = b * SEQ;
    const int qrow0 = (ctxq ? krow_ctx : krow_lat + qb * 256) + wid * 32;
    LAS float* wsf = (LAS float*)(lds + WS_OFF + wid * 512);
    LAS float* stg = (LAS float*)(lds + OST_OFF + wid * 8192);
#define ATT_ISSUE(t_) do { const int kr_ = ((t_) < 4) ? krow_ctx + 64 * (t_) : krow_lat + 64 * ((t_) - 4); const int so_ = ((t_) & 3) * SLOT; \
        glds16(T.K + (size_t)(kr_ + lane) * 384 + T.kvcol + wid * 8, lds + so_ + wid * 1024); \
        if (MODE == 1 && wid < 4) glds16(T.KR + (size_t)(kr_ + lane) * 32 + wid * 8, lds + so_ + (8 + wid) * 1024); \
        glds16(T.V + (size_t)(kr_ + 16 * (wid & 3) + (lane >> 2)) * 384 + T.kvcol + (wid >> 2) * 32 + (lane & 3) * 8, lds + so_ + KSLOT + wid * 1024); } while (0)
#define ATT_WAIT(n2, n3) do { if (MODE == 1 && wid < 4) asm volatile("s_waitcnt vmcnt(" #n3 ")" ::: "memory"); else asm volatile("s_waitcnt vmcnt(" #n2 ")" ::: "memory"); } while (0)
#define ATT_BAR() do { LDS_WAIT(); __builtin_amdgcn_s_barrier(); asm volatile("" ::: "memory"); } while (0)
    constexpr int NQ = MODE ? 6 : 4;
    bf16x8 qr[NQ];
    const LAS unsigned char* ql = lds + QS_OFF + wid * 4096 + lane * 16;
    { const bf16_t* qp = T.Q + (size_t)(qrow0 + r32) * T.qpitch + T.qcol + hi * 8;
#pragma unroll
      for (int d0 = 0; d0 < NQ; ++d0) { const bf16x8 q = *(const bf16x8*)(qp + d0 * 16); if (MODE == 1) qr[d0] = q; else *(LAS bf16x8*)(lds + QS_OFF + wid * 4096 + d0 * 1024 + lane * 16) = q; } }
    ATT_ISSUE(0); ATT_ISSUE(1); ATT_ISSUE(2);
    Sm st1{0.f, 0.f}, st2{0.f, 0.f};
    f32x16 o1[2], o2[2];
#pragma unroll
    for (int r = 0; r < 16; ++r) { o1[0][r] = 0.f; o1[1][r] = 0.f; o2[0][r] = 0.f; o2[1][r] = 0.f; }
    const int klane = hi * 1024 + r32 * 16;
    const int vlane = KSLOT + ((lane >> 4) & 1) * 32 + (lane & 3) * 8 + (4 * hi + ((lane & 15) >> 2)) * 64;
    f32x16 a0, a1, c0, c1;
    ATT_WAIT(4, 6); ATT_BAR();
    { const LAS unsigned char* kp = lds + klane;
      if (MODE == 1) { qk_tile<0, 6>(a0, a1, kp, qr, 0.f); }
      else { qk_tile_l<0, 2>(a0, a1, kp, ql, 0.f); qk_tile_l<2, 2>(c0, c1, kp, ql, 0.f); }
      { const float rm = rowmax32(a0, a1); st1.mhat = rm;
#pragma unroll
        for (int r = 0; r < 16; ++r) { a0[r] -= rm; a1[r] -= rm; } }
      if (MODE == 0) { const float rm = rowmax32(c0, c1); st2.mhat = rm;
#pragma unroll
        for (int r = 0; r < 16; ++r) { c0[r] -= rm; c1[r] -= rm; } } }
    f32x16 n0, n1, m0, m1;
    f32x16 negm1, negm2;
#pragma unroll
    for (int r = 0; r < 16; ++r) { negm1[r] = -st1.mhat; negm2[r] = -st2.mhat; }
#define ATT_PV1(vb_) do { PV_BLOCK(vb_, 0, o1[0] = mfma32(pa1[ks], vf, o1[0])); PV_BLOCK(vb_, 1, o1[1] = mfma32(pa1[ks], vf, o1[1])); } while (0)
#define ATT_PV2(vb_) do { PV_BLOCK(vb_, 0, o1[0] = mfma32(pa1[ks], vf, o1[0]); o2[0] = mfma32(pa2[ks], vf, o2[0])); PV_BLOCK(vb_, 1, o1[1] = mfma32(pa1[ks], vf, o1[1]); o2[1] = mfma32(pa2[ks], vf, o2[1])); } while (0)
#define ATT_STEP(t_, A0, A1, C0, C1, N0, N1, M0, M1) do { const int tt = (t_); \
        if (tt + 2 < NT) ATT_WAIT(2, 3); else asm volatile("s_waitcnt vmcnt(0)" ::: "memory"); \
        ATT_BAR();                                                  \
        if (tt + 3 < NT) ATT_ISSUE(tt + 3); \
        const LAS unsigned char* kpn = lds + ((tt + 1) & 3) * SLOT + klane; \
        const unsigned vp = (unsigned)(size_t)(lds + (tt & 3) * SLOT + vlane); \
        bf16x8 pa1[4], pa2[4]; \
        if (MODE == 1) { \
            { const unsigned kb_ = (unsigned)(size_t)kpn; bf16x8 kf[12]; \
              _Pragma("unroll") for (int d = 0; d < 6; ++d) { KRD16(kf[2 * d], kb_, d * 2048); KRD16(kf[2 * d + 1], kb_, d * 2048 + 512); } \
              asm volatile("s_waitcnt lgkmcnt(0)" ::: "memory"); SB0(); \
              N0 = mfma32(kf[0], qr[0], negm1); N1 = mfma32(kf[1], qr[0], negm1); \
              _Pragma("unroll") for (int d = 1; d < 6; ++d) { N0 = mfma32(kf[2 * d], qr[d], N0); N1 = mfma32(kf[2 * d + 1], qr[d], N1); } } \
            exp_pack(A0, A1, st1, pa1); \
            _Pragma("unroll") for (int sg = 0; sg < 12; ++sg) { __builtin_amdgcn_sched_group_barrier(0x8, 1, 0); __builtin_amdgcn_sched_group_barrier(0x2, 7, 0); } \
            SB0(); \
            const float rm1 = rowmax32(N0, N1); \
            ATT_PV1(vp); \
            SB0(); \
            rescale(N0, N1, st1, o1, rm1, wsf, r32, hi, negm1); \
        } else { \
            qk_tile_l<0, 2>(N0, N1, kpn, ql, st1.mhat); \
            exp_pack(A0, A1, st1, pa1); \
            SB0(); \
            qk_tile_l<2, 2>(M0, M1, kpn, ql, st2.mhat); \
            exp_pack(C0, C1, st2, pa2); \
            SB0(); \
            const float rm1 = rowmax32(N0, N1), rm2 = rowmax32(M0, M1); \
            ATT_PV2(vp); \
            SB0(); \
            rescale(N0, N1, st1, o1, rm1, wsf, r32, hi, negm1); rescale(M0, M1, st2, o2, rm2, wsf + 32, r32, hi, negm2); \
        } } while (0)
    for (int t = 0; t < NT - 2; t += 2) {
        ATT_STEP(t, a0, a1, c0, c1, n0, n1, m0, m1);
        ATT_STEP(t + 1, n0, n1, m0, m1, a0, a1, c0, c1);
    }
    ATT_STEP(NT - 2, a0, a1, c0, c1, n0, n1, m0, m1);
    { bf16x8 pa1[4], pa2[4]; const unsigned vp = (unsigned)(size_t)(lds + ((NT - 1) & 3) * SLOT + vlane);
      exp_pack(n0, n1, st1, pa1);
      if (MODE == 1) { ATT_PV1(vp); } else { exp_pack(m0, m1, st2, pa2); ATT_PV2(vp); } }
#undef ATT_PV1
#undef ATT_PV2
#undef ATT_STEP
#undef ATT_ISSUE
#undef ATT_WAIT
    ATT_BAR();
    { const float l1 = st1.l + __shfl_xor(st1.l, 32), l2 = st2.l + __shfl_xor(st2.l, 32);
      if (hi == 0) { wsf[64 + r32] = l1; if (MODE == 0) wsf[96 + r32] = l2; }
      LDS_WAIT();
#pragma unroll
      for (int r = 0; r < 16; ++r) { const int q = crow(r, hi); const float rl1 = fast_rcp(wsf[64 + q]);
          if (MODE == 1) { stg[q * 64 + r32] = o1[0][r] * rl1; stg[q * 64 + 32 + r32] = o1[1][r] * rl1; }
          else { const float rl2 = T.lam * fast_rcp(wsf[96 + q]);
              stg[q * 64 + r32] = o1[0][r] * rl1 - o2[0][r] * rl2; stg[q * 64 + 32 + r32] = o1[1][r] * rl1 - o2[1][r] * rl2; } }
      LDS_WAIT();
      const int ch = lane & 7;
      f32x4 g0 = (f32x4){1.f, 1.f, 1.f, 1.f}, g1 = g0;
      if (MODE == 0) { g0 = *(const f32x4*)(T.dn + ch * 8) * T.onem; g1 = *(const f32x4*)(T.dn + ch * 8 + 4) * T.onem; }
#pragma unroll
      for (int i = 0; i < 4; ++i) { const int row = i * 8 + (lane >> 3);
          f32x4 a = *(const LAS f32x4*)(stg + row * 64 + ch * 8), c = *(const LAS f32x4*)(stg + row * 64 + ch * 8 + 4);
          if (MODE == 0) { float ss = (a[0] * a[0] + a[1] * a[1]) + (a[2] * a[2] + a[3] * a[3]) + (c[0] * c[0] + c[1] * c[1]) + (c[2] * c[2] + c[3] * c[3]);
              ss += __shfl_xor(ss, 1); ss += __shfl_xor(ss, 2); ss += __shfl_xor(ss, 4);
              const float rstd = rsqrtf(ss * (1.0f / 64.0f) + RMS_EPS); a = a * rstd * g0; c = c * rstd * g1; }
          st16(T.O + (size_t)(qrow0 + row) * 1024 + T.ocol + ch * 8, a, c); } }
    ATT_BAR();
#undef ATT_BAR
#undef SB0
}
}

namespace lru {
constexpr int YP = 264;
constexpr int YBUF = 32 * YP * 2;
struct WaveCtx { bf16x8 wf[2][2][4]; float ba[2], bi[2], c8[2]; float cw[4], cb; };

__device__ __forceinline__ void load_ctx(WaveCtx& W, const int l, const bf16_t* WG, const float* conv_w, const float* conv_b, const float* lba, const float* lbi, const float* llam) {
    const int tid = otid(), lane = tid & 63, r32 = lane & 31, hi = lane >> 5, wid = __builtin_amdgcn_readfirstlane(tid >> 6);
    const int hb = wid & 3, half = wid >> 2, c2 = 64 * hb + 32 * half + r32;
#pragma unroll
    for (int d = 0; d < 2; ++d)
#pragma unroll
        for (int gt = 0; gt < 2; ++gt)
#pragma unroll
            for (int ks = 0; ks < 4; ++ks)
                W.wf[d][gt][ks] = *(const bf16x8*)(WG + ((size_t)(l * 1024 + hb * 256 + d * 128 + gt * 64 + 32 * half + r32)) * 64 + 16 * ks + 8 * hi);
#pragma unroll
    for (int d = 0; d < 2; ++d) { W.ba[d] = lba[(l * 2 + d) * 256 + c2]; W.bi[d] = lbi[(l * 2 + d) * 256 + c2];
        const float lam = llam[(l * 2 + d) * 256 + c2]; W.c8[d] = -8.0f * LOG2E * log1pf(expf(-lam)); }
    const int c = tid & 255;
#pragma unroll
    for (int k = 0; k < 4; ++k) W.cw[k] = conv_w[(l * 4 + k) * 256 + c];
    W.cb = conv_b[l * 256 + c];
}

struct ChunkPos { int seqbase, seqlen, tl0; };
__device__ __forceinline__ ChunkPos chunk_pos(const int cid) { ChunkPos p;
    if (cid < NCHUNK_LAT) { p.seqbase = (cid >> 7) * SEQ; p.seqlen = SEQ; p.tl0 = (cid & 127) * 32; }
    else { const int cc = cid - NCHUNK_LAT; p.seqbase = NLAT + (cc >> 3) * CTXL; p.seqlen = CTXL; p.tl0 = (cc & 7) * 32; }
    return p; }
__device__ __forceinline__ void conv_load(unsigned (&xr)[19], const int cid, const bf16_t* XL, const int tid) {
    const ChunkPos p = chunk_pos(cid); const int c = tid & 255, th = tid >> 8;
#pragma unroll
    for (int k = 0; k < 19; ++k) { int tl = p.tl0 + th * 16 - 2 + k; tl = tl < 0 ? 0 : (tl >= p.seqlen ? p.seqlen - 1 : tl); xr[k] = XL[(size_t)(p.seqbase + tl) * 256 + c]; }
}
__device__ __forceinline__ void conv_store(const unsigned (&xr)[19], const int cid, const WaveCtx& W, LAS bf16_t* Y, const int tid) {
    const ChunkPos p = chunk_pos(cid); const int c = tid & 255, th = tid >> 8; float xv[19];
#pragma unroll
    for (int k = 0; k < 19; ++k) { const int tl = p.tl0 + th * 16 - 2 + k; xv[k] = (tl >= 0 && tl < p.seqlen) ? bf2f(xr[k]) : 0.f; }
#pragma unroll
    for (int i = 0; i < 16; ++i) { const float y = W.cb + W.cw[0] * xv[i] + W.cw[1] * xv[i + 1] + W.cw[2] * xv[i + 2] + W.cw[3] * xv[i + 3]; Y[(th * 16 + i) * YP + c] = (bf16_t)f2bf(y); }
}
template <bool FINAL>
__device__ __forceinline__ void chunk(LAS unsigned char* ybuf, LAS unsigned char* ynbuf, const WaveCtx& W, const int cid, const int ncid, const bf16_t* XL, const bf16_t* GG, float* LSUM, const float* LCAR, bf16_t* MIX) {
    const int tid = otid(), lane = tid & 63, r32 = lane & 31, hi = lane >> 5, wid = __builtin_amdgcn_readfirstlane(tid >> 6);
    const int hb = wid & 3, half = wid >> 2, c2 = 64 * hb + 32 * half + r32;
    const ChunkPos p = chunk_pos(cid); const int seqbase = p.seqbase, tl0 = p.tl0;
    LAS bf16_t* Y = (LAS bf16_t*)ybuf;
    float hc[2] = {0.f, 0.f}; unsigned gr[16];
    if (FINAL) { hc[0] = LCAR[((size_t)cid * 2 + 0) * 256 + c2]; hc[1] = LCAR[((size_t)cid * 2 + 1) * 256 + c2];
#pragma unroll
        for (int r = 0; r < 16; ++r) gr[r] = GG[(size_t)(seqbase + tl0 + crow(r, hi)) * 256 + c2]; }
    unsigned xr[19];
    conv_load(xr, ncid >= 0 ? ncid : cid, XL, tid);
    float yv[16], hsum[16];
#pragma unroll
    for (int r = 0; r < 16; ++r) { yv[r] = bf2f(Y[crow(r, hi) * YP + c2]); hsum[r] = 0.f; }
#pragma unroll
    for (int d = 0; d < 2; ++d) {
        f32x16 acc[2];
#pragma unroll
        for (int r = 0; r < 16; ++r) { acc[0][r] = 0.f; acc[1][r] = 0.f; }
#pragma unroll
        for (int ks = 0; ks < 4; ++ks) { const bf16x8 a = *(const LAS bf16x8*)(Y + r32 * YP + 64 * hb + 16 * ks + 8 * hi);
            acc[0] = mfma32(a, W.wf[d][0][ks], acc[0]); acc[1] = mfma32(a, W.wf[d][1][ks], acc[1]); }
        float ca[16], hl[16];
#pragma unroll
        for (int r = 0; r < 16; ++r) { const float rg = sigmoidf_(acc[0][r] + W.ba[d]), ig = sigmoidf_(acc[1][r] + W.bi[d]);
            const float a = fast_exp2(W.c8[d] * rg); ca[r] = a; hl[r] = __builtin_amdgcn_sqrtf(fmaxf(1.0f - a * a, 0.f)) * (ig * yv[r]); }
        float sA[4], sH[4];
        if (d == 0) {
#pragma unroll
            for (int q = 0; q < 4; ++q) {
#pragma unroll
                for (int j = 1; j < 4; ++j) { hl[4 * q + j] = ca[4 * q + j] * hl[4 * q + j - 1] + hl[4 * q + j]; ca[4 * q + j] = ca[4 * q + j] * ca[4 * q + j - 1]; }
                sA[q] = ca[4 * q + 3]; sH[q] = hl[4 * q + 3]; }
        } else {
#pragma unroll
            for (int q = 0; q < 4; ++q) {
#pragma unroll
                for (int j = 2; j >= 0; --j) { hl[4 * q + j] = ca[4 * q + j] * hl[4 * q + j + 1] + hl[4 * q + j]; ca[4 * q + j] = ca[4 * q + j] * ca[4 * q + j + 1]; }
                sA[q] = ca[4 * q]; sH[q] = hl[4 * q]; }
        }
        float h = FINAL ? hc[d] : 0.f;
        float hbef[4];
        if (d == 0) {
#pragma unroll
            for (int q = 0; q < 4; ++q) { const float hb0 = h; const float t0 = sA[q] * h + sH[q]; const float hm = __shfl(t0, r32); const float t1 = sA[q] * hm + sH[q]; h = __shfl(t1, r32 + 32); hbef[q] = hi ? hm : hb0; }
        } else {
#pragma unroll
            for (int q = 3; q >= 0; --q) { const float hb1 = h; const float t1 = sA[q] * h + sH[q]; const float hm = __shfl(t1, r32 + 32); const float t0 = sA[q] * hm + sH[q]; h = __shfl(t0, r32); hbef[q] = hi ? hb1 : hm; }
        }
        if (!FINAL) {
            float at = (sA[0] * sA[1]) * (sA[2] * sA[3]); at *= __shfl_xor(at, 32);
            if (hi == 0) *(f32x2*)(LSUM + (((size_t)cid * 2 + d) * 256 + c2) * 2) = (f32x2){at, h};
        } else {
#pragma unroll
            for (int r = 0; r < 16; ++r) hsum[r] += ca[r] * hbef[r >> 2] + hl[r];
        }
    }
    if (FINAL) {
#pragma unroll
        for (int r = 0; r < 16; ++r) { const size_t row = (size_t)(seqbase + tl0 + crow(r, hi)); MIX[row * 1024 + c2] = (bf16_t)f2bf(hsum[r] * bf2f(gr[r])); }
    }
    if (ncid >= 0) conv_store(xr, ncid, W, (LAS bf16_t*)ynbuf, tid);
}
template <bool FINAL>
__device__ __forceinline__ void run_chunks(LAS unsigned char* lds, const WaveCtx& W, const int first, const int stride, const int nch, const bf16_t* XL, const bf16_t* GG, float* LSUM, const float* LCAR, bf16_t* MIX) {
    if (first < nch) { unsigned xr[19]; const int tid = otid(); conv_load(xr, first, XL, tid); conv_store(xr, first, W, (LAS bf16_t*)lds, tid); }
    int it = 0;
    for (int cid = first; cid < nch; cid += stride, ++it) {
        __syncthreads();
        const int ncid = (cid + stride < nch) ? cid + stride : -1;
        chunk<FINAL>(lds + (it & 1) * YBUF, lds + ((it + 1) & 1) * YBUF, W, cid, ncid, XL, GG, LSUM, LCAR, MIX);
    }
}

__device__ __forceinline__ void carry(const float* LSUM, float* LCAR) {
    if (blockIdx.x < NBATCH) {
        const int tid_ = otid(); const int b = blockIdx.x, d = tid_ >> 8, c = tid_ & 255;
        float h = 0.f;
#pragma unroll 8
        for (int n = 0; n < 136; ++n) {
            int cid;
            if (d == 0) cid = (n < 8) ? NCHUNK_LAT + b * 8 + n : b * 128 + (n - 8);
            else cid = (n < 8) ? NCHUNK_LAT + b * 8 + (7 - n) : b * 128 + (135 - n);
            const f32x2 ah = *(const f32x2*)(LSUM + (((size_t)cid * 2 + d) * 256 + c) * 2);
            LCAR[((size_t)cid * 2 + d) * 256 + c] = h;
            h = ah.x * h + ah.y;
        }
    }
}
}

namespace lnp {
struct Vec { f32x4 v[4]; };
__device__ __forceinline__ Vec ldv(const float* p, int lane) { Vec r;
#pragma unroll
    for (int j = 0; j < 4; ++j) r.v[j] = *(const f32x4*)(p + 4 * lane + 256 * j);
    return r; }
__device__ __forceinline__ Vec ldbf(const bf16_t* p, int lane) { Vec r;
#pragma unroll
    for (int j = 0; j < 4; ++j) { const u32x2 w = *(const u32x2*)(p + 4 * lane + 256 * j); r.v[j] = (f32x4){bflo(w.x), bfhi(w.x), bflo(w.y), bfhi(w.y)}; }
    return r; }
__device__ __forceinline__ void stf(float* p, int lane, const Vec& a) {
#pragma unroll
    for (int j = 0; j < 4; ++j) *(f32x4*)(p + 4 * lane + 256 * j) = a.v[j]; }
__device__ __forceinline__ void stbf(bf16_t* p, int lane, const Vec& a) {
#pragma unroll
    for (int j = 0; j < 4; ++j) st8(p + 4 * lane + 256 * j, a.v[j]); }
__device__ __forceinline__ void normalize(Vec& y) {
    float s = 0.f;
#pragma unroll
    for (int j = 0; j < 4; ++j) s += (y.v[j][0] + y.v[j][1]) + (y.v[j][2] + y.v[j][3]);
    const float mean = wave_sum(s) * (1.0f / DM); float q = 0.f;
#pragma unroll
    for (int j = 0; j < 4; ++j) { y.v[j] = y.v[j] - mean; q += (y.v[j][0] * y.v[j][0] + y.v[j][1] * y.v[j][1]) + (y.v[j][2] * y.v[j][2] + y.v[j][3] * y.v[j][3]); }
    const float rstd = rsqrtf(wave_sum(q) * (1.0f / DM) + LN_EPS);
#pragma unroll
    for (int j = 0; j < 4; ++j) y.v[j] = y.v[j] * rstd;
}

constexpr int LG_OFF = 65536, CNT_OFF = 86016, BASE_OFF = 86080;
__device__ __forceinline__ f32x4 cvt4u(const u32x2 w) { return (f32x4){bflo(w.x), bfhi(w.x), bflo(w.y), bfhi(w.y)}; }
__device__ __forceinline__ f32x4 cvt4b(const f32x4 r) { const unsigned a = __float_as_uint(r[0]), b = __float_as_uint(r[1]); return (f32x4){bflo(a), bfhi(a), bflo(b), bfhi(b)}; }
struct Raw2 { f32x4 x[4]; u32x2 o[4]; };
struct Ln1Par { Vec gate, gg, bb, m4, m3; int cur_bi; };
__device__ __forceinline__ float swap32_sum(const float x, const float y) { auto rr = __builtin_amdgcn_permlane32_swap(__float_as_uint(x), __float_as_uint(y), false, false); return __uint_as_float(rr[0]) + __uint_as_float(rr[1]); }
__device__ __forceinline__ float swap16_sum(const float x, const float y) { auto rr = __builtin_amdgcn_permlane16_swap(__float_as_uint(x), __float_as_uint(y), false, false); return __uint_as_float(rr[0]) + __uint_as_float(rr[1]); }
__device__ __forceinline__ void ln1_ld(Raw2& R, const int l, const int r_, const int rl, const float* xin_lat, const float* xin_ctx, const bf16_t* XB, const bf16_t* O, const int lane) {
    const int rr = (r_ < rl) ? r_ : rl;
    if (l == 0) { const float* xp = (rr < NLAT ? xin_lat + (size_t)rr * 1024 : xin_ctx + (size_t)(rr - NLAT) * 1024) + 4 * lane;
#pragma unroll
        for (int j = 0; j < 4; ++j) R.x[j] = *(const f32x4*)(xp + 256 * j); }
    else { const bf16_t* xp = XB + (size_t)rr * 1024 + 4 * lane;
#pragma unroll
        for (int j = 0; j < 4; ++j) { const u32x2 w = *(const u32x2*)(xp + 256 * j); R.x[j][0] = __uint_as_float(w.x); R.x[j][1] = __uint_as_float(w.y); } }
    const bf16_t* op = O + (size_t)rr * 1024 + 4 * lane;
#pragma unroll
    for (int j = 0; j < 4; ++j) R.o[j] = *(const u32x2*)(op + 256 * j);
}
__device__ __forceinline__ void ln1_row(const Raw2& R, Ln1Par& P, const int l, const int row, const int i, bf16_t* XB, const float* mod, const float* g1, const float* b1, bf16_t* V,
        const LAS float* Wl, LAS float* lg, const int lane) {
    const bool lat = row < NLAT; const int bi = lat ? (row >> 12) : 16;
    if (bi != P.cur_bi) { P.cur_bi = bi; const float* mb = mod + ((size_t)(l * 17 + bi) * 6) * 1024;
        P.gate = ldv(mb + 2 * 1024, lane); P.m3 = ldv(mb + 3 * 1024, lane); P.m4 = ldv(mb + 4 * 1024, lane); P.gg = ldv(g1 + l * 1024, lane); P.bb = ldv(b1 + l * 1024, lane);
#pragma unroll
        for (int j = 0; j < 4; ++j) P.m4.v[j] = P.m4.v[j] + 1.0f;
        __builtin_amdgcn_s_waitcnt(0x0F70); }
    Vec y;
#pragma unroll
    for (int j = 0; j < 4; ++j) y.v[j] = ((l == 0) ? R.x[j] : cvt4b(R.x[j])) * DN_ALPHA + P.gate.v[j] * cvt4u(R.o[j]);
    normalize(y);
    Vec v;
#pragma unroll
    for (int j = 0; j < 4; ++j) { y.v[j] = y.v[j] * P.gg.v[j] + P.bb.v[j]; v.v[j] = y.v[j] * P.m4.v[j] + P.m3.v[j]; }
    stbf(XB + (size_t)row * 1024, lane, y); stbf(V + (size_t)row * 1024, lane, v);
    f32x4 a[4];
#pragma unroll
    for (int q = 0; q < 4; ++q) a[q] = (f32x4){0.f, 0.f, 0.f, 0.f};
#pragma unroll
    for (int j = 0; j < 4; ++j)
#pragma unroll
        for (int e4 = 0; e4 < 4; ++e4) { const float vv = v.v[j][e4]; const int jj = j * 4 + e4;
#pragma unroll
            for (int q = 0; q < 4; ++q) a[q] += vv * *(const LAS f32x4*)(Wl + (((jj * 4 + q) * 64 + lane) << 2)); }
    float r8[8], r4[4], r2[2], r1;
#pragma unroll
    for (int k = 0; k < 8; ++k) r8[k] = swap32_sum(a[k >> 2][k & 3], a[2 + (k >> 2)][k & 3]);
#pragma unroll
    for (int k = 0; k < 4; ++k) r4[k] = swap16_sum(r8[k], r8[4 + k]);
    { const bool up = lane & 2;
#pragma unroll
      for (int k = 0; k < 2; ++k) { const float mine = up ? r4[2 + k] : r4[k], theirs = up ? r4[k] : r4[2 + k]; r2[k] = mine + dpp_f<0x4E>(theirs); } }
    { const bool up = lane & 1; const float mine = up ? r2[1] : r2[0], theirs = up ? r2[0] : r2[1]; r1 = mine + dpp_f<0xB1>(theirs); }
    r1 += dpp_f<0x124>(r1); r1 += dpp_f<0x128>(r1);
    if ((lane & 12) == 0) lg[i * 16 + (((lane >> 4) << 2) | (lane & 3))] = r1;
}
__device__ __forceinline__ void ln1_router(LAS unsigned char* lds, const int l, const int nrows, const float* xin_lat, const float* xin_ctx, bf16_t* XB, const bf16_t* O,
        const float* mod, const float* g1, const float* b1, const float* router_w, const float* router_b, bf16_t* V, float* route, unsigned* list, unsigned* gcnt) {
    const int tid = otid(), lane = tid & 63, wid = __builtin_amdgcn_readfirstlane(tid >> 6);
    LAS float* Wl = (LAS float*)lds; LAS float* lg = (LAS float*)(lds + LG_OFF) + wid * (34 * 16);
    LAS unsigned* cnt = (LAS unsigned*)(lds + CNT_OFF); LAS unsigned* base = (LAS unsigned*)(lds + BASE_OFF);
    for (int i = tid; i < 1024 * 16; i += NTHREADS) { const int k = i >> 4, e = i & 15, ln = (k & 255) >> 2, jj = (k >> 8) * 4 + (k & 3);
        Wl[(((jj * 4 + (e >> 2)) * 64 + ln) << 2) + (e & 3)] = router_w[i]; }
    if (tid < 16) cnt[tid] = 0u;
    __syncthreads();
    const int rpw = nrows / 256, rpv = rpw / 8;
    const int row0 = blockIdx.x * rpw + wid * rpv, rl = row0 + rpv - 1;
    Ln1Par P; P.cur_bi = -1;
    Raw2 RA, RB, RC;
    ln1_ld(RA, l, row0, rl, xin_lat, xin_ctx, XB, O, lane); ln1_ld(RB, l, row0 + 1, rl, xin_lat, xin_ctx, XB, O, lane);
    for (int i = 0; i < rpv; i += 3) {
        ln1_ld(RC, l, row0 + i + 2, rl, xin_lat, xin_ctx, XB, O, lane);
        ln1_row(RA, P, l, row0 + i, i, XB, mod, g1, b1, V, Wl, lg, lane);
        if (i + 1 >= rpv) break;
        ln1_ld(RA, l, row0 + i + 3, rl, xin_lat, xin_ctx, XB, O, lane);
        ln1_row(RB, P, l, row0 + i + 1, i + 1, XB, mod, g1, b1, V, Wl, lg, lane);
        if (i + 2 >= rpv) break;
        ln1_ld(RB, l, row0 + i + 4, rl, xin_lat, xin_ctx, XB, O, lane);
        ln1_row(RC, P, l, row0 + i + 2, i + 2, XB, mod, g1, b1, V, Wl, lg, lane);
    }
    LDS_WAIT();
    int e0 = 0, e1 = 0; float w0 = 0.f, w1 = 0.f; unsigned lp0 = 0, lp1 = 0;
    if (lane < rpv) {
        float sc[16], sel[16];
#pragma unroll
        for (int e = 0; e < 16; ++e) { sc[e] = 1.0f / (1.0f + __expf(-lg[lane * 16 + e])); sel[e] = sc[e] + router_b[e]; }
        float gs[4];
#pragma unroll
        for (int g = 0; g < 4; ++g) { const float s0 = sel[4 * g], s1 = sel[4 * g + 1], s2 = sel[4 * g + 2], s3 = sel[4 * g + 3];
            gs[g] = fmaxf(fmaxf(fmaxf(s0 + s1, s0 + s2), fmaxf(s0 + s3, s1 + s2)), fmaxf(s1 + s3, s2 + s3)); }
        int best = 0; float bv = gs[0];
#pragma unroll
        for (int g = 1; g < 4; ++g) if (gs[g] > bv) { bv = gs[g]; best = g; }
        float a4[4], c4[4];
#pragma unroll
        for (int k = 0; k < 4; ++k) { a4[k] = sel[k]; c4[k] = sc[k]; }
#pragma unroll
        for (int g = 1; g < 4; ++g) if (best == g) {
#pragma unroll
            for (int k = 0; k < 4; ++k) { a4[k] = sel[4 * g + k]; c4[k] = sc[4 * g + k]; } }
        int i0 = 0; float v0 = a4[0], s0 = c4[0];
#pragma unroll
        for (int k = 1; k < 4; ++k) if (a4[k] > v0) { v0 = a4[k]; i0 = k; s0 = c4[k]; }
        int i1 = -1; float v1 = 0.f, s1 = 0.f;
#pragma unroll
        for (int k = 0; k < 4; ++k) if (k != i0 && (i1 < 0 || a4[k] > v1)) { v1 = a4[k]; i1 = k; s1 = c4[k]; }
        e0 = best * 4 + i0; e1 = best * 4 + i1; const float inv = 1.0f / (s0 + s1); w0 = s0 * inv; w1 = s1 * inv;
        lp0 = atomicAdd((unsigned*)(cnt + e0), 1u); lp1 = atomicAdd((unsigned*)(cnt + e1), 1u);
    }
    __syncthreads();
    if (tid < 16) base[tid] = atomicAdd(gcnt + tid, cnt[tid]);
    __syncthreads();
    if (lane < rpv) { const int row = row0 + lane;
        ((u32x2*)list)[(size_t)e0 * NTOK + base[e0] + lp0] = (u32x2){(unsigned)row * 2u, __float_as_uint(w0)}; ((u32x2*)list)[(size_t)e1 * NTOK + base[e1] + lp1] = (u32x2){(unsigned)row * 2u + 1u, __float_as_uint(w1)};
        *(f32x4*)(route + (size_t)row * 4) = (f32x4){__int_as_float(e0), __int_as_float(e1), w0, w1}; }
    __syncthreads();
}

struct Raw3 { u32x2 x[4], f0[4], f1[4]; };
__device__ __forceinline__ void ld_raw3(Raw3& r, const bf16_t* XB, const bf16_t* F0, const bf16_t* F1, const int row, const int lane) {
    const size_t o = (size_t)row * 1024 + 4 * lane;
#pragma unroll
    for (int j = 0; j < 4; ++j) { r.x[j] = *(const u32x2*)(XB + o + 256 * j); r.f0[j] = *(const u32x2*)(F0 + o + 256 * j); r.f1[j] = *(const u32x2*)(F1 + o + 256 * j); } }
__device__ __forceinline__ f32x4 cvt4(const u32x2 w) { return (f32x4){bflo(w.x), bfhi(w.x), bflo(w.y), bfhi(w.y)}; }
struct Ln2Par { Vec gate, gg, bb, s1, s0; int cur_bi; };
__device__ __forceinline__ void ln2_row(const Raw3& R, Ln2Par& P, const int l, const int row, float* out_lat, bf16_t* XB, const float* mod, const float* g2, const float* b2, bf16_t* U, const int lane) {
    const bool lat = row < NLAT; const int bi = lat ? (row >> 12) : 16;
    if (bi != P.cur_bi) { P.cur_bi = bi; const float* mb = mod + ((size_t)(l * 17 + bi) * 6) * 1024;
        P.gate = ldv(mb + 5 * 1024, lane); P.gg = ldv(g2 + l * 1024, lane); P.bb = ldv(b2 + l * 1024, lane);
        if (l + 1 < DEPTH) { const float* mn = mod + ((size_t)((l + 1) * 17 + bi) * 6) * 1024; P.s0 = ldv(mn, lane); P.s1 = ldv(mn + 1024, lane);
#pragma unroll
            for (int j = 0; j < 4; ++j) P.s1.v[j] = P.s1.v[j] + 1.0f; }
        __builtin_amdgcn_s_waitcnt(0x0F70); }
    Vec y;
#pragma unroll
    for (int j = 0; j < 4; ++j) y.v[j] = cvt4(R.x[j]) * DN_ALPHA + P.gate.v[j] * (cvt4(R.f0[j]) + cvt4(R.f1[j]));
    normalize(y);
#pragma unroll
    for (int j = 0; j < 4; ++j) y.v[j] = y.v[j] * P.gg.v[j] + P.bb.v[j];
    if (l + 1 < DEPTH) stbf(XB + (size_t)row * 1024, lane, y); else stf(out_lat + (size_t)row * 1024, lane, y);
    if (l + 1 < DEPTH) { Vec u;
#pragma unroll
        for (int j = 0; j < 4; ++j) u.v[j] = y.v[j] * P.s1.v[j] + P.s0.v[j];
        stbf(U + (size_t)row * 1024, lane, u); }
}
__device__ __forceinline__ void ln2(const int l, const int nrows, float* out_lat, bf16_t* XB, const bf16_t* F0, const bf16_t* F1, const float* mod, const float* g2, const float* b2, bf16_t* U, const int gw, const int ngw) {
    const int lane = otid() & 63;
    const int per = (nrows + ngw - 1) / ngw;
    const int r0 = gw * per, rend = (r0 + per < nrows) ? r0 + per : nrows;
    Ln2Par P; P.cur_bi = -1;
    if (r0 >= rend) return;
    const int rl = rend - 1;
    Raw3 A, B, C;
    ld_raw3(A, XB, F0, F1, r0, lane);
    ld_raw3(B, XB, F0, F1, (r0 + 1 < rl) ? r0 + 1 : rl, lane);
    for (int row = r0; row < rend; row += 3) {
        ld_raw3(C, XB, F0, F1, (row + 2 < rl) ? row + 2 : rl, lane);
        ln2_row(A, P, l, row, out_lat, XB, mod, g2, b2, U, lane);
        if (row + 1 >= rend) break;
        ld_raw3(A, XB, F0, F1, (row + 3 < rl) ? row + 3 : rl, lane);
        ln2_row(B, P, l, row + 1, out_lat, XB, mod, g2, b2, U, lane);
        if (row + 2 >= rend) break;
        ld_raw3(B, XB, F0, F1, (row + 4 < rl) ? row + 4 : rl, lane);
        ln2_row(C, P, l, row + 2, out_lat, XB, mod, g2, b2, U, lane);
    }
}
}

namespace pro {
template <class Src>
__device__ __forceinline__ void tr_item(const Src& src, bf16_t* WT, const int K, const int n0, const int k0, LAS float* scr, const int lane) {
    float tv[32];
#pragma unroll
    for (int i = 0; i < 32; ++i) tv[i] = src(n0 + (lane & 31), k0 + 2 * i + (lane >> 5));
#pragma unroll
    for (int i = 0; i < 32; ++i) { const int kk = 2 * i + (lane >> 5); scr[kk * 33 + (lane & 31)] = tv[i]; }
    LDS_WAIT(); asm volatile("" ::: "memory");
    const int c = lane & 7;
#pragma unroll
    for (int j = 0; j < 4; ++j) { const int n = (lane >> 3) + 8 * j; const LAS float* s = scr + (8 * c) * 33 + n;
        u32x4 o; o.x = pk2(s[0 * 33], s[1 * 33]); o.y = pk2(s[2 * 33], s[3 * 33]); o.z = pk2(s[4 * 33], s[5 * 33]); o.w = pk2(s[6 * 33], s[7 * 33]);
        *(u32x4*)(WT + (size_t)(n0 + n) * K + k0 + 8 * c) = o; }
    LDS_WAIT(); asm volatile("" ::: "memory");
}
__device__ __forceinline__ int rotperm(int p) { return 16 * ((p >> 2) & 1) + 4 * (p >> 3) + (p & 3); }
struct SrcIn { const float* w; __device__ float operator()(int n, int k) const { if (n >= D_IN) return 0.f; const int g = n >> 5; const bool rt = (g >= 16 && g < 40) || g == 64;
    const int col = rt ? (g * 32 + rotperm(n & 31)) : n; return w[(size_t)k * D_IN + col]; } };
struct SrcOut { const float* w; __device__ float operator()(int n, int k) const { return w[(size_t)k * 1024 + n]; } };
struct Src13 { const float* w1; const float* w3; __device__ float operator()(int n, int k) const { const int g = n >> 5, p = n & 31, col = 16 * g + 4 * (p >> 3) + (p & 3);
    const float a = w1[(size_t)k * 256 + col], b = w3[(size_t)k * 256 + col]; return ((p >> 2) & 1) ? b : a; } };
struct Src2 { const float* w; __device__ float operator()(int n, int k) const { return w[(size_t)k * 1024 + n]; } };
struct SrcUQ { const float* w; const float* g; __device__ float operator()(int n, int k) const { if (n >= 576) return 0.f; const int gr = n >> 5, head = gr / 3, part = gr % 3;
    const int col = head * 96 + part * 32 + (part == 2 ? rotperm(n & 31) : (n & 31)); return g[k] * w[(size_t)k * 576 + col]; } };
struct SrcUKV { const float* w; const float* g; __device__ float operator()(int n, int k) const { return g[k] * w[(size_t)k * 768 + n]; } };
struct SrcG { const float* wa; const float* wi; __device__ float operator()(int n, int k) const { const int hb = n >> 8, o = n & 255, d = o >> 7, gt = (o >> 6) & 1, ch = o & 63;
    const size_t ix = (((size_t)d * 4 + hb) * 64 + k) * 64 + ch; const float a = wa[ix], b = wi[ix]; return gt ? b : a; } };
}


struct Args { const float* in[30]; float* out; unsigned char* ws; int ph_lo, ph_hi; };
constexpr int NPHASE = 2 + 9 * DEPTH;
typedef __attribute__((address_space(4))) const Args CArgs;
__device__ __forceinline__ void phase_skew(const int slots, const int q) { for (int s_ = 0; s_ < slots; ++s_) for (int r_ = 0; r_ < q; ++r_) __builtin_amdgcn_s_sleep(16); }
__device__ __forceinline__ CArgs* kargs() { CArgs* p = (CArgs*)__builtin_amdgcn_kernarg_segment_ptr(); asm volatile("" : "+s"(p)); return p; }
#define WSP(T, off) ((T*)(ws + (off)))
#ifndef PHMASK
#define PHMASK 0xFFFFFFFFu
#endif
#define PHON(j) ((PHMASK >> (j)) & 1u)

__global__ void __launch_bounds__(NTHREADS, 2) fwd_kernel(Args args_unused) {
    extern __shared__ __attribute__((aligned(16))) unsigned char lds_raw[];
    LAS unsigned char* lds = (LAS unsigned char*)lds_raw;
    const int tid = threadIdx.x;
    const int G = gridDim.x, bx = blockIdx.x; const int vcu = (G % 8 == 0) ? (bx % 8) * (G / 8) + bx / 8 : bx;
    static_assert(WIDTAB_OFF == MISC_OFF + 512 && WIDTAB_OFF + 256 <= LDS_BYTES, "wave-id table");
    for (int u = tid; u < (LDS_BYTES - MISC_OFF) / 4; u += NTHREADS) ((LAS unsigned*)(lds + MISC_OFF))[u] = 0u;
    __syncthreads();
    if ((tid & 63) == 0) { const unsigned hw = (unsigned)__builtin_amdgcn_s_getreg((5 << 11) | (0 << 6) | 4) & 63u; ((LAS int*)(lds + WIDTAB_OFF))[hw] = tid >> 6; }
    __syncthreads();
    int lo, hi;
    XcdBarrier bar;
    { CArgs* A = kargs(); lo = A->ph_lo; hi = A->ph_hi; unsigned* bw = (unsigned*)(A->ws + WS_CTL) + CW_BAR;
      bar.bar = bw; bar.x = 0; bar.st = nullptr;
      if (hi - lo > 1) bar = xcd_barrier_post(bw, (volatile LAS unsigned*)(lds + MISC_OFF) + 8); }
#define IN(k) (lo <= (k) && (k) < hi)
#define SEAM(k) do { if (IN(k) && IN((k) + 1)) xcd_barrier(bar); } while (0)

    if (PHON(0) && IN(0)) {
        CArgs* A = kargs(); unsigned char* ws = A->ws;
        const int lane = tid & 63, wave = __builtin_amdgcn_readfirstlane(tid >> 6); const int gw = vcu * NWAVES + wave, NGW = G * NWAVES;
        if (bx == G - 1) {
            float* ROT = WSP(float, WS_ROT); const float* diff_lambda = A->in[15];
            for (int i = tid; i < 512; i += NTHREADS) { const int pos = i >> 3, f = i & 7; const float inv = exp2f(-(float)f * (13.287712379549449f / 8.0f)); const float ang = (float)pos * inv;
                ROT[i] = __cosf(ang); ROT[512 + i] = __sinf(ang); }
            if (tid < DEPTH) { const float* lv = diff_lambda + tid * 128; float s01 = 0.f, s23 = 0.f; for (int k = 0; k < 32; ++k) { s01 += lv[k] * lv[32 + k]; s23 += lv[64 + k] * lv[96 + k]; }
                ROT[1024 + tid] = expf(s01) - expf(s23) + (0.8f - 0.6f * expf(-0.3f * (float)tid)); }
        }
        if (bx < 192) {
            const float* c_in = A->in[1]; const float* cctx_in = A->in[3]; const float* w_mod = A->in[4]; const float* b_mod = A->in[5]; float* MOD = WSP(float, WS_MOD);
            LAS float* S = (LAS float*)lds;
            LAS float* red = (LAS float*)(lds + 81920);
            for (int i = tid; i < 17 * 1024; i += NTHREADS) { const int bi = i >> 10, k = i & 1023; const float cv = (bi < 16) ? c_in[bi * 1024 + k] : cctx_in[k]; S[k * 20 + bi] = cv / (1.0f + __expf(-cv)); }
            __syncthreads();
            for (int item = bx; item < 192; item += G) {
                const int l = item / 48, n0 = (item % 48) * 128, kg = tid >> 7, cl = tid & 127;
                float acc[17];
#pragma unroll
                for (int b = 0; b < 17; ++b) acc[b] = 0.f;
                const float* wp = w_mod + ((size_t)l * 1024 + kg * 256) * 6144 + n0 + cl;
#pragma unroll 16
                for (int k = 0; k < 256; ++k) { const float w = wp[(size_t)k * 6144]; const LAS float* sp = S + (kg * 256 + k) * 20;
                    const f32x4 s0 = *(const LAS f32x4*)sp, s1 = *(const LAS f32x4*)(sp + 4), s2 = *(const LAS f32x4*)(sp + 8), s3 = *(const LAS f32x4*)(sp + 12); const float s4 = sp[16];
#pragma unroll
                    for (int b = 0; b < 4; ++b) { acc[b] += s0[b] * w; acc[4 + b] += s1[b] * w; acc[8 + b] += s2[b] * w; acc[12 + b] += s3[b] * w; }
                    acc[16] += s4 * w; }
#pragma unroll
                for (int b = 0; b < 17; ++b) red[(kg * 17 + b) * 128 + cl] = acc[b];
                __syncthreads();
                for (int i = tid; i < 17 * 128; i += NTHREADS) { const int b = i >> 7, c = i & 127; const float v = red[(0 * 17 + b) * 128 + c] + red[(1 * 17 + b) * 128 + c] + red[(2 * 17 + b) * 128 + c] + red[(3 * 17 + b) * 128 + c];
                    const int n = n0 + c, j = n >> 10, col = n & 1023; MOD[((size_t)(l * 17 + b) * 6 + j) * 1024 + col] = v + b_mod[l * 6144 + n]; }
                __syncthreads();
            }
        }
        __syncthreads();
        { LAS float* scr = (LAS float*)(lds + wave * 8448);
          constexpr int I_IN = 72 * 16, I_OUT = 32 * 16, I_13 = 16 * 16, I_2 = 32 * 4, I_UQ = 24 * 4, I_UKV = 24 * 2, I_G = 32;
          constexpr int T_IN = DEPTH * I_IN, T_OUT = DEPTH * I_OUT, T_13 = DEPTH * NEXP * I_13, T_2 = DEPTH * NEXP * I_2, T_UQ = DEPTH * I_UQ, T_UKV = DEPTH * I_UKV, T_G = DEPTH * I_G;
          constexpr int NITEMS = T_IN + T_OUT + T_13 + T_2 + T_UQ + T_UKV + T_G;
          for (int it = gw; it < NITEMS; it += NGW) {
              int r = it;
              if (r < T_IN) { const int l = r / I_IN, q = r % I_IN; pro::tr_item(pro::SrcIn{A->in[6] + (size_t)l * 1024 * D_IN}, WSP(bf16_t, WS_WIN) + (size_t)l * NIN_PAD * 1024, 1024, (q >> 4) * 32, (q & 15) * 64, scr, lane); continue; } r -= T_IN;
              if (r < T_OUT) { const int l = r / I_OUT, q = r % I_OUT; pro::tr_item(pro::SrcOut{A->in[7] + (size_t)l * 1024 * 1024}, WSP(bf16_t, WS_WOUT) + (size_t)l * 1024 * 1024, 1024, (q >> 4) * 32, (q & 15) * 64, scr, lane); continue; } r -= T_OUT;
              if (r < T_13) { const int le = r / I_13, q = r % I_13; pro::tr_item(pro::Src13{A->in[27] + (size_t)le * 1024 * 256, A->in[28] + (size_t)le * 1024 * 256}, WSP(bf16_t, WS_W13) + (size_t)le * 512 * 1024, 1024, (q >> 4) * 32, (q & 15) * 64, scr, lane); continue; } r -= T_13;
              if (r < T_2) { const int le = r / I_2, q = r % I_2; pro::tr_item(pro::Src2{A->in[29] + (size_t)le * 256 * 1024}, WSP(bf16_t, WS_W2) + (size_t)le * 1024 * 256, 256, (q >> 2) * 32, (q & 3) * 64, scr, lane); continue; } r -= T_2;
              if (r < T_UQ) { const int l = r / I_UQ, q = r % I_UQ; pro::tr_item(pro::SrcUQ{A->in[19] + (size_t)l * 256 * 576, A->in[17] + l * 256}, WSP(bf16_t, WS_WUQ) + (size_t)l * 768 * 256, 256, (q >> 2) * 32, (q & 3) * 64, scr, lane); continue; } r -= T_UQ;
              if (r < T_UKV) { const int l = r / I_UKV, q = r % I_UKV; pro::tr_item(pro::SrcUKV{A->in[20] + (size_t)l * 128 * 768, A->in[18] + l * 128}, WSP(bf16_t, WS_WUKV) + (size_t)l * 768 * 128, 128, (q >> 1) * 32, (q & 1) * 64, scr, lane); continue; } r -= T_UKV;
              { const int l = r / I_G, q = r % I_G; pro::tr_item(pro::SrcG{A->in[10] + (size_t)l * 2 * 4 * 64 * 64, A->in[12] + (size_t)l * 2 * 4 * 64 * 64}, WSP(bf16_t, WS_WG) + (size_t)l * 1024 * 64, 64, q * 32, 0, scr, lane); }
          } }
        __syncthreads();
    }
    SEAM(0);
    if (PHON(1) && IN(1)) {
        CArgs* A = kargs(); unsigned char* ws = A->ws; const float* x_in = A->in[0]; const float* ctx_in = A->in[2]; const float* MOD = WSP(float, WS_MOD); bf16_t* U = WSP(bf16_t, WS_U);
        const int lane = tid & 63, wave = __builtin_amdgcn_readfirstlane(tid >> 6); const int gw = vcu * NWAVES + wave, NGW = G * NWAVES;
        const int per = NTOK / NGW;
        int cur_bi = -1; lnp::Vec s0, s1;
        const int r0 = gw * per, rl = r0 + per - 1;
#define PB_LD(R, r_) do { const int rr_ = ((r_) < rl) ? (r_) : rl; R = lnp::ldv(rr_ < NLAT ? x_in + (size_t)rr_ * 1024 : ctx_in + (size_t)(rr_ - NLAT) * 1024, lane); } while (0)
#define PB_ROW(R, row_) do { const int row = (row_); const bool lat = row < NLAT; const int bi = lat ? (row >> 12) : 16; \
            if (bi != cur_bi) { cur_bi = bi; const float* mb = MOD + ((size_t)bi * 6) * 1024; s0 = lnp::ldv(mb, lane); s1 = lnp::ldv(mb + 1024, lane); \
                _Pragma("unroll") for (int j = 0; j < 4; ++j) s1.v[j] = s1.v[j] + 1.0f; \
                __builtin_amdgcn_s_waitcnt(0x0F70); } \
            lnp::Vec xv; _Pragma("unroll") for (int j = 0; j < 4; ++j) xv.v[j] = R.v[j] * s1.v[j] + s0.v[j]; \
            lnp::stbf(U + (size_t)row * 1024, lane, xv); } while (0)
        lnp::Vec RA, RB, RC; PB_LD(RA, r0); PB_LD(RB, r0 + 1);
        for (int i = 0; i < per; i += 3) {
            PB_LD(RC, r0 + i + 2); PB_ROW(RA, r0 + i);
            if (i + 1 >= per) break;
            PB_LD(RA, r0 + i + 3); PB_ROW(RB, r0 + i + 1);
            if (i + 2 >= per) break;
            PB_LD(RB, r0 + i + 4); PB_ROW(RC, r0 + i + 2);
        }
#undef PB_LD
#undef PB_ROW
    }
    SEAM(1);

    for (int l = 0; l < DEPTH; ++l) {
        const int pb = 2 + 9 * l;
        const bool need_ctx = l < DEPTH - 1;
        const int mrows = need_ctx ? NTOK : NLAT;
        if (PHON(2) && IN(pb)) {
            CArgs* A = kargs(); unsigned char* ws = A->ws;
            { const float* ROT = WSP(float, WS_ROT); for (int i = otid(); i < 1024; i += NTHREADS) ((LAS float*)(lds + ROT_OFF))[i] = ROT[i]; }
            __syncthreads();
            pg8::StaticOrder S; S.init(NTOK, NIN_PAD, G, bx);
            EpiInProj E{WSP(bf16_t, WS_XL), WSP(bf16_t, WS_GG), WSP(bf16_t, WS_QD), WSP(bf16_t, WS_KD), WSP(bf16_t, WS_VD), WSP(bf16_t, WS_CQ), WSP(bf16_t, WS_CKV), WSP(bf16_t, WS_KR),
                        WSP(float, WS_SSP), (const LAS float*)(lds + ROT_OFF)};
            phase_skew((bx & 3) + (bx >= 144 ? 4 : 0), 8);
            pg8::gemm_phase<EpiInProj, pg8::StaticOrder, false>(lds, WSP(bf16_t, WS_U), WSP(bf16_t, WS_WIN) + (size_t)l * NIN_PAD * 1024, 1024, S, E);
        }
        SEAM(pb);
        if (PHON(3) && IN(pb + 1)) {
            { CArgs* A = kargs(); unsigned char* ws = A->ws;
              { const float* ROT = WSP(float, WS_ROT); for (int i = otid(); i < 1024; i += NTHREADS) ((LAS float*)(lds + ROT_OFF))[i] = ROT[i]; }
              __syncthreads();
              pg8::StaticOrder S; S.init(NTOK, 768, G, bx); EpiExpQ E{WSP(bf16_t, WS_QM), WSP(float, WS_SSP), (const LAS float*)(lds + ROT_OFF)};
              pg8::gemm_phase<EpiExpQ, pg8::StaticOrder, false>(lds, WSP(bf16_t, WS_CQ), WSP(bf16_t, WS_WUQ) + (size_t)l * 768 * 256, 256, S, E); }
            __syncthreads(); asm volatile("" ::: "memory");
            { CArgs* A = kargs(); unsigned char* ws = A->ws;
              pg8::StaticOrder S; S.init(NTOK, 768, G, bx); EpiExpKV E{WSP(bf16_t, WS_KN), WSP(bf16_t, WS_VM), WSP(float, WS_SSP)};
              pg8::gemm_phase<EpiExpKV, pg8::StaticOrder, false>(lds, WSP(bf16_t, WS_CKV), WSP(bf16_t, WS_WUKV) + (size_t)l * 768 * 128, 128, S, E); }
            __syncthreads(); asm volatile("" ::: "memory");
            { CArgs* A = kargs(); unsigned char* ws = A->ws;
              lru::WaveCtx W; lru::load_ctx(W, l, WSP(bf16_t, WS_WG), A->in[8], A->in[9], A->in[11], A->in[13], A->in[14]);
              lru::run_chunks<false>(lds, W, vcu, G, NCHUNK, WSP(bf16_t, WS_XL), WSP(bf16_t, WS_GG), WSP(float, WS_LSUM), WSP(float, WS_LCAR), WSP(bf16_t, WS_MIX));
              __syncthreads(); }
        }
        SEAM(pb + 1);
        if (PHON(4) && IN(pb + 2)) { CArgs* A = kargs(); unsigned char* ws = A->ws; lru::carry(WSP(float, WS_LSUM), WSP(float, WS_LCAR)); }
        SEAM(pb + 2);
        if (PHON(5) && IN(pb + 3)) {
            { CArgs* A = kargs(); unsigned char* ws = A->ws;
              lru::WaveCtx W; lru::load_ctx(W, l, WSP(bf16_t, WS_WG), A->in[8], A->in[9], A->in[11], A->in[13], A->in[14]);
              const int nch = need_ctx ? NCHUNK : NCHUNK_LAT;
              lru::run_chunks<true>(lds, W, vcu, G, nch, WSP(bf16_t, WS_XL), WSP(bf16_t, WS_GG), WSP(float, WS_LSUM), WSP(float, WS_LCAR), WSP(bf16_t, WS_MIX));
              __syncthreads(); }
            asm volatile("" ::: "memory");
            { CArgs* A = kargs(); unsigned char* ws = A->ws;
              const float lam_init = 0.8f - 0.6f * expf(-0.3f * (float)l);
              attd::Tens T{WSP(bf16_t, WS_QD), 384, 0, WSP(bf16_t, WS_KD), nullptr, WSP(bf16_t, WS_VD), 0, WSP(bf16_t, WS_MIX), 256, WSP(float, WS_ROT)[1024 + l], 1.0f - lam_init, A->in[16] + l * 64};
              for (int i = 0; i < 6; ++i) { const int uidx = vcu + 256 * i; if (uidx < 1536) { const int bh = uidx >> 4, qb = uidx & 15, b = bh / 6, h = bh % 6;
                  T.qcol = h * 64; T.kvcol = h * 64; T.ocol = 256 + h * 64; attd::attn_unit<0>(lds, T, b, false, qb); } }
              if (need_ctx && vcu < 96) { const int b = vcu / 6, h = vcu % 6; T.qcol = h * 64; T.kvcol = h * 64; T.ocol = 256 + h * 64; attd::attn_unit<0>(lds, T, b, true, 0); } }
            asm volatile("" ::: "memory");
            { CArgs* A = kargs(); unsigned char* ws = A->ws;
              atts::Src S1{WSP(bf16_t, WS_QM), 576, 0, WSP(bf16_t, WS_KN), 0, WSP(bf16_t, WS_KR), WSP(bf16_t, WS_VM), 0};
              for (int i = 0; i < 7; ++i) {
                  const bool cx = (i == 6); if (cx && !(need_ctx && vcu >= 96 && vcu < 192)) break;
                  const int uidx = vcu + 256 * i; const int bh = cx ? vcu - 96 : (uidx >> 4), qb = cx ? 0 : (uidx & 15), b = bh / 6, h = bh % 6;
                  f32x16 oa[2]; atts::Sm sa;
                  S1.qcol = h * 96; S1.kcol = h * 64; S1.vcol = h * 64;
                  atts::attn_pass<1>(lds, S1, b, cx, qb, oa, sa);
                  atts::attn_store<false>(lds, oa, sa, oa, sa, 0.f, 0.f, nullptr, WSP(bf16_t, WS_MIX), 640 + h * 64, b, cx, qb);
              } }
        }
        SEAM(pb + 3);
        if (PHON(6) && IN(pb + 4)) {
            CArgs* A = kargs(); unsigned char* ws = A->ws;
            pg8::StaticOrder S; S.init(mrows, 1024, G, bx); EpiPlain E{WSP(bf16_t, WS_O), 1024};
            pg8::gemm_phase<EpiPlain, pg8::StaticOrder, false>(lds, WSP(bf16_t, WS_MIX), WSP(bf16_t, WS_WOUT) + (size_t)l * 1024 * 1024, 1024, S, E);
        }
        SEAM(pb + 4);
        if (PHON(7) && IN(pb + 5)) {
            CArgs* A = kargs(); unsigned char* ws = A->ws;
            lnp::ln1_router(lds, l, mrows, A->in[0], A->in[2], WSP(bf16_t, WS_XB), WSP(bf16_t, WS_O), WSP(float, WS_MOD), A->in[21], A->in[22], A->in[25], A->in[26],
                            WSP(bf16_t, WS_V), WSP(float, WS_ROUTE), WSP(unsigned, WS_LIST), WSP(unsigned, WS_CTL) + CW_CNT + 64 * l);
        }
        SEAM(pb + 5);
        if (PHON(8) && (IN(pb + 6) || IN(pb + 7))) {
            CArgs* A = kargs(); unsigned char* ws = A->ws;
            LAS int* tb = (LAS int*)(lds + MISC_OFF + 256);
            __syncthreads();
            if (otid() == 0) { gu32* gcnt = (gu32*)WSP(unsigned, WS_CTL) + CW_CNT + 64 * l; int off = 0, toff = 0;
                for (int e = 0; e < 16; ++e) { const int c = (int)__hip_atomic_load(gcnt + e, __ATOMIC_RELAXED, __HIP_MEMORY_SCOPE_AGENT); tb[e] = c; tb[16 + e] = off; tb[33 + e] = toff; off += c; toff += (c + 255) >> 8; }
                tb[32] = off; tb[49] = toff; }
            __syncthreads();
            if (IN(pb + 6)) {
                MoeSched S{tb, WSP(unsigned, WS_LIST), G, bx, 2}; EpiMoeUp E{WSP(bf16_t, WS_H)};
                pg8::gemm_phase<EpiMoeUp, MoeSched, true>(lds, WSP(bf16_t, WS_V), WSP(bf16_t, WS_W13) + (size_t)l * NEXP * 512 * 1024, 1024, S, E);
            }
        }
        SEAM(pb + 6);
        if (PHON(9) && IN(pb + 7)) {
            CArgs* A = kargs(); unsigned char* ws = A->ws;
            LAS int* tb = (LAS int*)(lds + MISC_OFF + 256);
            MoeSched S{tb, WSP(unsigned, WS_LIST), G, bx, 4}; EpiMoeDown E{WSP(bf16_t, WS_F0), WSP(bf16_t, WS_F1), WSP(unsigned, WS_LIST), WSP(float, WS_ROUTE)};
            pg8::gemm_phase<EpiMoeDown, MoeSched, false>(lds, WSP(bf16_t, WS_H), WSP(bf16_t, WS_W2) + (size_t)l * NEXP * 1024 * 256, 256, S, E);
        }
        SEAM(pb + 7);
        if (PHON(10) && IN(pb + 8)) {
            CArgs* A = kargs(); unsigned char* ws = A->ws; const int wave = __builtin_amdgcn_readfirstlane(otid() >> 6);
            lnp::ln2(l, mrows, A->out, WSP(bf16_t, WS_XB), WSP(bf16_t, WS_F0), WSP(bf16_t, WS_F1), WSP(float, WS_MOD), A->in[23], A->in[24], WSP(bf16_t, WS_U), vcu * NWAVES + wave, G * NWAVES);
        }
        SEAM(pb + 8);
    }
#undef IN
#undef SEAM
}

#ifndef MK_SPLIT
#define MK_SPLIT 0
#endif
extern "C" void kernel_launch(void* const* d_in, const int* in_sizes, int n_in, void* d_out, int out_size, void* d_ws, size_t ws_size, hipStream_t stream) {
    static int grid = 0;
    if (grid == 0) {
        if (n_in != 30 || out_size != NLAT * DM || ws_size < WS_END) { fprintf(stderr, "kernel_launch: unexpected problem (n_in %d out %d ws %zu)\n", n_in, out_size, ws_size); grid = -1; return; }
        int dev = 0, cus = 0;
        if (hipGetDevice(&dev) != hipSuccess || hipDeviceGetAttribute(&cus, hipDeviceAttributeMultiprocessorCount, dev) != hipSuccess) { grid = -1; return; }
        if (hipFuncSetAttribute((const void*)fwd_kernel, hipFuncAttributeMaxDynamicSharedMemorySize, LDS_BYTES) != hipSuccess) { fprintf(stderr, "kernel_launch: hipFuncSetAttribute failed\n"); grid = -1; return; }
        int per_cu = 0;
        if (hipOccupancyMaxActiveBlocksPerMultiprocessor(&per_cu, (const void*)fwd_kernel, NTHREADS, LDS_BYTES) != hipSuccess || per_cu < 1) fprintf(stderr, "kernel_launch: occupancy query says %d\n", per_cu);
        (void)hipGetLastError();
        grid = cus;
        if (grid != 256) { fprintf(stderr, "kernel_launch: built for 256 CUs, device has %d\n", cus); grid = -1; return; }
    }
    if (grid < 0) return;
    if (hipMemsetAsync((char*)d_ws + WS_CTL, 0, CTL_ZERO_BYTES, stream) != hipSuccess) return;
    Args a{};
    for (int i = 0; i < 30; ++i) a.in[i] = (const float*)d_in[i];
    a.out = (float*)d_out; a.ws = (unsigned char*)d_ws;
#if MK_SPLIT
    for (int p = 0; p < NPHASE; ++p) { a.ph_lo = p; a.ph_hi = p + 1; hipLaunchKernelGGL(fwd_kernel, dim3(grid), dim3(NTHREADS), LDS_BYTES, stream, a); }
#else
    a.ph_lo = 0; a.ph_hi = NPHASE; hipLaunchKernelGGL(fwd_kernel, dim3(grid), dim3(NTHREADS), LDS_BYTES, stream, a);
#endif
}
```

```cpp
#include <hip/hip_runtime.h>
#include <cstdio>
#include <cstdint>

#define LAS __attribute__((address_space(3)))
#define GAS __attribute__((address_space(1)))
typedef unsigned short bf16_t;
typedef short bf16x8 __attribute__((ext_vector_type(8)));
typedef short s16x4 __attribute__((ext_vector_type(4)));
typedef float f32x2 __attribute__((ext_vector_type(2)));
typedef float f32x4 __attribute__((ext_vector_type(4)));
typedef float f32x16 __attribute__((ext_vector_type(16)));
typedef unsigned u32x2 __attribute__((ext_vector_type(2)));
typedef unsigned u32x4 __attribute__((ext_vector_type(4)));
typedef GAS unsigned gu32;

constexpr int DM = 1024, NBATCH = 16, SEQ = 4096, DEPTH = 4, CTXL = 256;
constexpr int NLAT = NBATCH * SEQ, NCTX = NBATCH * CTXL, NTOK = NLAT + NCTX;
constexpr int D_IN = 2080, NIN_PAD = 2304;
constexpr int NEXP = 16, DEXP = 256;
constexpr int NWAVES = 8, NTHREADS = 512;
constexpr float LN_EPS = 1e-5f, RMS_EPS = 1e-6f;
constexpr float DN_ALPHA = 1.6817928305074292f;
constexpr float LOG2E = 1.4426950408889634f;
constexpr float DA_QSCALE = 0.17677669529663687f * LOG2E;
constexpr float MLA_QSCALE = 0.10206207261596577f * LOG2E;
constexpr int NCHUNK_LAT = NLAT / 32, NCHUNK = NTOK / 32;

constexpr size_t MiB = 1u << 20;
constexpr size_t WS_CTL = 0, CTL_ZERO_BYTES = 1 * MiB;
constexpr size_t WS_MOD = 1 * MiB;
constexpr size_t WS_ROT = 3 * MiB;
constexpr size_t WS_SSQ = 4 * MiB;
constexpr size_t WS_ROUTE = 7 * MiB;
constexpr size_t WS_LIST = 154 * MiB;
constexpr size_t WS_LSUM = 14 * MiB;
constexpr size_t WS_LCAR = 23 * MiB;
constexpr size_t WS_WG = 28 * MiB;
constexpr size_t WS_WUQ = 29 * MiB;
constexpr size_t WS_WUKV = 31 * MiB;
constexpr size_t WS_WIN = 32 * MiB;
constexpr size_t WS_WOUT = 50 * MiB;
constexpr size_t WS_W13 = 58 * MiB;
constexpr size_t WS_W2 = 122 * MiB;
constexpr size_t WS_XC = 154 * MiB;
constexpr size_t WS_R1 = 170 * MiB;
constexpr size_t WS_R2 = 306 * MiB;
constexpr size_t WS_R3 = 442 * MiB;
constexpr size_t WS_R4 = 578 * MiB;
constexpr size_t WS_U = WS_R1, WS_MIX = WS_R1;
constexpr size_t WS_O = WS_R2, WS_F0 = WS_R2, WS_QD = WS_R2, WS_KD = WS_R2 + 51 * MiB, WS_XL = WS_R2 + 102 * MiB;
constexpr size_t WS_V = WS_R3, WS_F1 = WS_R3, WS_VD = WS_R3, WS_KN = WS_R3 + 51 * MiB, WS_GG = WS_R3 + 102 * MiB;
constexpr size_t WS_VM = WS_R4, WS_QM = WS_R4 + 51 * MiB, WS_CQ = WS_R4 + 128 * MiB, WS_CKV = WS_R4 + 162 * MiB, WS_KR = WS_R4 + 179 * MiB, WS_H = WS_R4;
constexpr size_t WS_XB = WS_R4 + 184 * MiB;
constexpr size_t WS_SSP = WS_XB + 136 * MiB;
constexpr size_t WS_END = WS_SSP + 4 * MiB;
static_assert((size_t)NTOK * 384 * 2 <= 51 * MiB && (size_t)NTOK * 256 * 2 <= 34 * MiB && (size_t)NTOK * 576 * 2 <= 77 * MiB && (size_t)NTOK * 1024 * 2 == 136 * MiB, "ws map");
static_assert((size_t)(2 * NTOK + 256) * 256 * 2 <= 128 * MiB, "H overlay");
constexpr int CW_BAR = 4096;
constexpr int CW_CNT = 2048;

constexpr int RING_BYTES = 155648;
constexpr int ROT_OFF = RING_BYTES;
constexpr int MISC_OFF = ROT_OFF + 4096;

constexpr int LDS_BYTES = 163840;

#define LDS_WAIT() asm volatile("s_waitcnt lgkmcnt(0)" ::: "memory")
#define VM_WAIT() asm volatile("s_waitcnt vmcnt(0)" ::: "memory")
__device__ __forceinline__ unsigned f2bf(float f) { unsigned u = __builtin_bit_cast(unsigned, f); return (u + 0x7fffu + ((u >> 16) & 1u)) >> 16; }
__device__ __forceinline__ unsigned pk2(float lo, float hi) { return f2bf(lo) | (f2bf(hi) << 16); }
typedef float f32x2_t __attribute__((ext_vector_type(2))); typedef __bf16 bf16x2_t __attribute__((ext_vector_type(2)));
__device__ __forceinline__ unsigned cvt_pk_bf16(float lo, float hi) { f32x2_t v = {lo, hi}; bf16x2_t b = __builtin_convertvector(v, bf16x2_t); return __builtin_bit_cast(unsigned, b); }
__device__ __forceinline__ float bf2f(unsigned h) { return __uint_as_float(h << 16); }
__device__ __forceinline__ float bflo(unsigned w) { return __uint_as_float(w << 16); }
__device__ __forceinline__ float bfhi(unsigned w) { return __uint_as_float(w & 0xffff0000u); }
template <int CTRL> __device__ __forceinline__ float dpp_f(float v) { return __builtin_bit_cast(float, __builtin_amdgcn_update_dpp(0, __builtin_bit_cast(int, v), CTRL, 0xF, 0xF, true)); }
__device__ __forceinline__ float wave_sum(float v) {
    v += dpp_f<0xB1>(v); v += dpp_f<0x4E>(v); v += dpp_f<0x124>(v); v += dpp_f<0x128>(v);
    { auto rr = __builtin_amdgcn_permlane16_swap(__float_as_uint(v), __float_as_uint(v), false, false); v = __uint_as_float(rr[0]) + __uint_as_float(rr[1]); }
    { auto rr = __builtin_amdgcn_permlane32_swap(__float_as_uint(v), __float_as_uint(v), false, false); v = __uint_as_float(rr[0]) + __uint_as_float(rr[1]); }
    return v;
}
__device__ __forceinline__ float fast_exp2(float x) { return __builtin_amdgcn_exp2f(x); }
__device__ __forceinline__ float fast_rcp(float x) { return __builtin_amdgcn_rcpf(x); }
__device__ __forceinline__ float sigmoidf_(float x) { return fast_rcp(1.0f + fast_exp2(-LOG2E * x)); }
__device__ __forceinline__ float gelu_tanh(float x) { const float z = 0.7978845608028654f * (x + 0.044715f * x * x * x); return x * fast_rcp(1.0f + fast_exp2(-2.0f * LOG2E * z)); }
constexpr int WIDTAB_OFF = 159744 + 512;
__device__ __forceinline__ int otid() {
    const unsigned hw = (unsigned)__builtin_amdgcn_s_getreg((5 << 11) | (0 << 6) | 4) & 63u;
    int w = ((const LAS int*)(size_t)WIDTAB_OFF)[hw];
    int t = (w << 6) | (int)__builtin_amdgcn_mbcnt_hi(~0u, __builtin_amdgcn_mbcnt_lo(~0u, 0u));
    asm volatile("" : "+v"(t)); return t; }
__device__ __forceinline__ int crow(int r, int hi) { return (r & 3) + 8 * (r >> 2) + 4 * hi; }
__device__ __forceinline__ f32x16 mfma32(bf16x8 a, bf16x8 b, f32x16 c) { return __builtin_amdgcn_mfma_f32_32x32x16_bf16(a, b, c, 0, 0, 0); }

#define XB_TMO      128
#define XB_XCNT(j)  (256  + 64 * (j))
#define XB_XSUB(j)  (1280 + 64 * (j))
#define XB_XGEN(j)  (2304 + 64 * (j))
#define XB_TOP      3328
#define XB_TOPGEN   3392
#define XCD_BAR_WORDS 3456
#define XB_SPIN_CAP (1u << 18)

__device__ __forceinline__ unsigned xb_ld(unsigned* p)              { return __hip_atomic_load(p, __ATOMIC_RELAXED, __HIP_MEMORY_SCOPE_AGENT); }
__device__ __forceinline__ unsigned xb_add(unsigned* p, unsigned v) { return __hip_atomic_fetch_add(p, v, __ATOMIC_RELAXED, __HIP_MEMORY_SCOPE_AGENT); }
__device__ __forceinline__ unsigned xb_xcc_id() { return (unsigned)__builtin_amdgcn_s_getreg((3 << 11) | 20) & 0xFu; }
#define XB_SPIN(cond, bar) do { unsigned _sp = 0; while (cond) { __builtin_amdgcn_s_sleep(1); \
    if ((++_sp & 255u) == 0u) { if (xb_ld(&(bar)[XB_TMO])) break; if (_sp > XB_SPIN_CAP) { atomicAdd(&(bar)[XB_TMO], 1u); break; } } } } while (0)

struct XcdBarrier {
    unsigned* bar; unsigned x;
    volatile LAS unsigned* st;
};

__device__ __forceinline__ XcdBarrier xcd_barrier_post(unsigned* bar, volatile LAS unsigned* st) {
    XcdBarrier b; b.bar = bar; b.x = xb_xcc_id(); b.st = st;
    if (threadIdx.x == 0) (void)xb_add(&bar[XB_XCNT(b.x)], 1u);
    return b;
}
__device__ __forceinline__ void xcd_barrier_complete(unsigned* bar, unsigned x, unsigned& nloc, unsigned& nx) {
    const unsigned G = gridDim.x * gridDim.y * gridDim.z;
    unsigned sum, cnt, mine, sp = 0u;
    for (;;) {
        sum = 0u; cnt = 0u; mine = 0u;
#pragma unroll
        for (unsigned j = 0; j < 16; ++j) { const unsigned c = xb_ld(&bar[XB_XCNT(j)]); sum += c; cnt += (c > 0u) ? 1u : 0u; mine = (j == x) ? c : mine; }
        if (sum == G) break;
        __builtin_amdgcn_s_sleep(1);
        if ((++sp & 255u) == 0u) { if (xb_ld(&bar[XB_TMO])) break; if (sp > XB_SPIN_CAP) { atomicAdd(&bar[XB_TMO], 1u); break; } }
    }
    nloc = mine > 0u ? mine : 1u; nx = cnt > 0u ? cnt : 1u;
}

__device__ __forceinline__ void xcd_barrier(const XcdBarrier& b) {
    asm volatile("s_waitcnt vmcnt(0)" ::: "memory");
    __syncthreads();
    if (otid() == 0) {
        unsigned* bar = b.bar; unsigned bx_ = b.x; asm volatile("" : "+s"(bar), "+s"(bx_));
        __builtin_amdgcn_s_waitcnt(0);
        unsigned nloc = b.st[0], nx = b.st[1];
        if (nloc == 0u) { xcd_barrier_complete(bar, bx_, nloc, nx); b.st[0] = nloc; b.st[1] = nx; }
        const unsigned old = xb_add(&bar[XB_XSUB(bx_)], 1u);
        const unsigned gen = old / nloc;
        if (old + 1u == (gen + 1u) * nloc) {
            __builtin_amdgcn_fence(__ATOMIC_RELEASE, "agent");
            asm volatile("s_waitcnt vmcnt(0)" ::: "memory");
            const unsigned og = xb_add(&bar[XB_TOP], 1u);
            const unsigned tg = og / nx;
            if (og + 1u == (tg + 1u) * nx) xb_add(&bar[XB_TOPGEN], 1u);
            else XB_SPIN(xb_ld(&bar[XB_TOPGEN]) == tg, bar);
            __builtin_amdgcn_fence(__ATOMIC_ACQUIRE, "agent");
            xb_add(&bar[XB_XGEN(bx_)], 1u);
            asm volatile("s_waitcnt vmcnt(0)" ::: "memory");
        } else {
            XB_SPIN(xb_ld(&bar[XB_XGEN(bx_)]) == gen, bar);
            __builtin_amdgcn_fence(__ATOMIC_ACQUIRE, "agent");
            asm volatile("s_waitcnt vmcnt(0)" ::: "memory");
        }
    }
    __syncthreads();
}

namespace pg8 {
constexpr int BM = 256, BK = 64, HALF = 128, HTB = HALF * BK * 2  , STAGE_BYTES = 8 * HTB, NXCD = 8, WGM = 8;
__host__ __device__ __forceinline__ int lds_byte(int r, int c) { const int st = (r >> 4) * 2 + (c >> 5), rr = r & 15, cc = c & 31, ob = rr * 64 + cc * 2; return st * 1024 + (ob ^ (((ob >> 9) & 1) << 5)); }
__host__ __device__ __forceinline__ void stage_rc(int b, int& R, int& C) { const int st = b / 1024, sb = b % 1024, swz = sb ^ (((sb >> 9) & 1) << 5); R = (st >> 1) * 16 + swz / 64; C = (st & 1) * 32 + (swz % 64) / 2; }
__host__ __device__ __forceinline__ int perm32(int rho) { const int n = rho >> 4, i = rho & 15; return 8 * (i >> 2) + 4 * n + (i & 3); }

struct Unit { int arow, brow, pm, pn, e, nvalid; };

struct StaticOrder {
    int nM, nN, nwg, G, c;
    __device__ void init(int M, int N, int G_, int c_) { nM = M / BM; nN = N / BM; nwg = nM * nN; G = G_; c = c_; }
    __device__ bool next(int i, Unit& u) const {
        const long L = (long)i * G + c; if (L >= nwg) return false;
        int wgid = (int)L; { const int q = nwg / NXCD, r = nwg % NXCD, xcd = wgid % NXCD, off = wgid / NXCD; wgid = (xcd < r ? xcd * (q + 1) : r * (q + 1) + (xcd - r) * q) + off; }
        const int nig = WGM * nN, gid = wgid / nig, fm = gid * WGM, gsz = (nM - fm) < WGM ? (nM - fm) : WGM;
        u.pm = fm + ((wgid % nig) % gsz); u.pn = (wgid % nig) / gsz; u.arow = u.pm * BM; u.brow = u.pn * BM; u.e = 0; u.nvalid = BM; return true;
    }
    __device__ __forceinline__ unsigned goff(const Unit&, int) const { return 0u; }
};

template <class Epi, class Sched, bool GATHER>
__device__ __forceinline__ void gemm_phase(LAS unsigned char* lds, const bf16_t* Ag, const bf16_t* Btg, const int K_, const Sched& S, const Epi& E) {
    int K = K_; asm volatile("" : "+s"(K));
    const int tid = otid(), wid = __builtin_amdgcn_readfirstlane(tid >> 6), lane = tid & 63, wr = wid >> 2, wc = wid & 3, fr = lane & 15, fq = lane >> 4;
    const int nt = K / BK;
    unsigned voffA[2], voffB[2];
#pragma unroll
    for (int i = 0; i < 2; ++i) { int R, C; stage_rc(tid * 16 + i * 8192, R, C); const int Rb = (R & ~31) + perm32(R & 31);
        voffA[i] = (unsigned)(R * K + C) * 2u; voffB[i] = (unsigned)(Rb * K + C) * 2u; }
    const size_t kstep = (size_t)(BK * 2);
    const size_t hstep = (size_t)HALF * K * 2;
    const unsigned ldsw = (unsigned)wid * 1024u;
    const int aoff = lds_byte(wr * 64 + fr, fq * 8), boff = lds_byte(wc * 32 + fr, fq * 8);
    unsigned vAc[2][2], vAn[2][2];
#define PG8_SA(b, h) (((b) * 2 + (h)) * HTB)
#define PG8_SB(b, h) ((4 + (b) * 2 + (h)) * HTB)
#define PG8_STAGE(bufoff, gbase, voff) do { _Pragma("unroll") for (int _i = 0; _i < 2; ++_i) \
        __builtin_amdgcn_global_load_lds((const unsigned*)((const char*)(gbase) + (voff)[_i]), (LAS unsigned*)(lds + (bufoff) + ldsw + _i * 8192), 16, 0, 0); } while (0)
#define PG8_STAGE_A(bufoff, base, h, nx) do { if constexpr (GATHER) { _Pragma("unroll") for (int _i = 0; _i < 2; ++_i) \
        __builtin_amdgcn_global_load_lds((const unsigned*)((const char*)(base) + ((nx) ? vAn[h][_i] : vAc[h][_i])), (LAS unsigned*)(lds + (bufoff) + ldsw + _i * 8192), 16, 0, 0); } \
        else { PG8_STAGE(bufoff, (const char*)(base) + (h) * hstep, voffA); } } while (0)
#define PG8_LDA(dst, b, h) do { _Pragma("unroll") for (int m = 0; m < 4; ++m) _Pragma("unroll") for (int k = 0; k < 2; ++k) dst[m][k] = *(const LAS bf16x8*)(lds + PG8_SA(b, h) + aoff + m * 2048 + k * 1024); } while (0)
#define PG8_LDB(dst, b, h) do { _Pragma("unroll") for (int n = 0; n < 2; ++n) _Pragma("unroll") for (int k = 0; k < 2; ++k) dst[n][k] = *(const LAS bf16x8*)(lds + PG8_SB(b, h) + boff + n * 2048 + k * 1024); } while (0)
#define PG8_MMA(ai, bj, At, Bt) do { __builtin_amdgcn_s_setprio(1); _Pragma("unroll") for (int m = 0; m < 4; ++m) _Pragma("unroll") for (int n = 0; n < 2; ++n) _Pragma("unroll") for (int k = 0; k < 2; ++k) \
        acc[ai][bj][m][n] = __builtin_amdgcn_mfma_f32_16x16x32_bf16(Bt[n][k], At[m][k], acc[ai][bj][m][n], 0, 0, 0); __builtin_amdgcn_s_setprio(0); } while (0)
#define PG8_WAIT_V(n) asm volatile("s_waitcnt vmcnt(" #n ")" ::: "memory")
#define PG8_WAIT_L(n) asm volatile("s_waitcnt lgkmcnt(" #n ")" ::: "memory")
#define PG8_BAR __builtin_amdgcn_s_barrier()
#define PG8_SCHED __builtin_amdgcn_sched_barrier(0)
#define PG8_GOFF(u, v) do { if constexpr (GATHER) { const int _t = otid(); _Pragma("unroll") for (int _i = 0; _i < 2; ++_i) { int _R, _C; stage_rc(_t * 16 + _i * 8192, _R, _C); \
        _Pragma("unroll") for (int _h = 0; _h < 2; ++_h) v[_h][_i] = (S.goff(u, _h * HALF + _R) + (unsigned)_C) * 2u; } } } while (0)
    Unit cur, nxt; int ui = 0;
    if (!S.next(0, cur)) return;
    f32x4 acc[2][2][4][2];
#pragma unroll
    for (int a = 0; a < 2; ++a)
#pragma unroll
        for (int b = 0; b < 2; ++b)
#pragma unroll
            for (int m = 0; m < 4; ++m)
#pragma unroll
                for (int n = 0; n < 2; ++n) acc[a][b][m][n] = (f32x4){0.f, 0.f, 0.f, 0.f};
    bf16x8 At[4][2], B0[2][2], B1[2][2];
    PG8_GOFF(cur, vAc);
#pragma unroll
    for (int _h = 0; _h < 2; ++_h)
#pragma unroll
        for (int _i = 0; _i < 2; ++_i) vAn[_h][_i] = vAc[_h][_i];
    const char* cA = GATHER ? (const char*)Ag : (const char*)Ag + (size_t)cur.arow * K * 2; const char* cB = (const char*)Btg + (size_t)cur.brow * K * 2;
    PG8_STAGE(PG8_SB(0, 0), cB, voffB); PG8_STAGE(PG8_SB(0, 1), cB + hstep, voffB); PG8_STAGE_A(PG8_SA(0, 0), cA, 0, false); PG8_STAGE_A(PG8_SA(0, 1), cA, 1, false);
    if (wr == 1) PG8_BAR;
    PG8_WAIT_V(2); PG8_BAR;
    PG8_STAGE(PG8_SB(1, 0), cB + kstep, voffB); PG8_STAGE_A(PG8_SA(1, 0), cA + kstep, 0, false); PG8_STAGE(PG8_SB(1, 1), cB + hstep + kstep, voffB);
    PG8_WAIT_V(6); PG8_BAR;
    for (;;) {
        const bool has_next = S.next(ui + 1, nxt);
        if (has_next) { PG8_GOFF(nxt, vAn); }
        const char* nA = GATHER ? (const char*)Ag : (has_next ? (const char*)Ag + (size_t)nxt.arow * K * 2 : cA); const char* nB = has_next ? (const char*)Btg + (size_t)nxt.brow * K * 2 : cB;
#pragma nounroll
        for (int t = 0; t < nt; t += 2) {
            const bool last = (t == nt - 2);
            const char* a1 = cA + (size_t)(t + 1) * kstep;
            const char* a2 = last ? nA : cA + (size_t)(t + 2) * kstep; const char* b2 = last ? nB : cB + (size_t)(t + 2) * kstep;
            const char* a3 = a2 + kstep; const char* b3 = b2 + kstep;
            PG8_LDB(B0, 0, 0); PG8_LDB(B1, 0, 1); PG8_SCHED; PG8_LDA(At, 0, 0); PG8_STAGE_A(PG8_SA(1, 1), a1, 1, false);
            PG8_WAIT_V(8); PG8_WAIT_L(0); PG8_BAR; PG8_MMA(0, 0, At, B0); PG8_MMA(0, 1, At, B1); PG8_BAR; PG8_SCHED;
            PG8_LDA(At, 0, 1); PG8_STAGE(PG8_SB(0, 0), b2, voffB); PG8_STAGE(PG8_SB(0, 1), b2 + hstep, voffB); PG8_STAGE_A(PG8_SA(0, 0), a2, 0, last);
            PG8_WAIT_V(8); PG8_WAIT_L(0); PG8_BAR; PG8_MMA(1, 0, At, B0); PG8_MMA(1, 1, At, B1); PG8_BAR; PG8_SCHED;
            PG8_LDB(B0, 1, 0); PG8_LDB(B1, 1, 1); PG8_SCHED; PG8_LDA(At, 1, 0); PG8_STAGE_A(PG8_SA(0, 1), a2, 1, last);
            PG8_WAIT_V(8); PG8_WAIT_L(0); PG8_BAR; PG8_MMA(0, 0, At, B0); PG8_MMA(0, 1, At, B1); PG8_BAR; PG8_SCHED;
            PG8_LDA(At, 1, 1); PG8_STAGE(PG8_SB(1, 0), b3, voffB); PG8_STAGE(PG8_SB(1, 1), b3 + hstep, voffB); PG8_STAGE_A(PG8_SA(1, 0), a3, 0, last);
            PG8_WAIT_V(8); PG8_WAIT_L(0); PG8_BAR; PG8_MMA(1, 0, At, B0); PG8_MMA(1, 1, At, B1); PG8_BAR; PG8_SCHED;
        }
        if (wr == 0) PG8_BAR;
        E(acc, cur, wr, wc, fr, fq);
        if (!has_next) break;
#pragma unroll
        for (int a = 0; a < 2; ++a)
#pragma unroll
            for (int b = 0; b < 2; ++b)
#pragma unroll
                for (int m = 0; m < 4; ++m)
#pragma unroll
                    for (int n = 0; n < 2; ++n) acc[a][b][m][n] = (f32x4){0.f, 0.f, 0.f, 0.f};
        cur = nxt; cA = nA; cB = nB; ++ui;
#pragma unroll
        for (int _h = 0; _h < 2; ++_h)
#pragma unroll
            for (int _i = 0; _i < 2; ++_i) vAc[_h][_i] = vAn[_h][_i];
        if (wr == 1) PG8_BAR;
    }
    PG8_WAIT_V(0);
    PG8_BAR;
#undef PG8_SA
#undef PG8_SB
#undef PG8_STAGE
#undef PG8_STAGE_A
#undef PG8_LDA
#undef PG8_LDB
#undef PG8_MMA
#undef PG8_WAIT_V
#undef PG8_WAIT_L
#undef PG8_BAR
#undef PG8_SCHED
#undef PG8_GOFF
}
}

using pg8::Unit;
__device__ __forceinline__ void st16(bf16_t* p, f32x4 v0, f32x4 v1) { u32x4 w; w.x = cvt_pk_bf16(v0[0], v0[1]); w.y = cvt_pk_bf16(v0[2], v0[3]); w.z = cvt_pk_bf16(v1[0], v1[1]); w.w = cvt_pk_bf16(v1[2], v1[3]); *(u32x4*)p = w; }
__device__ __forceinline__ void st8(bf16_t* p, f32x4 v) { u32x2 w; w.x = cvt_pk_bf16(v[0], v[1]); w.y = cvt_pk_bf16(v[2], v[3]); *(u32x2*)p = w; }

__device__ __forceinline__ void rot4(f32x4& x1, f32x4& x2, const LAS float* rot, int row, int fq) {
    const int t = row & (SEQ - 1), pos = (fq < 2) ? (t >> 6) : (t & 63);
    const f32x4 c = *(const LAS f32x4*)(rot + pos * 8 + 4 * (fq & 1)), s = *(const LAS f32x4*)(rot + 512 + pos * 8 + 4 * (fq & 1));
    const f32x4 a = x1 * c - x2 * s, b = x1 * s + x2 * c; x1 = a; x2 = b;
}

struct EpiInProj {
    bf16_t *XL, *GG, *QD, *KD, *VD, *CQ, *CKV, *KR; float* ssq; const LAS float* rot;
    __device__ __forceinline__ void operator()(const f32x4 (&acc)[2][2][4][2], const Unit& u, int wr, int wc, int fr, int fq) const {
#pragma unroll
        for (int bj = 0; bj < 2; ++bj) {
            const int g = u.pn * 8 + bj * 4 + wc;
            if (g >= 65) continue;
            bf16_t* dst; int pitch, gl, kind = 0, sq = -1; float sc = 1.0f;
            if (g < 8) { dst = XL; pitch = 256; gl = g; }
            else if (g < 16) { dst = GG; pitch = 256; gl = g - 8; kind = 1; }
            else if (g < 28) { dst = QD; pitch = 384; gl = g - 16; kind = 2; sc = DA_QSCALE; }
            else if (g < 40) { dst = KD; pitch = 384; gl = g - 28; kind = 2; }
            else if (g < 52) { dst = VD; pitch = 384; gl = g - 40; }
            else if (g < 60) { dst = CQ; pitch = 256; gl = g - 52; sq = 0; }
            else if (g < 64) { dst = CKV; pitch = 128; gl = g - 60; sq = 1; }
            else { dst = KR; pitch = 32; gl = 0; kind = 2; }
#pragma unroll
            for (int ai = 0; ai < 2; ++ai)
#pragma unroll
                for (int m = 0; m < 4; ++m) {
                    const int row = u.pm * 256 + ai * 128 + wr * 64 + m * 16 + fr;
                    f32x4 v0 = acc[ai][bj][m][0], v1 = acc[ai][bj][m][1];
                    bf16_t* rp = dst + (size_t)row * pitch + gl * 32;
                    if (kind == 2) {
                        if (row < NLAT) rot4(v0, v1, rot, row, fq);
                        v0 = v0 * sc; v1 = v1 * sc;
                        st8(rp + 4 * fq, v0); st8(rp + 16 + 4 * fq, v1);
                    } else {
                        if (kind == 1) {
#pragma unroll
                            for (int j = 0; j < 4; ++j) { v0[j] = gelu_tanh(v0[j]); v1[j] = gelu_tanh(v1[j]); }
                        }
                        if (sq >= 0) {
                            float s = (v0[0] * v0[0] + v0[1] * v0[1]) + (v0[2] * v0[2] + v0[3] * v0[3]) + (v1[0] * v1[0] + v1[1] * v1[1]) + (v1[2] * v1[2] + v1[3] * v1[3]);
                            s += __shfl_xor(s, 16); s += __shfl_xor(s, 32);
                            if (fq == 0) ssq[(size_t)row * 12 + (g - 52)] = s;
                        }
                        st16(rp + 8 * fq, v0, v1);
                    }
                }
        }
    }
};

struct EpiExpQ {
    bf16_t* QM; const float* ssq; const LAS float* rot;
    __device__ __forceinline__ void operator()(const f32x4 (&acc)[2][2][4][2], const Unit& u, int wr, int wc, int fr, int fq) const {
        float rs[2][4];
#pragma unroll
        for (int ai = 0; ai < 2; ++ai)
#pragma unroll
            for (int m = 0; m < 4; ++m) { const int row = u.pm * 256 + ai * 128 + wr * 64 + m * 16 + fr; const f32x4 pa_ = *(const f32x4*)(ssq + (size_t)row * 12), pb_ = *(const f32x4*)(ssq + (size_t)row * 12 + 4);
                rs[ai][m] = rsqrtf((((pa_[0] + pa_[1]) + (pa_[2] + pa_[3])) + ((pb_[0] + pb_[1]) + (pb_[2] + pb_[3]))) * (1.0f / 256.0f) + RMS_EPS) * MLA_QSCALE; }
#pragma unroll
        for (int bj = 0; bj < 2; ++bj) {
            const int g = u.pn * 8 + bj * 4 + wc;
            if (g >= 18) continue;
            const int head = g / 3, part = g % 3;
#pragma unroll
            for (int ai = 0; ai < 2; ++ai)
#pragma unroll
                for (int m = 0; m < 4; ++m) {
                    const int row = u.pm * 256 + ai * 128 + wr * 64 + m * 16 + fr;
                    f32x4 v0 = acc[ai][bj][m][0] * rs[ai][m], v1 = acc[ai][bj][m][1] * rs[ai][m];
                    bf16_t* rp = QM + (size_t)row * 576 + head * 96 + part * 32;
                    if (part == 2) { if (row < NLAT) rot4(v0, v1, rot, row, fq); st8(rp + 4 * fq, v0); st8(rp + 16 + 4 * fq, v1); }
                    else st16(rp + 8 * fq, v0, v1);
                }
        }
    }
};
struct EpiExpKV {
    bf16_t *KN, *VM; const float* ssq;
    __device__ __forceinline__ void operator()(const f32x4 (&acc)[2][2][4][2], const Unit& u, int wr, int wc, int fr, int fq) const {
        float rs[2][4];
#pragma unroll
        for (int ai = 0; ai < 2; ++ai)
#pragma unroll
            for (int m = 0; m < 4; ++m) { const int row = u.pm * 256 + ai * 128 + wr * 64 + m * 16 + fr; const f32x4 pc_ = *(const f32x4*)(ssq + (size_t)row * 12 + 8);
                rs[ai][m] = rsqrtf(((pc_[0] + pc_[1]) + (pc_[2] + pc_[3])) * (1.0f / 128.0f) + RMS_EPS); }
#pragma unroll
        for (int bj = 0; bj < 2; ++bj) {
            const int g = u.pn * 8 + bj * 4 + wc;
            const int head = g >> 2, part = g & 3;
            bf16_t* base = (part < 2 ? KN : VM) + head * 64 + (part & 1) * 32 + 8 * fq;
#pragma unroll
            for (int ai = 0; ai < 2; ++ai)
#pragma unroll
                for (int m = 0; m < 4; ++m) {
                    const int row = u.pm * 256 + ai * 128 + wr * 64 + m * 16 + fr;
                    st16(base + (size_t)row * 384, acc[ai][bj][m][0] * rs[ai][m], acc[ai][bj][m][1] * rs[ai][m]);
                }
        }
    }
};
struct EpiPlain {
    bf16_t* O; int ldc;
    __device__ __forceinline__ void operator()(const f32x4 (&acc)[2][2][4][2], const Unit& u, int wr, int wc, int fr, int fq) const {
#pragma unroll
        for (int ai = 0; ai < 2; ++ai)
#pragma unroll
            for (int m = 0; m < 4; ++m) {
                bf16_t* rp = O + (size_t)(u.pm * 256 + ai * 128 + wr * 64 + m * 16 + fr) * ldc + u.pn * 256 + wc * 32 + 8 * fq;
#pragma unroll
                for (int bj = 0; bj < 2; ++bj) st16(rp + bj * 128, acc[ai][bj][m][0], acc[ai][bj][m][1]);
            }
    }
};

struct MoeSched {
    const LAS int* tb;
    const unsigned* list;
    int G, c, ncol;
    __device__ bool next(int i, Unit& u) const {
        const int L = i * G + c, T = tb[33 + 16];
        if (L >= T * ncol) return false;
        const int tl = L / ncol; u.pn = L % ncol;
        int e = 0;
#pragma unroll
        for (int k = 1; k < 16; ++k) e += (tl >= tb[33 + k]) ? 1 : 0;
        u.e = e; u.pm = tl - tb[33 + e]; u.nvalid = tb[e] - u.pm * 256; if (u.nvalid > 256) u.nvalid = 256;
        u.arow = tb[16 + e] + u.pm * 256; u.brow = (e * ncol + u.pn) * 256;
        return true;
    }
    __device__ __forceinline__ unsigned goff(const Unit& u, int r) const {
        const int rc = r < u.nvalid ? r : u.nvalid - 1; const unsigned ent = list[((size_t)u.e * NTOK + u.pm * 256 + rc) * 2];
        return (ent >> 1) * 1024u;
    }
};
struct EpiMoeUp {
    bf16_t* H;
    __device__ __forceinline__ void operator()(const f32x4 (&acc)[2][2][4][2], const Unit& u, int wr, int wc, int fr, int fq) const {
#pragma unroll
        for (int ai = 0; ai < 2; ++ai)
#pragma unroll
            for (int m = 0; m < 4; ++m) {
                const int r = ai * 128 + wr * 64 + m * 16 + fr;
                if (r < u.nvalid) {
                    bf16_t* rp = H + (size_t)(u.arow + r) * 256 + (u.pn & 1) * 128 + wc * 16 + 4 * fq;
#pragma unroll
                    for (int bj = 0; bj < 2; ++bj) { const f32x4 a = acc[ai][bj][m][0], b = acc[ai][bj][m][1]; f32x4 h;
#pragma unroll
                        for (int j = 0; j < 4; ++j) h[j] = a[j] * sigmoidf_(a[j]) * b[j];
                        st8(rp + bj * 64, h); }
                }
            }
    }
};
struct EpiMoeDown {
    bf16_t *F0, *F1; const unsigned* list; const float* route;
    __device__ __forceinline__ void operator()(const f32x4 (&acc)[2][2][4][2], const Unit& u, int wr, int wc, int fr, int fq) const {
        const u32x2* lp = (const u32x2*)list + (size_t)u.e * NTOK + u.pm * 256;
#pragma unroll
        for (int ai = 0; ai < 2; ++ai) {
            u32x2 ew[4];
#pragma unroll
            for (int m = 0; m < 4; ++m) { const int r = ai * 128 + wr * 64 + m * 16 + fr; const int rc = r < u.nvalid ? r : u.nvalid - 1; ew[m] = lp[rc]; }
#pragma unroll
            for (int m = 0; m < 4; ++m) {
                const int r = ai * 128 + wr * 64 + m * 16 + fr;
                if (r < u.nvalid) {
                    const unsigned tok = ew[m].x >> 1, kk = ew[m].x & 1u; const float ww = __uint_as_float(ew[m].y);
                    bf16_t* rp = F0 + (size_t)kk * (size_t)(F1 - F0) + (size_t)tok * 1024 + u.pn * 256 + wc * 32 + 8 * fq;
#pragma unroll
                    for (int bj = 0; bj < 2; ++bj) st16(rp + bj * 128, acc[ai][bj][m][0] * ww, acc[ai][bj][m][1] * ww);
                }
            }
            asm volatile("" ::: "memory");
        }
    }
};


__device__ __forceinline__ unsigned cvtpk_s(float lo, float hi) { f32x2_t v = {lo, hi}; bf16x2_t b = __builtin_convertvector(v, bf16x2_t); return __builtin_bit_cast(unsigned, b); }
__device__ __forceinline__ float max3f(float a, float b, float c) { float r; asm("v_max3_f32 %0, %1, %2, %3" : "=v"(r) : "v"(a), "v"(b), "v"(c)); return r; }
__device__ __forceinline__ float max2f(float a, float b) { float r; asm("v_max_f32_e32 %0, %1, %2" : "=v"(r) : "v"(a), "v"(b)); return r; }
__device__ __forceinline__ float mx2(float a, float b) { return __builtin_elementwise_maximum(a, b); }
__device__ __forceinline__ float rowmax32_fast(f32x16& p0, f32x16& p1) {
    float a = mx2(mx2(p0[0], p0[1]), p1[0]), b = mx2(mx2(p0[2], p0[3]), p1[1]); a = mx2(mx2(a, p1[2]), p1[3]);
#pragma unroll
    for (int r = 4; r < 16; r += 4) { a = mx2(mx2(a, p0[r]), p0[r + 1]); b = mx2(mx2(b, p0[r + 2]), p0[r + 3]); a = mx2(mx2(a, p1[r]), p1[r + 1]); b = mx2(mx2(b, p1[r + 2]), p1[r + 3]); }
    const float m = mx2(a, b);
    auto rr = __builtin_amdgcn_permlane32_swap(__float_as_uint(m), __float_as_uint(m), false, false);
    return mx2(__uint_as_float(rr[0]), __uint_as_float(rr[1]));
}
__device__ __forceinline__ bf16x8 pack8(const f32x16& p, const int b) { u32x4 w; w.x = cvtpk_s(p[b], p[b + 1]); w.y = cvtpk_s(p[b + 2], p[b + 3]); w.z = cvtpk_s(p[b + 4], p[b + 5]); w.w = cvtpk_s(p[b + 6], p[b + 7]); return __builtin_bit_cast(bf16x8, w); }
#define VTR_RD(dst, addr, off) asm volatile("ds_read_b64_tr_b16 %0, %1 offset:%c2" : "=&v"(dst) : "v"(addr), "i"(off) : "memory")
#define PV_BLOCK(vb_, db_, BODY) do { s16x4 lo_[4], hi_[4]; \
    _Pragma("unroll") for (int ks = 0; ks < 4; ++ks) { VTR_RD(lo_[ks], vb_, (db_) * 4096 + ks * 1024); VTR_RD(hi_[ks], vb_, (db_) * 4096 + ks * 1024 + 512); } \
    asm volatile("s_waitcnt lgkmcnt(0)" ::: "memory"); __builtin_amdgcn_sched_barrier(0); \
    _Pragma("unroll") for (int ks = 0; ks < 4; ++ks) { const bf16x8 vf = (bf16x8){lo_[ks][0], lo_[ks][1], lo_[ks][2], lo_[ks][3], hi_[ks][0], hi_[ks][1], hi_[ks][2], hi_[ks][3]}; BODY; } } while (0)
namespace attd {
typedef short v4i16_t __attribute__((ext_vector_type(4)));
constexpr float THR = 6.0f;
__device__ __forceinline__ float rowmax32(f32x16& p0, f32x16& p1) { return rowmax32_fast(p0, p1); }
struct Sm { float mhat, l; };
__device__ __forceinline__ void softmax_tile(f32x16& p0, f32x16& p1, Sm& st, f32x16 (&o)[2], const bool first, LAS float* wsf, const int r32, const int hi, bf16x8 (&pa)[4], f32x16& negm) {
    const float rm = rowmax32(p0, p1);
    if (first || __any(rm > THR)) {
        const float dl = first ? rm : fmaxf(rm, 0.f);
        st.mhat += dl;
#pragma unroll
        for (int r = 0; r < 16; ++r) { p0[r] -= dl; p1[r] -= dl; negm[r] = -st.mhat; }
        const float f = fminf(fast_exp2(-dl), 3.0e38f); st.l *= f;
        if (hi == 0) wsf[r32] = f;
        LDS_WAIT();
#pragma unroll
        for (int r = 0; r < 16; ++r) { const float fr_ = wsf[crow(r, hi)]; o[0][r] *= fr_; o[1][r] *= fr_; }
    }
    float s = 0.f;
#pragma unroll
    for (int r = 0; r < 16; ++r) { p0[r] = fast_exp2(p0[r]); p1[r] = fast_exp2(p1[r]); s = (s + p0[r]) + p1[r]; }
    st.l += s;
    pa[0] = pack8(p0, 0); pa[1] = pack8(p0, 8); pa[2] = pack8(p1, 0); pa[3] = pack8(p1, 8);
}
__device__ __forceinline__ void glds16(const bf16_t* src, LAS unsigned char* dst) { __builtin_amdgcn_global_load_lds((const unsigned*)src, (LAS unsigned*)dst, 16, 0, 0); }

#define KRD16(dst, addr, off) asm volatile("ds_read_b128 %0, %1 offset:%c2" : "=&v"(dst) : "v"(addr), "i"(off) : "memory")
#define MFMA_C(D, A, B, C) asm("v_mfma_f32_32x32x16_bf16 %0, %1, %2, %3" : "=&v"(D) : "v"(A), "v"(B), "v"(C))
struct Tens {
    const bf16_t* Q; int qpitch, qcol;
    const bf16_t* K; const bf16_t* KR; const bf16_t* V; int kvcol;
    bf16_t* O; int ocol;
    float lam, onem; const float* dn;
};
template <int MODE>
__device__ __forceinline__ void attn_unit(LAS unsigned char* lds, const Tens& T, const int b, const bool ctxq, const int qb) {
    constexpr int NCH = MODE ? 12 : 8, KSLOT = NCH * 1024, SLOT = KSLOT + 8192, NSLOT = 6;
    constexpr int WS_OFF = NSLOT * SLOT, OST_OFF = 0, QS_OFF = WS_OFF + 8 * 512;
    static_assert((MODE == 1 ? WS_OFF + 8 * 512 : QS_OFF + 8 * 4096) <= RING_BYTES && 8 * 8192 <= WS_OFF, "attention LDS");
    const int tid = otid(), lane = tid & 63, r32 = lane & 31, hi = lane >> 5, wid = __builtin_amdgcn_readfirstlane(tid >> 6);
    const int NT = ctxq ? 4 : 68;
    const int krow_ctx = NLAT + b * CTXL, krow_lat = b * SEQ;
    const int qrow0 = (ctxq ? krow_ctx : krow_lat + qb * 256) + wid * 32;
    LAS float* wsf = (LAS float*)(lds + WS_OFF + wid * 512);
    LAS float* stg = (LAS float*)(lds + OST_OFF + wid * 8192);
    static_assert(MODE == 0, "attd: differential attention only");
    const int kswz = (4 * (wid & 1) + (lane >> 4)) & 7;
#define ATT_ISSUE(t_) do { const int kr_ = ((t_) < 4) ? krow_ctx + 64 * (t_) : krow_lat + 64 * ((t_) - 4); const int so_ = ((t_) % NSLOT) * SLOT; \
        glds16(T.K + (size_t)(kr_ + 8 * wid + (lane >> 3)) * 384 + T.kvcol + (((lane & 7) ^ kswz) << 3), lds + so_ + wid * 1024); \
        glds16(T.V + (size_t)(kr_ + 16 * (wid & 3) + (lane >> 2)) * 384 + T.kvcol + (wid >> 2) * 32 + (lane & 3) * 8, lds + so_ + KSLOT + wid * 1024); } while (0)
    constexpr int NQ = MODE ? 6 : 4;
    bf16x8 qr[NQ];
    { const bf16_t* qp = T.Q + (size_t)(qrow0 + r32) * T.qpitch + T.qcol + hi * 8;
#pragma unroll
      for (int d0 = 0; d0 < NQ; ++d0) { const bf16x8 q = *(const bf16x8*)(qp + d0 * 16); if (MODE == 1) qr[d0] = q; else *(LAS bf16x8*)(lds + QS_OFF + wid * 4096 + d0 * 1024 + lane * 16) = q; } }
    const LAS unsigned char* ql = lds + QS_OFF + wid * 4096 + lane * 16;
    ATT_ISSUE(0); ATT_ISSUE(1); ATT_ISSUE(2); ATT_ISSUE(3);
    Sm st1{0.f, 0.f}, st2{0.f, 0.f};
    f32x16 o1[2], o2[2];
#pragma unroll
    for (int r = 0; r < 16; ++r) { o1[0][r] = 0.f; o1[1][r] = 0.f; o2[0][r] = 0.f; o2[1][r] = 0.f; }
    const int vlane = ((lane >> 4) & 1) * 32 + (lane & 3) * 8 + (4 * hi + ((lane & 15) >> 2)) * 64;
    f32x16 negm1, negm2;
#pragma unroll
    for (int r = 0; r < 16; ++r) { negm1[r] = 0.f; negm2[r] = 0.f; }
    for (int tp = 0; tp < NT; tp += 2) {
        if (tp + 2 < NT) { if (MODE == 1 && wid < 4) asm volatile("s_waitcnt vmcnt(6)" ::: "memory"); else asm volatile("s_waitcnt vmcnt(4)" ::: "memory"); }
        else asm volatile("s_waitcnt vmcnt(0)" ::: "memory");
        LDS_WAIT(); __builtin_amdgcn_s_barrier(); asm volatile("" ::: "memory");
        if (tp + 4 < NT) { ATT_ISSUE(tp + 4); ATT_ISSUE(tp + 5); }
#pragma unroll 1
      for (int t = tp; t < tp + 2; ++t) {
        const int s_cur = (t % NSLOT) * SLOT;
        const unsigned ka0 = (unsigned)(size_t)lds + s_cur + r32 * 128 + (((((r32 >> 1) & 7) ^ hi)) << 4);
        const unsigned vb = (unsigned)(size_t)(lds + s_cur + KSLOT + vlane);
        bf16x8 pa1[4], pa2[4];
        {
            f32x16 p10, p11, p20, p21; s16x4 vlo[4], vhi[4];
            { bf16x8 kf[8], qf[4]; const unsigned qb_ = (unsigned)(size_t)ql;
#pragma unroll
              for (int d0 = 0; d0 < 4; ++d0) { const unsigned kb_ = ka0 ^ (d0 << 5); KRD16(kf[2 * d0], kb_, 0); KRD16(kf[2 * d0 + 1], kb_, 4096); KRD16(qf[d0], qb_, d0 * 1024); }
              asm volatile("s_waitcnt lgkmcnt(6)" ::: "memory"); __builtin_amdgcn_sched_barrier(0);
              MFMA_C(p10, kf[0], qf[0], negm1); MFMA_C(p11, kf[1], qf[0], negm1); p10 = mfma32(kf[2], qf[1], p10); p11 = mfma32(kf[3], qf[1], p11);
              __builtin_amdgcn_sched_barrier(0);
#pragma unroll
              for (int ks = 0; ks < 4; ++ks) { VTR_RD(vlo[ks], vb, ks * 1024); VTR_RD(vhi[ks], vb, ks * 1024 + 512); }
              asm volatile("s_waitcnt lgkmcnt(8)" ::: "memory"); __builtin_amdgcn_sched_barrier(0);
              MFMA_C(p20, kf[4], qf[2], negm2); MFMA_C(p21, kf[5], qf[2], negm2); p20 = mfma32(kf[6], qf[3], p20); p21 = mfma32(kf[7], qf[3], p21);
              asm volatile("s_waitcnt lgkmcnt(0)" ::: "memory"); __builtin_amdgcn_sched_barrier(0); }
            softmax_tile(p10, p11, st1, o1, t == 0, wsf, r32, hi, pa1, negm1);
            softmax_tile(p20, p21, st2, o2, t == 0, wsf + 32, r32, hi, pa2, negm2);
            __builtin_amdgcn_sched_barrier(0);
            { s16x4 wlo[4], whi[4];
#pragma unroll
              for (int ks = 0; ks < 4; ++ks) { VTR_RD(wlo[ks], vb, 4096 + ks * 1024); VTR_RD(whi[ks], vb, 4096 + ks * 1024 + 512); }
#pragma unroll
              for (int ks = 0; ks < 4; ++ks) { const bf16x8 vf = (bf16x8){vlo[ks][0], vlo[ks][1], vlo[ks][2], vlo[ks][3], vhi[ks][0], vhi[ks][1], vhi[ks][2], vhi[ks][3]};
                  o1[0] = mfma32(pa1[ks], vf, o1[0]); o2[0] = mfma32(pa2[ks], vf, o2[0]); }
              asm volatile("s_waitcnt lgkmcnt(0)" ::: "memory"); __builtin_amdgcn_sched_barrier(0);
#pragma unroll
              for (int ks = 0; ks < 4; ++ks) { const bf16x8 vf = (bf16x8){wlo[ks][0], wlo[ks][1], wlo[ks][2], wlo[ks][3], whi[ks][0], whi[ks][1], whi[ks][2], whi[ks][3]};
                  o1[1] = mfma32(pa1[ks], vf, o1[1]); o2[1] = mfma32(pa2[ks], vf, o2[1]); } }
        }
      }
    }
#undef ATT_ISSUE
    LDS_WAIT(); __builtin_amdgcn_s_barrier(); asm volatile("" ::: "memory");
    { const float l1 = st1.l + __shfl_xor(st1.l, 32), l2 = st2.l + __shfl_xor(st2.l, 32);
      if (hi == 0) { wsf[64 + r32] = l1; if (MODE == 0) wsf[96 + r32] = l2; }
      LDS_WAIT();
#pragma unroll
      for (int r = 0; r < 16; ++r) { const int q = crow(r, hi); const float rl1 = fast_rcp(wsf[64 + q]);
          if (MODE == 1) { stg[q * 64 + r32] = o1[0][r] * rl1; stg[q * 64 + 32 + r32] = o1[1][r] * rl1; }
          else { const float rl2 = T.lam * fast_rcp(wsf[96 + q]);
              stg[q * 64 + r32] = o1[0][r] * rl1 - o2[0][r] * rl2; stg[q * 64 + 32 + r32] = o1[1][r] * rl1 - o2[1][r] * rl2; } }
      LDS_WAIT();
      const int ch = lane & 7;
      f32x4 g0 = (f32x4){1.f, 1.f, 1.f, 1.f}, g1 = g0;
      if (MODE == 0) { g0 = *(const f32x4*)(T.dn + ch * 8) * T.onem; g1 = *(const f32x4*)(T.dn + ch * 8 + 4) * T.onem; }
#pragma unroll
      for (int i = 0; i < 4; ++i) { const int row = i * 8 + (lane >> 3);
          f32x4 a = *(const LAS f32x4*)(stg + row * 64 + ch * 8), c = *(const LAS f32x4*)(stg + row * 64 + ch * 8 + 4);
          if (MODE == 0) { float ss = (a[0] * a[0] + a[1] * a[1]) + (a[2] * a[2] + a[3] * a[3]) + (c[0] * c[0] + c[1] * c[1]) + (c[2] * c[2] + c[3] * c[3]);
              ss += __shfl_xor(ss, 1); ss += __shfl_xor(ss, 2); ss += __shfl_xor(ss, 4);
              const float rstd = rsqrtf(ss * (1.0f / 64.0f) + RMS_EPS); a = a * rstd * g0; c = c * rstd * g1; }
          st16(T.O + (size_t)(qrow0 + row) * 1024 + T.ocol + ch * 8, a, c); } }
    LDS_WAIT(); __builtin_amdgcn_s_barrier(); asm volatile("" ::: "memory");
}
}

namespace atts {
constexpr float THR = 6.0f;
#define SB0() __builtin_amdgcn_sched_barrier(0)
struct Sm { float mhat, l; };
__device__ __forceinline__ void exp_pack(f32x16& p0, f32x16& p1, Sm& st, bf16x8 (&pa)[4]) {
    float s = 0.f;
#pragma unroll
    for (int r = 0; r < 16; ++r) { p0[r] = fast_exp2(p0[r]); p1[r] = fast_exp2(p1[r]); s = (s + p0[r]) + p1[r]; }
    st.l += s;
    pa[0] = pack8(p0, 0); pa[1] = pack8(p0, 8); pa[2] = pack8(p1, 0); pa[3] = pack8(p1, 8);
}
__device__ __forceinline__ void exp_head(f32x16& p0, float& s) {
#pragma unroll
    for (int r = 0; r < 8; ++r) { p0[r] = fast_exp2(p0[r]); s += p0[r]; }
}
__device__ __forceinline__ void exp_tail(f32x16& p0, f32x16& p1, float& s, Sm& st, bf16x8 (&pa)[4]) {
#pragma unroll
    for (int r = 8; r < 16; ++r) { p0[r] = fast_exp2(p0[r]); s += p0[r]; }
#pragma unroll
    for (int r = 0; r < 16; ++r) { p1[r] = fast_exp2(p1[r]); s += p1[r]; }
    st.l += s;
    pa[0] = pack8(p0, 0); pa[1] = pack8(p0, 8); pa[2] = pack8(p1, 0); pa[3] = pack8(p1, 8);
}
__device__ __forceinline__ void rescale(f32x16& p0, f32x16& p1, Sm& st, f32x16 (&o)[2], const float rm, LAS float* wsf, const int r32, const int hi, f32x16& negm) {
    if (__any(rm > THR)) {
        const float dl = fmaxf(rm, 0.f);
        st.mhat += dl;
#pragma unroll
        for (int r = 0; r < 16; ++r) negm[r] = -st.mhat;
#pragma unroll
        for (int r = 0; r < 16; ++r) { p0[r] -= dl; p1[r] -= dl; }
        const float f = fast_exp2(-dl); st.l *= f;
        if (hi == 0) wsf[r32] = f;
        LDS_WAIT();
#pragma unroll
        for (int r = 0; r < 16; ++r) { const float fr_ = wsf[crow(r, hi)]; o[0][r] *= fr_; o[1][r] *= fr_; }
    }
}
__device__ __forceinline__ void glds16(const bf16_t* src, LAS unsigned char* dst) { __builtin_amdgcn_global_load_lds((const unsigned*)src, (LAS unsigned*)dst, 16, 0, 0); }
#ifndef KRD16
#define KRD16(dst, addr, off) asm volatile("ds_read_b128 %0, %1 offset:%c2" : "=&v"(dst) : "v"(addr), "i"(off) : "memory")
#endif
struct Src {
    const bf16_t* Q; int qpitch, qcol;
    const bf16_t* K; int kcol;
    const bf16_t* KR;
    const bf16_t* V; int vcol;
};
template <int KIND>
__device__ __forceinline__ void attn_pass(LAS unsigned char* lds, const Src& T, const int b, const bool ctxq, const int qb, f32x16 (&o1)[2], Sm& st1) {
    constexpr int NCH = KIND ? 12 : 4, NKW = KIND ? 8 : 4, ND = KIND ? 6 : 2, KSLOT = NCH * 1024, SLOT = KSLOT + 8192, NSLOT = 4;
    constexpr int WS_OFF = 90112;
    static_assert(NSLOT * SLOT <= WS_OFF && WS_OFF + 8 * 512 <= RING_BYTES, "attention LDS");
    const int tid = otid(), lane = tid & 63, r32 = lane & 31, hi = lane >> 5, wid = __builtin_amdgcn_readfirstlane(tid >> 6);
    const int NT = ctxq ? 4 : 68;
    const int krow_ctx = NLAT + b * CTXL, krow_lat = b * SEQ;
    const int qrow0 = (ctxq ? krow_ctx : krow_lat + qb * 256) + wid * 32;
    LAS float* wsf = (LAS float*)(lds + WS_OFF + wid * 512);
#define ATT_ISSUE(t_) do { const int kr_ = ((t_) < 4) ? krow_ctx + 64 * (t_) : krow_lat + 64 * ((t_) - 4); const int so_ = ((t_) & 3) * SLOT; \
        if (wid < NKW) glds16(T.K + (size_t)(kr_ + lane) * 384 + T.kcol + wid * 8, lds + so_ + wid * 1024); \
        if (KIND == 1 && wid < 4) glds16(T.KR + (size_t)(kr_ + lane) * 32 + wid * 8, lds + so_ + (8 + wid) * 1024); \
        glds16(T.V + (size_t)(kr_ + 16 * (wid & 3) + (lane >> 2)) * 384 + T.vcol + (wid >> 2) * 32 + (lane & 3) * 8, lds + so_ + KSLOT + wid * 1024); } while (0)
#define ATT_WAITN(n) do { const int np_ = (KIND == 1) ? (wid < 4 ? 3 : 2) : (wid < 4 ? 2 : 1); \
        if ((n) == 0) asm volatile("s_waitcnt vmcnt(0)" ::: "memory"); \
        else if (np_ * (n) == 1) asm volatile("s_waitcnt vmcnt(1)" ::: "memory"); else if (np_ * (n) == 2) asm volatile("s_waitcnt vmcnt(2)" ::: "memory"); \
        else if (np_ * (n) == 3) asm volatile("s_waitcnt vmcnt(3)" ::: "memory"); else if (np_ * (n) == 4) asm volatile("s_waitcnt vmcnt(4)" ::: "memory"); \
        else asm volatile("s_waitcnt vmcnt(6)" ::: "memory"); } while (0)
#define ATT_BAR() do { LDS_WAIT(); __builtin_amdgcn_s_barrier(); asm volatile("" ::: "memory"); } while (0)
    bf16x8 qr[ND];
    { const bf16_t* qp = T.Q + (size_t)(qrow0 + r32) * T.qpitch + T.qcol + hi * 8;
#pragma unroll
      for (int d0 = 0; d0 < ND; ++d0) qr[d0] = *(const bf16x8*)(qp + d0 * 16); }
    ATT_ISSUE(0); ATT_ISSUE(1); ATT_ISSUE(2);
    st1.mhat = 0.f; st1.l = 0.f;
#pragma unroll
    for (int r = 0; r < 16; ++r) { o1[0][r] = 0.f; o1[1][r] = 0.f; }
    const unsigned klane = (unsigned)(size_t)lds + hi * 1024 + r32 * 16;
    const unsigned vlane = (unsigned)(size_t)lds + KSLOT + ((lane >> 4) & 1) * 32 + (lane & 3) * 8 + (4 * hi + ((lane & 15) >> 2)) * 64;
    f32x16 a0, a1, n0, n1, negm1;
#define ATT_KRD(t_, kf) do { const unsigned kb_ = klane + ((t_) & 3) * SLOT; \
        _Pragma("unroll") for (int d = 0; d < ND; ++d) { KRD16(kf[2 * d], kb_, d * 2048); KRD16(kf[2 * d + 1], kb_, d * 2048 + 512); } } while (0)
#define ATT_MM(kf, P0, P1) do { asm volatile("s_waitcnt lgkmcnt(0)" ::: "memory"); SB0(); \
        P0 = mfma32(kf[0], qr[0], negm1); P1 = mfma32(kf[1], qr[0], negm1); \
        _Pragma("unroll") for (int d = 1; d < ND; ++d) { P0 = mfma32(kf[2 * d], qr[d], P0); P1 = mfma32(kf[2 * d + 1], qr[d], P1); } } while (0)
#define ATT_QK(t_, P0, P1) do { bf16x8 kf_[2 * ND]; ATT_KRD(t_, kf_); ATT_MM(kf_, P0, P1); } while (0)
#pragma unroll
    for (int r = 0; r < 16; ++r) negm1[r] = 0.f;
    ATT_WAITN(2); ATT_BAR();
    ATT_QK(0, a0, a1);
    { const float rm = rowmax32_fast(a0, a1); st1.mhat = rm;
#pragma unroll
      for (int r = 0; r < 16; ++r) { a0[r] -= rm; a1[r] -= rm; negm1[r] = -rm; } }
#define ATT_STEP(t_, A0, A1, N0, N1) do { const int tt = (t_); \
        if (tt + 2 < NT) ATT_WAITN(1); else ATT_WAITN(0); \
        ATT_BAR();                                                  \
        if (tt + 3 < NT) ATT_ISSUE(tt + 3); \
        const unsigned vb_ = vlane + (tt & 3) * SLOT; \
        bf16x8 pa1[4]; bf16x8 kf_[2 * ND]; float es_ = 0.f; \
        ATT_KRD(tt + 1, kf_); SB0(); \
        exp_head(A0, es_); SB0();                                    \
        ATT_MM(kf_, N0, N1); \
        exp_tail(A0, A1, es_, st1, pa1); \
        _Pragma("unroll") for (int sg = 0; sg < 2 * ND; ++sg) { __builtin_amdgcn_sched_group_barrier(0x8, 1, 0); __builtin_amdgcn_sched_group_barrier(0x2, KIND ? 6 : 16, 0); } \
        SB0(); \
        PV_BLOCK(vb_, 0, o1[0] = mfma32(pa1[ks], vf, o1[0])); PV_BLOCK(vb_, 1, o1[1] = mfma32(pa1[ks], vf, o1[1])); \
        const float rm1 = rowmax32_fast(N0, N1);                    \
        _Pragma("unroll") for (int sg = 0; sg < 4; ++sg) { __builtin_amdgcn_sched_group_barrier(0x8, 1, 0); __builtin_amdgcn_sched_group_barrier(0x2, 5, 0); } \
        SB0(); \
        rescale(N0, N1, st1, o1, rm1, wsf, r32, hi, negm1); } while (0)
    for (int t = 0; t < NT - 2; t += 2) {
        ATT_STEP(t, a0, a1, n0, n1);
        ATT_STEP(t + 1, n0, n1, a0, a1);
    }
    ATT_STEP(NT - 2, a0, a1, n0, n1);
    { bf16x8 pa1[4]; const unsigned vb_ = vlane + ((NT - 1) & 3) * SLOT;
      exp_pack(n0, n1, st1, pa1);
      PV_BLOCK(vb_, 0, o1[0] = mfma32(pa1[ks], vf, o1[0])); PV_BLOCK(vb_, 1, o1[1] = mfma32(pa1[ks], vf, o1[1])); }
    ATT_BAR();
#undef ATT_STEP
#undef ATT_QK
#undef ATT_ISSUE
#undef ATT_WAITN
}
template <bool DIFF>
__device__ __forceinline__ void attn_store(LAS unsigned char* lds, const f32x16 (&o1)[2], const Sm& st1, const f32x16 (&o2)[2], const Sm& st2, const float lam, const float onem, const float* dn,
        bf16_t* O, const int ocol, const int b, const bool ctxq, const int qb) {
    const int tid = otid(), lane = tid & 63, r32 = lane & 31, hi = lane >> 5, wid = __builtin_amdgcn_readfirstlane(tid >> 6);
    const int qrow0 = (ctxq ? NLAT + b * CTXL : b * SEQ + qb * 256) + wid * 32;
    LAS float* wsf = (LAS float*)(lds + 90112 + wid * 512);
    LAS float* stg = (LAS float*)(lds + wid * 8192);
    const float l1 = st1.l + __shfl_xor(st1.l, 32), l2 = DIFF ? st2.l + __shfl_xor(st2.l, 32) : 1.f;
    if (hi == 0) { wsf[64 + r32] = l1; if (DIFF) wsf[96 + r32] = l2; }
    LDS_WAIT();
#pragma unroll
    for (int r = 0; r < 16; ++r) { const int q = crow(r, hi); const float rl1 = fast_rcp(wsf[64 + q]);
        if (!DIFF) { stg[q * 64 + r32] = o1[0][r] * rl1; stg[q * 64 + 32 + r32] = o1[1][r] * rl1; }
        else { const float rl2 = lam * fast_rcp(wsf[96 + q]);
            stg[q * 64 + r32] = o1[0][r] * rl1 - o2[0][r] * rl2; stg[q * 64 + 32 + r32] = o1[1][r] * rl1 - o2[1][r] * rl2; } }
    LDS_WAIT();
    const int ch = lane & 7;
    f32x4 g0 = (f32x4){1.f, 1.f, 1.f, 1.f}, g1 = g0;
    if (DIFF) { g0 = *(const f32x4*)(dn + ch * 8) * onem; g1 = *(const f32x4*)(dn + ch * 8 + 4) * onem; }
#pragma unroll
    for (int i = 0; i < 4; ++i) { const int row = i * 8 + (lane >> 3);
        f32x4 a = *(const LAS f32x4*)(stg + row * 64 + ch * 8), c = *(const LAS f32x4*)(stg + row * 64 + ch * 8 + 4);
        if (DIFF) { float ss = (a[0] * a[0] + a[1] * a[1]) + (a[2] * a[2] + a[3] * a[3]) + (c[0] * c[0] + c[1] * c[1]) + (c[2] * c[2] + c[3] * c[3]);
            ss += __shfl_xor(ss, 1); ss += __shfl_xor(ss, 2); ss += __shfl_xor(ss, 4);
            const float rstd = rsqrtf(ss * (1.0f / 64.0f) + RMS_EPS); a = a * rstd * g0; c = c * rstd * g1; }
        st16(O + (size_t)(qrow0 + row) * 1024 + ocol + ch * 8, a, c); }
    LDS_WAIT(); __builtin_amdgcn_s_barrier(); asm volatile("" ::: "memory");
}
#undef ATT_BAR
#undef SB0
}

namespace attp {
typedef short v4i16_t __attribute__((ext_vector_type(4)));
constexpr float THR = 6.0f;
#define SB0() __builtin_amdgcn_sched_barrier(0)
__device__ __forceinline__ float rowmax32(f32x16& p0, f32x16& p1) { return rowmax32_fast(p0, p1); }
struct Sm { float mhat, l; };
__device__ __forceinline__ void exp_pack(f32x16& p0, f32x16& p1, Sm& st, bf16x8 (&pa)[4]) {
    float s = 0.f;
#pragma unroll
    for (int r = 0; r < 16; ++r) { p0[r] = fast_exp2(p0[r]); p1[r] = fast_exp2(p1[r]); s = (s + p0[r]) + p1[r]; }
    st.l += s;
    pa[0] = pack8(p0, 0); pa[1] = pack8(p0, 8); pa[2] = pack8(p1, 0); pa[3] = pack8(p1, 8);
}
__device__ __forceinline__ void rescale(f32x16& p0, f32x16& p1, Sm& st, f32x16 (&o)[2], const float rm, LAS float* wsf, const int r32, const int hi, f32x16& negm) {
    if (__any(rm > THR)) {
        const float dl = fmaxf(rm, 0.f);
        st.mhat += dl;
#pragma unroll
        for (int r = 0; r < 16; ++r) negm[r] = -st.mhat;
#pragma unroll
        for (int r = 0; r < 16; ++r) { p0[r] -= dl; p1[r] -= dl; }
        const float f = fast_exp2(-dl); st.l *= f;
        if (hi == 0) wsf[r32] = f;
        LDS_WAIT();
#pragma unroll
        for (int r = 0; r < 16; ++r) { const float fr_ = wsf[crow(r, hi)]; o[0][r] *= fr_; o[1][r] *= fr_; }
    }
}
__device__ __forceinline__ void glds16(const bf16_t* src, LAS unsigned char* dst) { __builtin_amdgcn_global_load_lds((const unsigned*)src, (LAS unsigned*)dst, 16, 0, 0); }

#define KRD16(dst, addr, off) asm volatile("ds_read_b128 %0, %1 offset:%c2" : "=&v"(dst) : "v"(addr), "i"(off) : "memory")
struct Tens {
    const bf16_t* Q; int qpitch, qcol;
    const bf16_t* K; const bf16_t* KR; const bf16_t* V; int kvcol;
    bf16_t* O; int ocol;
    float lam, onem; const float* dn;
};
template <int D0, int ND>
__device__ __forceinline__ void qk_tile(f32x16& p0, f32x16& p1, const LAS unsigned char* kp, const bf16x8* qr, const float mhat) {
    f32x16 c;
#pragma unroll
    for (int r = 0; r < 16; ++r) c[r] = -mhat;
#pragma unroll
    for (int d = 0; d < ND; ++d) { const bf16x8 k0 = *(const LAS bf16x8*)(kp + (D0 + d) * 2048), k1 = *(const LAS bf16x8*)(kp + (D0 + d) * 2048 + 512);
        if (d == 0) { p0 = mfma32(k0, qr[D0], c); p1 = mfma32(k1, qr[D0], c); } else { p0 = mfma32(k0, qr[D0 + d], p0); p1 = mfma32(k1, qr[D0 + d], p1); } }
}
template <int D0, int ND>
__device__ __forceinline__ void qk_tile_l(f32x16& p0, f32x16& p1, const LAS unsigned char* kp, const LAS unsigned char* ql, const float mhat) {
#pragma unroll
    for (int r = 0; r < 16; ++r) { p0[r] = -mhat; p1[r] = -mhat; }
#pragma unroll
    for (int d = 0; d < ND; ++d) { const bf16x8 k0 = *(const LAS bf16x8*)(kp + (D0 + d) * 2048), k1 = *(const LAS bf16x8*)(kp + (D0 + d) * 2048 + 512);
        const bf16x8 q = *(const LAS bf16x8*)(ql + (D0 + d) * 1024);
        p0 = mfma32(k0, q, p0); p1 = mfma32(k1, q, p1); }
}
template <int MODE>
__device__ __forceinline__ void attn_unit(LAS unsigned char* lds, const Tens& T, const int b, const bool ctxq, const int qb) {
    constexpr int NCH = MODE ? 12 : 8, KSLOT = NCH * 1024, SLOT = KSLOT + 8192, NSLOT = 4;
    constexpr int WS_OFF = NSLOT * SLOT, OST_OFF = 0, QS_OFF = WS_OFF + 8 * 512;
    static_assert(QS_OFF + 8 * 4096 <= RING_BYTES && 8 * 8192 <= WS_OFF, "attention LDS");
    const int tid = otid(), lane = tid & 63, r32 = lane & 31, hi = lane >> 5, wid = __builtin_amdgcn_readfirstlane(tid >> 6);
    const int NT = ctxq ? 4 : 68;
    const int krow_ctx = NLAT + b * CTXL, krow_lat = b * SEQ;
    const int qrow0 = (ctxq ? krow_ctx : krow_lat + qb * 256) + wid * 32;
    LAS float* wsf = (LAS float*)(lds + WS_OFF + wid * 512);
    LAS float* stg = (LAS float*)(lds + OST_OFF + wid * 8192);
#define ATT_ISSUE(t_) do { const int kr_ = ((t_) < 4) ? krow_ctx + 64 * (t_) : krow_lat + 64 * ((t_) - 4); const int so_ = ((t_) & 3) * SLOT; \
        glds16(T.K + (size_t)(kr_ + lane) * 384 + T.kvcol + wid * 8, lds + so_ + wid * 1024); \
        if (MODE == 1 && wid < 4) glds16(T.KR + (size_t)(kr_ + lane) * 32 + wid * 8, lds + so_ + (8 + wid) * 1024); \
        glds16(T.V + (size_t)(kr_ + 16 * (wid & 3) + (lane >> 2)) * 384 + T.kvcol + (wid >> 2) * 32 + (lane & 3) * 8, lds + so_ + KSLOT + wid * 1024); } while (0)
#define ATT_WAIT(n2, n3) do { if (MODE == 1 && wid < 4) asm volatile("s_waitcnt vmcnt(" #n3 ")" ::: "memory"); else asm volatile("s_waitcnt vmcnt(" #n2 ")" ::: "memory"); } while (0)
#define ATT_BAR() do { LDS_WAIT(); __builtin_amdgcn_s_barrier(); asm volatile("" ::: "memory"); } while (0)
    constexpr int NQ = MODE ? 6 : 4;
    bf16x8 qr[NQ];
    const LAS unsigned char* ql = lds + QS_OFF + wid * 4096 + lane * 16;
    { const bf16_t* qp = T.Q + (size_t)(qrow0 + r32) * T.qpitch + T.qcol + hi * 8;
#pragma unroll
      for (int d0 = 0; d0 < NQ; ++d0) { const bf16x8 q = *(const bf16x8*)(qp + d0 * 16); if (MODE == 1) qr[d0] = q; else *(LAS bf16x8*)(lds + QS_OFF + wid * 4096 + d0 * 1024 + lane * 16) = q; } }
    ATT_ISSUE(0); ATT_ISSUE(1); ATT_ISSUE(2);
    Sm st1{0.f, 0.f}, st2{0.f, 0.f};
    f32x16 o1[2], o2[2];
#pragma unroll
    for (int r = 0; r < 16; ++r) { o1[0][r] = 0.f; o1[1][r] = 0.f; o2[0][r] = 0.f; o2[1][r] = 0.f; }
    const int klane = hi * 1024 + r32 * 16;
    const int vlane = KSLOT + ((lane >> 4) & 1) * 32 + (lane & 3) * 8 + (4 * hi + ((lane & 15) >> 2)) * 64;
    f32x16 a0, a1, c0, c1;
    ATT_WAIT(4, 6); ATT_BAR();
    { const LAS unsigned char* kp = lds + klane;
      if (MODE == 1) { qk_tile<0, 6>(a0, a1, kp, qr, 0.f); }
      else { qk_tile_l<0, 2>(a0, a1, kp, ql, 0.f); qk_tile_l<2, 2>(c0, c1, kp, ql, 0.f); }
      { const float rm = rowmax32(a0, a1); st1.mhat = rm;
#pragma unroll
        for (int r = 0; r < 16; ++r) { a0[r] -= rm; a1[r] -= rm; } }
      if (MODE == 0) { const float rm = rowmax32(c0, c1); st2.mhat = rm;
#pragma unroll
        for (int r = 0; r < 16; ++r) { c0[r] -= rm; c1[r] -= rm; } } }
    f32x16 n0, n1, m0, m1;
    f32x16 negm1, negm2;
#pragma unroll
    for (int r = 0; r < 16; ++r) { negm1[r] = -st1.mhat; negm2[r] = -st2.mhat; }
#define ATT_PV1(vb_) do { PV_BLOCK(vb_, 0, o1[0] = mfma32(pa1[ks], vf, o1[0])); PV_BLOCK(vb_, 1, o1[1] = mfma32(pa1[ks], vf, o1[1])); } while (0)
#define ATT_PV2(vb_) do { PV_BLOCK(vb_, 0, o1[0] = mfma32(pa1[ks], vf, o1[0]); o2[0] = mfma32(pa2[ks], vf, o2[0])); PV_BLOCK(vb_, 1, o1[1] = mfma32(pa1[ks], vf, o1[1]); o2[1] = mfma32(pa2[ks], vf, o2[1])); } while (0)
#define ATT_STEP(t_, A0, A1, C0, C1, N0, N1, M0, M1) do { const int tt = (t_); \
        if (tt + 2 < NT) ATT_WAIT(2, 3); else asm volatile("s_waitcnt vmcnt(0)" ::: "memory"); \
        ATT_BAR();                                                  \
        if (tt + 3 < NT) ATT_ISSUE(tt + 3); \
        const LAS unsigned char* kpn = lds + ((tt + 1) & 3) * SLOT + klane; \
        const unsigned vp = (unsigned)(size_t)(lds + (tt & 3) * SLOT + vlane); \
        bf16x8 pa1[4], pa2[4]; \
        if (MODE == 1) { \
            { const unsigned kb_ = (unsigned)(size_t)kpn; bf16x8 kf[12]; \
              _Pragma("unroll") for (int d = 0; d < 6; ++d) { KRD16(kf[2 * d], kb_, d * 2048); KRD16(kf[2 * d + 1], kb_, d * 2048 + 512); } \
              asm volatile("s_waitcnt lgkmcnt(0)" ::: "memory"); SB0(); \
              N0 = mfma32(kf[0], qr[0], negm1); N1 = mfma32(kf[1], qr[0], negm1); \
              _Pragma("unroll") for (int d = 1; d < 6; ++d) { N0 = mfma32(kf[2 * d], qr[d], N0); N1 = mfma32(kf[2 * d + 1], qr[d], N1); } } \
            exp_pack(A0, A1, st1, pa1); \
            _Pragma("unroll") for (int sg = 0; sg < 12; ++sg) { __builtin_amdgcn_sched_group_barrier(0x8, 1, 0); __builtin_amdgcn_sched_group_barrier(0x2, 7, 0); } \
            SB0(); \
            const float rm1 = rowmax32(N0, N1); \
            ATT_PV1(vp); \
            SB0(); \
            rescale(N0, N1, st1, o1, rm1, wsf, r32, hi, negm1); \
        } else { \
            qk_tile_l<0, 2>(N0, N1, kpn, ql, st1.mhat); \
            exp_pack(A0, A1, st1, pa1); \
            SB0(); \
            qk_tile_l<2, 2>(M0, M1, kpn, ql, st2.mhat); \
            exp_pack(C0, C1, st2, pa2); \
            SB0(); \
            const float rm1 = rowmax32(N0, N1), rm2 = rowmax32(M0, M1); \
            ATT_PV2(vp); \
            SB0(); \
            rescale(N0, N1, st1, o1, rm1, wsf, r32, hi, negm1); rescale(M0, M1, st2, o2, rm2, wsf + 32, r32, hi, negm2); \
        } } while (0)
    for (int t = 0; t < NT - 2; t += 2) {
        ATT_STEP(t, a0, a1, c0, c1, n0, n1, m0, m1);
        ATT_STEP(t + 1, n0, n1, m0, m1, a0, a1, c0, c1);
    }
    ATT_STEP(NT - 2, a0, a1, c0, c1, n0, n1, m0, m1);
    { bf16x8 pa1[4], pa2[4]; const unsigned vp = (unsigned)(size_t)(lds + ((NT - 1) & 3) * SLOT + vlane);
      exp_pack(n0, n1, st1, pa1);
      if (MODE == 1) { ATT_PV1(vp); } else { exp_pack(m0, m1, st2, pa2); ATT_PV2(vp); } }
#undef ATT_PV1
#undef ATT_PV2
#undef ATT_STEP
#undef ATT_ISSUE
#undef ATT_WAIT
    ATT_BAR();
    { const float l1 = st1.l + __shfl_xor(st1.l, 32), l2 = st2.l + __shfl_xor(st2.l, 32);
      if (hi == 0) { wsf[64 + r32] = l1; if (MODE == 0) wsf[96 + r32] = l2; }
      LDS_WAIT();
#pragma unroll
      for (int r = 0; r < 16; ++r) { const int q = crow(r, hi); const float rl1 = fast_rcp(wsf[64 + q]);
          if (MODE == 1) { stg[q * 64 + r32] = o1[0][r] * rl1; stg[q * 64 + 32 + r32] = o1[1][r] * rl1; }
          else { const float rl2 = T.lam * fast_rcp(wsf[96 + q]);
              stg[q * 64 + r32] = o1[0][r] * rl1 - o2[0][r] * rl2; stg[q * 64 + 32 + r32] = o1[1][r] * rl1 - o2[1][r] * rl2; } }
      LDS_WAIT();
      const int ch = lane & 7;
      f32x4 g0 = (f32x4){1.f, 1.f, 1.f, 1.f}, g1 = g0;
      if (MODE == 0) { g0 = *(const f32x4*)(T.dn + ch * 8) * T.onem; g1 = *(const f32x4*)(T.dn + ch * 8 + 4) * T.onem; }
#pragma unroll
      for (int i = 0; i < 4; ++i) { const int row = i * 8 + (lane >> 3);
          f32x4 a = *(const LAS f32x4*)(stg + row * 64 + ch * 8), c = *(const LAS f32x4*)(stg + row * 64 + ch * 8 + 4);
          if (MODE == 0) { float ss = (a[0] * a[0] + a[1] * a[1]) + (a[2] * a[2] + a[3] * a[3]) + (c[0] * c[0] + c[1] * c[1]) + (c[2] * c[2] + c[3] * c[3]);
              ss += __shfl_xor(ss, 1); ss += __shfl_xor(ss, 2); ss += __shfl_xor(ss, 4);
              const float rstd = rsqrtf(ss * (1.0f / 64.0f) + RMS_EPS); a = a * rstd * g0; c = c * rstd * g1; }
          st16(T.O + (size_t)(qrow0 + row) * 1024 + T.ocol + ch * 8, a, c); } }
    ATT_BAR();
#undef ATT_BAR
#undef SB0
}
}

namespace lru {
constexpr int YP = 264;
constexpr int YBUF = 32 * YP * 2;
struct WaveCtx { bf16x8 wf[2][2][4]; float ba[2], bi[2], c8[2]; float cw[4], cb; };

__device__ __forceinline__ void load_ctx(WaveCtx& W, const int l, const bf16_t* WG, const float* conv_w, const float* conv_b, const float* lba, const float* lbi, const float* llam) {
    const int tid = otid(), lane = tid & 63, r32 = lane & 31, hi = lane >> 5, wid = __builtin_amdgcn_readfirstlane(tid >> 6);
    const int hb = wid & 3, half = wid >> 2, c2 = 64 * hb + 32 * half + r32;
#pragma unroll
    for (int d = 0; d < 2; ++d)
#pragma unroll
        for (int gt = 0; gt < 2; ++gt)
#pragma unroll
            for (int ks = 0; ks < 4; ++ks)
                W.wf[d][gt][ks] = *(const bf16x8*)(WG + ((size_t)(l * 1024 + hb * 256 + d * 128 + gt * 64 + 32 * half + r32)) * 64 + 16 * ks + 8 * hi);
#pragma unroll
    for (int d = 0; d < 2; ++d) { W.ba[d] = lba[(l * 2 + d) * 256 + c2]; W.bi[d] = lbi[(l * 2 + d) * 256 + c2];
        const float lam = llam[(l * 2 + d) * 256 + c2]; W.c8[d] = -8.0f * LOG2E * log1pf(expf(-lam)); }
    const int c = tid & 255;
#pragma unroll
    for (int k = 0; k < 4; ++k) W.cw[k] = conv_w[(l * 4 + k) * 256 + c];
    W.cb = conv_b[l * 256 + c];
}

struct ChunkPos { int seqbase, seqlen, tl0; };
__device__ __forceinline__ ChunkPos chunk_pos(const int cid) { ChunkPos p;
    if (cid < NCHUNK_LAT) { p.seqbase = (cid >> 7) * SEQ; p.seqlen = SEQ; p.tl0 = (cid & 127) * 32; }
    else { const int cc = cid - NCHUNK_LAT; p.seqbase = NLAT + (cc >> 3) * CTXL; p.seqlen = CTXL; p.tl0 = (cc & 7) * 32; }
    return p; }
__device__ __forceinline__ void conv_load(unsigned (&xr)[19], const int cid, const bf16_t* XL, const int tid) {
    const ChunkPos p = chunk_pos(cid); const int c = tid & 255, th = tid >> 8;
#pragma unroll
    for (int k = 0; k < 19; ++k) { int tl = p.tl0 + th * 16 - 2 + k; tl = tl < 0 ? 0 : (tl >= p.seqlen ? p.seqlen - 1 : tl); xr[k] = XL[(size_t)(p.seqbase + tl) * 256 + c]; }
}
__device__ __forceinline__ void conv_store(const unsigned (&xr)[19], const int cid, const WaveCtx& W, LAS bf16_t* Y, const int tid) {
    const ChunkPos p = chunk_pos(cid); const int c = tid & 255, th = tid >> 8; float xv[19];
#pragma unroll
    for (int k = 0; k < 19; ++k) { const int tl = p.tl0 + th * 16 - 2 + k; xv[k] = (tl >= 0 && tl < p.seqlen) ? bf2f(xr[k]) : 0.f; }
#pragma unroll
    for (int i = 0; i < 16; ++i) { const float y = W.cb + W.cw[0] * xv[i] + W.cw[1] * xv[i + 1] + W.cw[2] * xv[i + 2] + W.cw[3] * xv[i + 3]; Y[(th * 16 + i) * YP + c] = (bf16_t)f2bf(y); }
}
template <bool FINAL>
__device__ __forceinline__ void chunk(LAS unsigned char* ybuf, LAS unsigned char* ynbuf, const WaveCtx& W, const int cid, const int ncid, const bf16_t* XL, const bf16_t* GG, float* LSUM, const float* LCAR, bf16_t* MIX) {
    const int tid = otid(), lane = tid & 63, r32 = lane & 31, hi = lane >> 5, wid = __builtin_amdgcn_readfirstlane(tid >> 6);
    const int hb = wid & 3, half = wid >> 2, c2 = 64 * hb + 32 * half + r32;
    const ChunkPos p = chunk_pos(cid); const int seqbase = p.seqbase, tl0 = p.tl0;
    LAS bf16_t* Y = (LAS bf16_t*)ybuf;
    float hc[2] = {0.f, 0.f}; unsigned gr[16];
    if (FINAL) { hc[0] = LCAR[((size_t)cid * 2 + 0) * 256 + c2]; hc[1] = LCAR[((size_t)cid * 2 + 1) * 256 + c2];
#pragma unroll
        for (int r = 0; r < 16; ++r) gr[r] = GG[(size_t)(seqbase + tl0 + crow(r, hi)) * 256 + c2]; }
    unsigned xr[19];
    conv_load(xr, ncid >= 0 ? ncid : cid, XL, tid);
    float yv[16], hsum[16];
#pragma unroll
    for (int r = 0; r < 16; ++r) { yv[r] = bf2f(Y[crow(r, hi) * YP + c2]); hsum[r] = 0.f; }
#pragma unroll
    for (int d = 0; d < 2; ++d) {
        f32x16 acc[2];
#pragma unroll
        for (int r = 0; r < 16; ++r) { acc[0][r] = 0.f; acc[1][r] = 0.f; }
#pragma unroll
        for (int ks = 0; ks < 4; ++ks) { const bf16x8 a = *(const LAS bf16x8*)(Y + r32 * YP + 64 * hb + 16 * ks + 8 * hi);
            acc[0] = mfma32(a, W.wf[d][0][ks], acc[0]); acc[1] = mfma32(a, W.wf[d][1][ks], acc[1]); }
        float ca[16], hl[16];
#pragma unroll
        for (int r = 0; r < 16; ++r) { const float rg = sigmoidf_(acc[0][r] + W.ba[d]), ig = sigmoidf_(acc[1][r] + W.bi[d]);
            const float a = fast_exp2(W.c8[d] * rg); ca[r] = a; hl[r] = __builtin_amdgcn_sqrtf(fmaxf(1.0f - a * a, 0.f)) * (ig * yv[r]); }
        float sA[4], sH[4];
        if (d == 0) {
#pragma unroll
            for (int q = 0; q < 4; ++q) {
#pragma unroll
                for (int j = 1; j < 4; ++j) { hl[4 * q + j] = ca[4 * q + j] * hl[4 * q + j - 1] + hl[4 * q + j]; ca[4 * q + j] = ca[4 * q + j] * ca[4 * q + j - 1]; }
                sA[q] = ca[4 * q + 3]; sH[q] = hl[4 * q + 3]; }
        } else {
#pragma unroll
            for (int q = 0; q < 4; ++q) {
#pragma unroll
                for (int j = 2; j >= 0; --j) { hl[4 * q + j] = ca[4 * q + j] * hl[4 * q + j + 1] + hl[4 * q + j]; ca[4 * q + j] = ca[4 * q + j] * ca[4 * q + j + 1]; }
                sA[q] = ca[4 * q]; sH[q] = hl[4 * q]; }
        }
        float h = FINAL ? hc[d] : 0.f;
        float hbef[4];
        if (d == 0) {
#pragma unroll
            for (int q = 0; q < 4; ++q) { const float hb0 = h; const float t0 = sA[q] * h + sH[q]; const float hm = __shfl(t0, r32); const float t1 = sA[q] * hm + sH[q]; h = __shfl(t1, r32 + 32); hbef[q] = hi ? hm : hb0; }
        } else {
#pragma unroll
            for (int q = 3; q >= 0; --q) { const float hb1 = h; const float t1 = sA[q] * h + sH[q]; const float hm = __shfl(t1, r32 + 32); const float t0 = sA[q] * hm + sH[q]; h = __shfl(t0, r32); hbef[q] = hi ? hb1 : hm; }
        }
        if (!FINAL) {
            float at = (sA[0] * sA[1]) * (sA[2] * sA[3]); at *= __shfl_xor(at, 32);
            if (hi == 0) *(f32x2*)(LSUM + (((size_t)cid * 2 + d) * 256 + c2) * 2) = (f32x2){at, h};
        } else {
#pragma unroll
            for (int r = 0; r < 16; ++r) hsum[r] += ca[r] * hbef[r >> 2] + hl[r];
        }
    }
    if (FINAL) {
#pragma unroll
        for (int r = 0; r < 16; ++r) { const size_t row = (size_t)(seqbase + tl0 + crow(r, hi)); MIX[row * 1024 + c2] = (bf16_t)f2bf(hsum[r] * bf2f(gr[r])); }
    }
    if (ncid >= 0) conv_store(xr, ncid, W, (LAS bf16_t*)ynbuf, tid);
}
template <bool FINAL>
__device__ __forceinline__ void run_chunks(LAS unsigned char* lds, const WaveCtx& W, const int first, const int stride, const int nch, const bf16_t* XL, const bf16_t* GG, float* LSUM, const float* LCAR, bf16_t* MIX) {
    if (first < nch) { unsigned xr[19]; const int tid = otid(); conv_load(xr, first, XL, tid); conv_store(xr, first, W, (LAS bf16_t*)lds, tid); }
    int it = 0;
    for (int cid = first; cid < nch; cid += stride, ++it) {
        __syncthreads();
        const int ncid = (cid + stride < nch) ? cid + stride : -1;
        chunk<FINAL>(lds + (it & 1) * YBUF, lds + ((it + 1) & 1) * YBUF, W, cid, ncid, XL, GG, LSUM, LCAR, MIX);
    }
}

__device__ __forceinline__ void carry(const float* LSUM, float* LCAR) {
    if (blockIdx.x < NBATCH) {
        const int tid_ = otid(); const int b = blockIdx.x, d = tid_ >> 8, c = tid_ & 255;
        float h = 0.f;
#pragma unroll 8
        for (int n = 0; n < 136; ++n) {
            int cid;
            if (d == 0) cid = (n < 8) ? NCHUNK_LAT + b * 8 + n : b * 128 + (n - 8);
            else cid = (n < 8) ? NCHUNK_LAT + b * 8 + (7 - n) : b * 128 + (135 - n);
            const f32x2 ah = *(const f32x2*)(LSUM + (((size_t)cid * 2 + d) * 256 + c) * 2);
            LCAR[((size_t)cid * 2 + d) * 256 + c] = h;
            h = ah.x * h + ah.y;
        }
    }
}
}

namespace lnp {
struct Vec { f32x4 v[4]; };
__device__ __forceinline__ Vec ldv(const float* p, int lane) { Vec r;
#pragma unroll
    for (int j = 0; j < 4; ++j) r.v[j] = *(const f32x4*)(p + 4 * lane + 256 * j);
    return r; }
__device__ __forceinline__ Vec ldbf(const bf16_t* p, int lane) { Vec r;
#pragma unroll
    for (int j = 0; j < 4; ++j) { const u32x2 w = *(const u32x2*)(p + 4 * lane + 256 * j); r.v[j] = (f32x4){bflo(w.x), bfhi(w.x), bflo(w.y), bfhi(w.y)}; }
    return r; }
__device__ __forceinline__ void stf(float* p, int lane, const Vec& a) {
#pragma unroll
    for (int j = 0; j < 4; ++j) *(f32x4*)(p + 4 * lane + 256 * j) = a.v[j]; }
__device__ __forceinline__ void stbf(bf16_t* p, int lane, const Vec& a) {
#pragma unroll
    for (int j = 0; j < 4; ++j) st8(p + 4 * lane + 256 * j, a.v[j]); }
__device__ __forceinline__ void normalize(Vec& y) {
    float s = 0.f;
#pragma unroll
    for (int j = 0; j < 4; ++j) s += (y.v[j][0] + y.v[j][1]) + (y.v[j][2] + y.v[j][3]);
    const float mean = wave_sum(s) * (1.0f / DM); float q = 0.f;
#pragma unroll
    for (int j = 0; j < 4; ++j) { y.v[j] = y.v[j] - mean; q += (y.v[j][0] * y.v[j][0] + y.v[j][1] * y.v[j][1]) + (y.v[j][2] * y.v[j][2] + y.v[j][3] * y.v[j][3]); }
    const float rstd = rsqrtf(wave_sum(q) * (1.0f / DM) + LN_EPS);
#pragma unroll
    for (int j = 0; j < 4; ++j) y.v[j] = y.v[j] * rstd;
}

constexpr int LG_OFF = 65536, CNT_OFF = 86016, BASE_OFF = 86080;
__device__ __forceinline__ f32x4 cvt4u(const u32x2 w) { return (f32x4){bflo(w.x), bfhi(w.x), bflo(w.y), bfhi(w.y)}; }
__device__ __forceinline__ f32x4 cvt4b(const f32x4 r) { const unsigned a = __float_as_uint(r[0]), b = __float_as_uint(r[1]); return (f32x4){bflo(a), bfhi(a), bflo(b), bfhi(b)}; }
struct Raw2 { f32x4 x[4]; u32x2 o[4]; };
struct Ln1Par { Vec gate, gg, bb, m4, m3; int cur_bi; };
__device__ __forceinline__ float swap32_sum(const float x, const float y) { auto rr = __builtin_amdgcn_permlane32_swap(__float_as_uint(x), __float_as_uint(y), false, false); return __uint_as_float(rr[0]) + __uint_as_float(rr[1]); }
__device__ __forceinline__ float swap16_sum(const float x, const float y) { auto rr = __builtin_amdgcn_permlane16_swap(__float_as_uint(x), __float_as_uint(y), false, false); return __uint_as_float(rr[0]) + __uint_as_float(rr[1]); }
__device__ __forceinline__ void ln1_ld(Raw2& R, const int l, const int r_, const int rl, const float* xin_lat, const float* xin_ctx, const bf16_t* XB, const bf16_t* O, const int lane) {
    const int rr = (r_ < rl) ? r_ : rl;
    if (l == 0) { const float* xp = (rr < NLAT ? xin_lat + (size_t)rr * 1024 : xin_ctx + (size_t)(rr - NLAT) * 1024) + 4 * lane;
#pragma unroll
        for (int j = 0; j < 4; ++j) R.x[j] = *(const f32x4*)(xp + 256 * j); }
    else { const bf16_t* xp = XB + (size_t)rr * 1024 + 4 * lane;
#pragma unroll
        for (int j = 0; j < 4; ++j) { const u32x2 w = *(const u32x2*)(xp + 256 * j); R.x[j][0] = __uint_as_float(w.x); R.x[j][1] = __uint_as_float(w.y); } }
    const bf16_t* op = O + (size_t)rr * 1024 + 4 * lane;
#pragma unroll
    for (int j = 0; j < 4; ++j) R.o[j] = *(const u32x2*)(op + 256 * j);
}
__device__ __forceinline__ void ln1_row(const Raw2& R, Ln1Par& P, const int l, const int row, const int i, bf16_t* XB, const float* mod, const float* g1, const float* b1, bf16_t* V,
        const LAS float* Wl, LAS float* lg, const int lane) {
    const bool lat = row < NLAT; const int bi = lat ? (row >> 12) : 16;
    if (bi != P.cur_bi) { P.cur_bi = bi; const float* mb = mod + ((size_t)(l * 17 + bi) * 6) * 1024;
        P.gate = ldv(mb + 2 * 1024, lane); P.m3 = ldv(mb + 3 * 1024, lane); P.m4 = ldv(mb + 4 * 1024, lane); P.gg = ldv(g1 + l * 1024, lane); P.bb = ldv(b1 + l * 1024, lane);
#pragma unroll
        for (int j = 0; j < 4; ++j) P.m4.v[j] = P.m4.v[j] + 1.0f;
        __builtin_amdgcn_s_waitcnt(0x0F70); }
    Vec y;
#pragma unroll
    for (int j = 0; j < 4; ++j) y.v[j] = ((l == 0) ? R.x[j] : cvt4b(R.x[j])) * DN_ALPHA + P.gate.v[j] * cvt4u(R.o[j]);
    normalize(y);
    Vec v;
#pragma unroll
    for (int j = 0; j < 4; ++j) { y.v[j] = y.v[j] * P.gg.v[j] + P.bb.v[j]; v.v[j] = y.v[j] * P.m4.v[j] + P.m3.v[j]; }
    stbf(XB + (size_t)row * 1024, lane, y); stbf(V + (size_t)row * 1024, lane, v);
    f32x4 a[4];
#pragma unroll
    for (int q = 0; q < 4; ++q) a[q] = (f32x4){0.f, 0.f, 0.f, 0.f};
#pragma unroll
    for (int j = 0; j < 4; ++j)
#pragma unroll
        for (int e4 = 0; e4 < 4; ++e4) { const float vv = v.v[j][e4]; const int jj = j * 4 + e4;
#pragma unroll
            for (int q = 0; q < 4; ++q) a[q] += vv * *(const LAS f32x4*)(Wl + (((jj * 4 + q) * 64 + lane) << 2)); }
    float r8[8], r4[4], r2[2], r1;
#pragma unroll
    for (int k = 0; k < 8; ++k) r8[k] = swap32_sum(a[k >> 2][k & 3], a[2 + (k >> 2)][k & 3]);
#pragma unroll
    for (int k = 0; k < 4; ++k) r4[k] = swap16_sum(r8[k], r8[4 + k]);
    { const bool up = lane & 2;
#pragma unroll
      for (int k = 0; k < 2; ++k) { const float mine = up ? r4[2 + k] : r4[k], theirs = up ? r4[k] : r4[2 + k]; r2[k] = mine + dpp_f<0x4E>(theirs); } }
    { const bool up = lane & 1; const float mine = up ? r2[1] : r2[0], theirs = up ? r2[0] : r2[1]; r1 = mine + dpp_f<0xB1>(theirs); }
    r1 += dpp_f<0x124>(r1); r1 += dpp_f<0x128>(r1);
    if ((lane & 12) == 0) lg[i * 16 + (((lane >> 4) << 2) | (lane & 3))] = r1;
}
__device__ __forceinline__ void ln1_router(LAS unsigned char* lds, const int l, const int nrows, const float* xin_lat, const float* xin_ctx, bf16_t* XB, const bf16_t* O,
        const float* mod, const float* g1, const float* b1, const float* router_w, const float* router_b, bf16_t* V, float* route, unsigned* list, unsigned* gcnt) {
    const int tid = otid(), lane = tid & 63, wid = __builtin_amdgcn_readfirstlane(tid >> 6);
    LAS float* Wl = (LAS float*)lds; LAS float* lg = (LAS float*)(lds + LG_OFF) + wid * (34 * 16);
    LAS unsigned* cnt = (LAS unsigned*)(lds + CNT_OFF); LAS unsigned* base = (LAS unsigned*)(lds + BASE_OFF);
    for (int i = tid; i < 1024 * 16; i += NTHREADS) { const int k = i >> 4, e = i & 15, ln = (k & 255) >> 2, jj = (k >> 8) * 4 + (k & 3);
        Wl[(((jj * 4 + (e >> 2)) * 64 + ln) << 2) + (e & 3)] = router_w[i]; }
    if (tid < 16) cnt[tid] = 0u;
    __syncthreads();
    const int rpw = nrows / 256, rpv = rpw / 8;
    const int row0 = blockIdx.x * rpw + wid * rpv, rl = row0 + rpv - 1;
    Ln1Par P; P.cur_bi = -1;
    Raw2 RA, RB, RC;
    ln1_ld(RA, l, row0, rl, xin_lat, xin_ctx, XB, O, lane); ln1_ld(RB, l, row0 + 1, rl, xin_lat, xin_ctx, XB, O, lane);
    for (int i = 0; i < rpv; i += 3) {
        ln1_ld(RC, l, row0 + i + 2, rl, xin_lat, xin_ctx, XB, O, lane);
        ln1_row(RA, P, l, row0 + i, i, XB, mod, g1, b1, V, Wl, lg, lane);
        if (i + 1 >= rpv) break;
        ln1_ld(RA, l, row0 + i + 3, rl, xin_lat, xin_ctx, XB, O, lane);
        ln1_row(RB, P, l, row0 + i + 1, i + 1, XB, mod, g1, b1, V, Wl, lg, lane);
        if (i + 2 >= rpv) break;
        ln1_ld(RB, l, row0 + i + 4, rl, xin_lat, xin_ctx, XB, O, lane);
        ln1_row(RC, P, l, row0 + i + 2, i + 2, XB, mod, g1, b1, V, Wl, lg, lane);
    }
    LDS_WAIT();
    int e0 = 0, e1 = 0; float w0 = 0.f, w1 = 0.f; unsigned lp0 = 0, lp1 = 0;
    if (lane < rpv) {
        float sc[16], sel[16];
#pragma unroll
        for (int e = 0; e < 16; ++e) { sc[e] = 1.0f / (1.0f + __expf(-lg[lane * 16 + e])); sel[e] = sc[e] + router_b[e]; }
        float gs[4];
#pragma unroll
        for (int g = 0; g < 4; ++g) { const float s0 = sel[4 * g], s1 = sel[4 * g + 1], s2 = sel[4 * g + 2], s3 = sel[4 * g + 3];
            gs[g] = fmaxf(fmaxf(fmaxf(s0 + s1, s0 + s2), fmaxf(s0 + s3, s1 + s2)), fmaxf(s1 + s3, s2 + s3)); }
        int best = 0; float bv = gs[0];
#pragma unroll
        for (int g = 1; g < 4; ++g) if (gs[g] > bv) { bv = gs[g]; best = g; }
        float a4[4], c4[4];
#pragma unroll
        for (int k = 0; k < 4; ++k) { a4[k] = sel[k]; c4[k] = sc[k]; }
#pragma unroll
        for (int g = 1; g < 4; ++g) if (best == g) {
#pragma unroll
            for (int k = 0; k < 4; ++k) { a4[k] = sel[4 * g + k]; c4[k] = sc[4 * g + k]; } }
        int i0 = 0; float v0 = a4[0], s0 = c4[0];
#pragma unroll
        for (int k = 1; k < 4; ++k) if (a4[k] > v0) { v0 = a4[k]; i0 = k; s0 = c4[k]; }
        int i1 = -1; float v1 = 0.f, s1 = 0.f;
#pragma unroll
        for (int k = 0; k < 4; ++k) if (k != i0 && (i1 < 0 || a4[k] > v1)) { v1 = a4[k]; i1 = k; s1 = c4[k]; }
        e0 = best * 4 + i0; e1 = best * 4 + i1; const float inv = 1.0f / (s0 + s1); w0 = s0 * inv; w1 = s1 * inv;
        lp0 = atomicAdd((unsigned*)(cnt + e0), 1u); lp1 = atomicAdd((unsigned*)(cnt + e1), 1u);
    }
    __syncthreads();
    if (tid < 16) base[tid] = atomicAdd(gcnt + tid, cnt[tid]);
    __syncthreads();
    if (lane < rpv) { const int row = row0 + lane;
        ((u32x2*)list)[(size_t)e0 * NTOK + base[e0] + lp0] = (u32x2){(unsigned)row * 2u, __float_as_uint(w0)}; ((u32x2*)list)[(size_t)e1 * NTOK + base[e1] + lp1] = (u32x2){(unsigned)row * 2u + 1u, __float_as_uint(w1)};
        *(f32x4*)(route + (size_t)row * 4) = (f32x4){__int_as_float(e0), __int_as_float(e1), w0, w1}; }
    __syncthreads();
}

struct Raw3 { u32x2 x[4], f0[4], f1[4]; };
__device__ __forceinline__ void ld_raw3(Raw3& r, const bf16_t* XB, const bf16_t* F0, const bf16_t* F1, const int row, const int lane) {
    const size_t o = (size_t)row * 1024 + 4 * lane;
#pragma unroll
    for (int j = 0; j < 4; ++j) { r.x[j] = *(const u32x2*)(XB + o + 256 * j); r.f0[j] = *(const u32x2*)(F0 + o + 256 * j); r.f1[j] = *(const u32x2*)(F1 + o + 256 * j); } }
__device__ __forceinline__ f32x4 cvt4(const u32x2 w) { return (f32x4){bflo(w.x), bfhi(w.x), bflo(w.y), bfhi(w.y)}; }
struct Ln2Par { Vec gate, gg, bb, s1, s0; int cur_bi; };
__device__ __forceinline__ void ln2_row(const Raw3& R, Ln2Par& P, const int l, const int row, float* out_lat, bf16_t* XB, const float* mod, const float* g2, const float* b2, bf16_t* U, const int lane) {
    const bool lat = row < NLAT; const int bi = lat ? (row >> 12) : 16;
    if (bi != P.cur_bi) { P.cur_bi = bi; const float* mb = mod + ((size_t)(l * 17 + bi) * 6) * 1024;
        P.gate = ldv(mb + 5 * 1024, lane); P.gg = ldv(g2 + l * 1024, lane); P.bb = ldv(b2 + l * 1024, lane);
        if (l + 1 < DEPTH) { const float* mn = mod + ((size_t)((l + 1) * 17 + bi) * 6) * 1024; P.s0 = ldv(mn, lane); P.s1 = ldv(mn + 1024, lane);
#pragma unroll
            for (int j = 0; j < 4; ++j) P.s1.v[j] = P.s1.v[j] + 1.0f; }
        __builtin_amdgcn_s_waitcnt(0x0F70); }
    Vec y;
#pragma unroll
    for (int j = 0; j < 4; ++j) y.v[j] = cvt4(R.x[j]) * DN_ALPHA + P.gate.v[j] * (cvt4(R.f0[j]) + cvt4(R.f1[j]));
    normalize(y);
#pragma unroll
    for (int j = 0; j < 4; ++j) y.v[j] = y.v[j] * P.gg.v[j] + P.bb.v[j];
    if (l + 1 < DEPTH) stbf(XB + (size_t)row * 1024, lane, y); else stf(out_lat + (size_t)row * 1024, lane, y);
    if (l + 1 < DEPTH) { Vec u;
#pragma unroll
        for (int j = 0; j < 4; ++j) u.v[j] = y.v[j] * P.s1.v[j] + P.s0.v[j];
        stbf(U + (size_t)row * 1024, lane, u); }
}
__device__ __forceinline__ void ln2(const int l, const int nrows, float* out_lat, bf16_t* XB, const bf16_t* F0, const bf16_t* F1, const float* mod, const float* g2, const float* b2, bf16_t* U, const int gw, const int ngw) {
    const int lane = otid() & 63;
    const int per = (nrows + ngw - 1) / ngw;
    const int r0 = gw * per, rend = (r0 + per < nrows) ? r0 + per : nrows;
    Ln2Par P; P.cur_bi = -1;
    if (r0 >= rend) return;
    const int rl = rend - 1;
    Raw3 A, B, C;
    ld_raw3(A, XB, F0, F1, r0, lane);
    ld_raw3(B, XB, F0, F1, (r0 + 1 < rl) ? r0 + 1 : rl, lane);
    for (int row = r0; row < rend; row += 3) {
        ld_raw3(C, XB, F0, F1, (row + 2 < rl) ? row + 2 : rl, lane);
        ln2_row(A, P, l, row, out_lat, XB, mod, g2, b2, U, lane);
        if (row + 1 >= rend) break;
        ld_raw3(A, XB, F0, F1, (row + 3 < rl) ? row + 3 : rl, lane);
        ln2_row(B, P, l, row + 1, out_lat, XB, mod, g2, b2, U, lane);
        if (row + 2 >= rend) break;
        ld_raw3(B, XB, F0, F1, (row + 4 < rl) ? row + 4 : rl, lane);
        ln2_row(C, P, l, row + 2, out_lat, XB, mod, g2, b2, U, lane);
    }
}
}

namespace pro {
template <class Src>
__device__ __forceinline__ void tr_item(const Src& src, bf16_t* WT, const int K, const int n0, const int k0, LAS float* scr, const int lane) {
    float tv[32];
#pragma unroll
    for (int i = 0; i < 32; ++i) tv[i] = src(n0 + (lane & 31), k0 + 2 * i + (lane >> 5));
#pragma unroll
    for (int i = 0; i < 32; ++i) { const int kk = 2 * i + (lane >> 5); scr[kk * 33 + (lane & 31)] = tv[i]; }
    LDS_WAIT(); asm volatile("" ::: "memory");
    const int c = lane & 7;
#pragma unroll
    for (int j = 0; j < 4; ++j) { const int n = (lane >> 3) + 8 * j; const LAS float* s = scr + (8 * c) * 33 + n;
        u32x4 o; o.x = pk2(s[0 * 33], s[1 * 33]); o.y = pk2(s[2 * 33], s[3 * 33]); o.z = pk2(s[4 * 33], s[5 * 33]); o.w = pk2(s[6 * 33], s[7 * 33]);
        *(u32x4*)(WT + (size_t)(n0 + n) * K + k0 + 8 * c) = o; }
    LDS_WAIT(); asm volatile("" ::: "memory");
}
__device__ __forceinline__ int rotperm(int p) { return 16 * ((p >> 2) & 1) + 4 * (p >> 3) + (p & 3); }
struct SrcIn { const float* w; __device__ float operator()(int n, int k) const { if (n >= D_IN) return 0.f; const int g = n >> 5; const bool rt = (g >= 16 && g < 40) || g == 64;
    const int col = rt ? (g * 32 + rotperm(n & 31)) : n; return w[(size_t)k * D_IN + col]; } };
struct SrcOut { const float* w; __device__ float operator()(int n, int k) const { return w[(size_t)k * 1024 + n]; } };
struct Src13 { const float* w1; const float* w3; __device__ float operator()(int n, int k) const { const int g = n >> 5, p = n & 31, col = 16 * g + 4 * (p >> 3) + (p & 3);
    const float a = w1[(size_t)k * 256 + col], b = w3[(size_t)k * 256 + col]; return ((p >> 2) & 1) ? b : a; } };
struct Src2 { const float* w; __device__ float operator()(int n, int k) const { return w[(size_t)k * 1024 + n]; } };
struct SrcUQ { const float* w; const float* g; __device__ float operator()(int n, int k) const { if (n >= 576) return 0.f; const int gr = n >> 5, head = gr / 3, part = gr % 3;
    const int col = head * 96 + part * 32 + (part == 2 ? rotperm(n & 31) : (n & 31)); return g[k] * w[(size_t)k * 576 + col]; } };
struct SrcUKV { const float* w; const float* g; __device__ float operator()(int n, int k) const { return g[k] * w[(size_t)k * 768 + n]; } };
struct SrcG { const float* wa; const float* wi; __device__ float operator()(int n, int k) const { const int hb = n >> 8, o = n & 255, d = o >> 7, gt = (o >> 6) & 1, ch = o & 63;
    const size_t ix = (((size_t)d * 4 + hb) * 64 + k) * 64 + ch; const float a = wa[ix], b = wi[ix]; return gt ? b : a; } };
}


struct Args { const float* in[30]; float* out; unsigned char* ws; int ph_lo, ph_hi; };
constexpr int NPHASE = 2 + 9 * DEPTH;
typedef __attribute__((address_space(4))) const Args CArgs;
__device__ __forceinline__ CArgs* kargs() { CArgs* p = (CArgs*)__builtin_amdgcn_kernarg_segment_ptr(); asm volatile("" : "+s"(p)); return p; }
#define WSP(T, off) ((T*)(ws + (off)))
#ifndef PHMASK
#define PHMASK 0xFFFFFFFFu
#endif
#define PHON(j) ((PHMASK >> (j)) & 1u)

__global__ void __launch_bounds__(NTHREADS, 2) fwd_kernel(Args args_unused) {
    extern __shared__ __attribute__((aligned(16))) unsigned char lds_raw[];
    LAS unsigned char* lds = (LAS unsigned char*)lds_raw;
    const int tid = threadIdx.x;
    const int G = gridDim.x, bx = blockIdx.x; const int vcu = (G % 8 == 0) ? (bx % 8) * (G / 8) + bx / 8 : bx;
    static_assert(WIDTAB_OFF == MISC_OFF + 512 && WIDTAB_OFF + 256 <= LDS_BYTES, "wave-id table");
    for (int u = tid; u < (LDS_BYTES - MISC_OFF) / 4; u += NTHREADS) ((LAS unsigned*)(lds + MISC_OFF))[u] = 0u;
    __syncthreads();
    if ((tid & 63) == 0) { const unsigned hw = (unsigned)__builtin_amdgcn_s_getreg((5 << 11) | (0 << 6) | 4) & 63u; ((LAS int*)(lds + WIDTAB_OFF))[hw] = tid >> 6; }
    __syncthreads();
    int lo, hi;
    XcdBarrier bar;
    { CArgs* A = kargs(); lo = A->ph_lo; hi = A->ph_hi; unsigned* bw = (unsigned*)(A->ws + WS_CTL) + CW_BAR;
      bar.bar = bw; bar.x = 0; bar.st = nullptr;
      if (hi - lo > 1) bar = xcd_barrier_post(bw, (volatile LAS unsigned*)(lds + MISC_OFF) + 8); }
#define IN(k) (lo <= (k) && (k) < hi)
#define SEAM(k) do { if (IN(k) && IN((k) + 1)) xcd_barrier(bar); } while (0)

    if (PHON(0) && IN(0)) {
        CArgs* A = kargs(); unsigned char* ws = A->ws;
        const int lane = tid & 63, wave = __builtin_amdgcn_readfirstlane(tid >> 6); const int gw = vcu * NWAVES + wave, NGW = G * NWAVES;
        if (bx == G - 1) {
            float* ROT = WSP(float, WS_ROT); const float* diff_lambda = A->in[15];
            for (int i = tid; i < 512; i += NTHREADS) { const int pos = i >> 3, f = i & 7; const float inv = exp2f(-(float)f * (13.287712379549449f / 8.0f)); const float ang = (float)pos * inv;
                ROT[i] = __cosf(ang); ROT[512 + i] = __sinf(ang); }
            if (tid < DEPTH) { const float* lv = diff_lambda + tid * 128; float s01 = 0.f, s23 = 0.f; for (int k = 0; k < 32; ++k) { s01 += lv[k] * lv[32 + k]; s23 += lv[64 + k] * lv[96 + k]; }
                ROT[1024 + tid] = expf(s01) - expf(s23) + (0.8f - 0.6f * expf(-0.3f * (float)tid)); }
        }
        if (bx < 192) {
            const float* c_in = A->in[1]; const float* cctx_in = A->in[3]; const float* w_mod = A->in[4]; const float* b_mod = A->in[5]; float* MOD = WSP(float, WS_MOD);
            LAS float* S = (LAS float*)lds;
            LAS float* red = (LAS float*)(lds + 81920);
            for (int i = tid; i < 17 * 1024; i += NTHREADS) { const int bi = i >> 10, k = i & 1023; const float cv = (bi < 16) ? c_in[bi * 1024 + k] : cctx_in[k]; S[k * 20 + bi] = cv / (1.0f + __expf(-cv)); }
            __syncthreads();
            for (int item = bx; item < 192; item += G) {
                const int l = item / 48, n0 = (item % 48) * 128, kg = tid >> 7, cl = tid & 127;
                float acc[17];
#pragma unroll
                for (int b = 0; b < 17; ++b) acc[b] = 0.f;
                const float* wp = w_mod + ((size_t)l * 1024 + kg * 256) * 6144 + n0 + cl;
#pragma unroll 16
                for (int k = 0; k < 256; ++k) { const float w = wp[(size_t)k * 6144]; const LAS float* sp = S + (kg * 256 + k) * 20;
                    const f32x4 s0 = *(const LAS f32x4*)sp, s1 = *(const LAS f32x4*)(sp + 4), s2 = *(const LAS f32x4*)(sp + 8), s3 = *(const LAS f32x4*)(sp + 12); const float s4 = sp[16];
#pragma unroll
                    for (int b = 0; b < 4; ++b) { acc[b] += s0[b] * w; acc[4 + b] += s1[b] * w; acc[8 + b] += s2[b] * w; acc[12 + b] += s3[b] * w; }
                    acc[16] += s4 * w; }
#pragma unroll
                for (int b = 0; b < 17; ++b) red[(kg * 17 + b) * 128 + cl] = acc[b];
                __syncthreads();
                for (int i = tid; i < 17 * 128; i += NTHREADS) { const int b = i >> 7, c = i & 127; const float v = red[(0 * 17 + b) * 128 + c] + red[(1 * 17 + b) * 128 + c] + red[(2 * 17 + b) * 128 + c] + red[(3 * 17 + b) * 128 + c];
                    const int n = n0 + c, j = n >> 10, col = n & 1023; MOD[((size_t)(l * 17 + b) * 6 + j) * 1024 + col] = v + b_mod[l * 6144 + n]; }
                __syncthreads();
            }
        }
        __syncthreads();
        { LAS float* scr = (LAS float*)(lds + wave * 8448);
          constexpr int I_IN = 72 * 16, I_OUT = 32 * 16, I_13 = 16 * 16, I_2 = 32 * 4, I_UQ = 24 * 4, I_UKV = 24 * 2, I_G = 32;
          constexpr int T_IN = DEPTH * I_IN, T_OUT = DEPTH * I_OUT, T_13 = DEPTH * NEXP * I_13, T_2 = DEPTH * NEXP * I_2, T_UQ = DEPTH * I_UQ, T_UKV = DEPTH * I_UKV, T_G = DEPTH * I_G;
          constexpr int NITEMS = T_IN + T_OUT + T_13 + T_2 + T_UQ + T_UKV + T_G;
          for (int it = gw; it < NITEMS; it += NGW) {
              int r = it;
              if (r < T_IN) { const int l = r / I_IN, q = r % I_IN; pro::tr_item(pro::SrcIn{A->in[6] + (size_t)l * 1024 * D_IN}, WSP(bf16_t, WS_WIN) + (size_t)l * NIN_PAD * 1024, 1024, (q >> 4) * 32, (q & 15) * 64, scr, lane); continue; } r -= T_IN;
              if (r < T_OUT) { const int l = r / I_OUT, q = r % I_OUT; pro::tr_item(pro::SrcOut{A->in[7] + (size_t)l * 1024 * 1024}, WSP(bf16_t, WS_WOUT) + (size_t)l * 1024 * 1024, 1024, (q >> 4) * 32, (q & 15) * 64, scr, lane); continue; } r -= T_OUT;
              if (r < T_13) { const int le = r / I_13, q = r % I_13; pro::tr_item(pro::Src13{A->in[27] + (size_t)le * 1024 * 256, A->in[28] + (size_t)le * 1024 * 256}, WSP(bf16_t, WS_W13) + (size_t)le * 512 * 1024, 1024, (q >> 4) * 32, (q & 15) * 64, scr, lane); continue; } r -= T_13;
              if (r < T_2) { const int le = r / I_2, q = r % I_2; pro::tr_item(pro::Src2{A->in[29] + (size_t)le * 256 * 1024}, WSP(bf16_t, WS_W2) + (size_t)le * 1024 * 256, 256, (q >> 2) * 32, (q & 3) * 64, scr, lane); continue; } r -= T_2;
              if (r < T_UQ) { const int l = r / I_UQ, q = r % I_UQ; pro::tr_item(pro::SrcUQ{A->in[19] + (size_t)l * 256 * 576, A->in[17] + l * 256}, WSP(bf16_t, WS_WUQ) + (size_t)l * 768 * 256, 256, (q >> 2) * 32, (q & 3) * 64, scr, lane); continue; } r -= T_UQ;
              if (r < T_UKV) { const int l = r / I_UKV, q = r % I_UKV; pro::tr_item(pro::SrcUKV{A->in[20] + (size_t)l * 128 * 768, A->in[18] + l * 128}, WSP(bf16_t, WS_WUKV) + (size_t)l * 768 * 128, 128, (q >> 1) * 32, (q & 1) * 64, scr, lane); continue; } r -= T_UKV;
              { const int l = r / I_G, q = r % I_G; pro::tr_item(pro::SrcG{A->in[10] + (size_t)l * 2 * 4 * 64 * 64, A->in[12] + (size_t)l * 2 * 4 * 64 * 64}, WSP(bf16_t, WS_WG) + (size_t)l * 1024 * 64, 64, q * 32, 0, scr, lane); }
          } }
        __syncthreads();
    }
    SEAM(0);
    if (PHON(1) && IN(1)) {
        CArgs* A = kargs(); unsigned char* ws = A->ws; const float* x_in = A->in[0]; const float* ctx_in = A->in[2]; const float* MOD = WSP(float, WS_MOD); bf16_t* U = WSP(bf16_t, WS_U);
        const int lane = tid & 63, wave = __builtin_amdgcn_readfirstlane(tid >> 6); const int gw = vcu * NWAVES + wave, NGW = G * NWAVES;
        const int per = NTOK / NGW;
        int cur_bi = -1; lnp::Vec s0, s1;
        const int r0 = gw * per, rl = r0 + per - 1;
#define PB_LD(R, r_) do { const int rr_ = ((r_) < rl) ? (r_) : rl; R = lnp::ldv(rr_ < NLAT ? x_in + (size_t)rr_ * 1024 : ctx_in + (size_t)(rr_ - NLAT) * 1024, lane); } while (0)
#define PB_ROW(R, row_) do { const int row = (row_); const bool lat = row < NLAT; const int bi = lat ? (row >> 12) : 16; \
            if (bi != cur_bi) { cur_bi = bi; const float* mb = MOD + ((size_t)bi * 6) * 1024; s0 = lnp::ldv(mb, lane); s1 = lnp::ldv(mb + 1024, lane); \
                _Pragma("unroll") for (int j = 0; j < 4; ++j) s1.v[j] = s1.v[j] + 1.0f; \
                __builtin_amdgcn_s_waitcnt(0x0F70); } \
            lnp::Vec xv; _Pragma("unroll") for (int j = 0; j < 4; ++j) xv.v[j] = R.v[j] * s1.v[j] + s0.v[j]; \
            lnp::stbf(U + (size_t)row * 1024, lane, xv); } while (0)
        lnp::Vec RA, RB, RC; PB_LD(RA, r0); PB_LD(RB, r0 + 1);
        for (int i = 0; i < per; i += 3) {
            PB_LD(RC, r0 + i + 2); PB_ROW(RA, r0 + i);
            if (i + 1 >= per) break;
            PB_LD(RA, r0 + i + 3); PB_ROW(RB, r0 + i + 1);
            if (i + 2 >= per) break;
            PB_LD(RB, r0 + i + 4); PB_ROW(RC, r0 + i + 2);
        }
#undef PB_LD
#undef PB_ROW
    }
    SEAM(1);

    for (int l = 0; l < DEPTH; ++l) {
        const int pb = 2 + 9 * l;
        const bool need_ctx = l < DEPTH - 1;
        const int mrows = need_ctx ? NTOK : NLAT;
        if (PHON(2) && IN(pb)) {
            CArgs* A = kargs(); unsigned char* ws = A->ws;
            { const float* ROT = WSP(float, WS_ROT); for (int i = otid(); i < 1024; i += NTHREADS) ((LAS float*)(lds + ROT_OFF))[i] = ROT[i]; }
            __syncthreads();
            pg8::StaticOrder S; S.init(NTOK, NIN_PAD, G, bx);
            EpiInProj E{WSP(bf16_t, WS_XL), WSP(bf16_t, WS_GG), WSP(bf16_t, WS_QD), WSP(bf16_t, WS_KD), WSP(bf16_t, WS_VD), WSP(bf16_t, WS_CQ), WSP(bf16_t, WS_CKV), WSP(bf16_t, WS_KR),
                        WSP(float, WS_SSP), (const LAS float*)(lds + ROT_OFF)};
            pg8::gemm_phase<EpiInProj, pg8::StaticOrder, false>(lds, WSP(bf16_t, WS_U), WSP(bf16_t, WS_WIN) + (size_t)l * NIN_PAD * 1024, 1024, S, E);
        }
        SEAM(pb);
        if (PHON(3) && IN(pb + 1)) {
            { CArgs* A = kargs(); unsigned char* ws = A->ws;
              { const float* ROT = WSP(float, WS_ROT); for (int i = otid(); i < 1024; i += NTHREADS) ((LAS float*)(lds + ROT_OFF))[i] = ROT[i]; }
              __syncthreads();
              pg8::StaticOrder S; S.init(NTOK, 768, G, bx); EpiExpQ E{WSP(bf16_t, WS_QM), WSP(float, WS_SSP), (const LAS float*)(lds + ROT_OFF)};
              pg8::gemm_phase<EpiExpQ, pg8::StaticOrder, false>(lds, WSP(bf16_t, WS_CQ), WSP(bf16_t, WS_WUQ) + (size_t)l * 768 * 256, 256, S, E); }
            __syncthreads(); asm volatile("" ::: "memory");
            { CArgs* A = kargs(); unsigned char* ws = A->ws;
              pg8::StaticOrder S; S.init(NTOK, 768, G, bx); EpiExpKV E{WSP(bf16_t, WS_KN), WSP(bf16_t, WS_VM), WSP(float, WS_SSP)};
              pg8::gemm_phase<EpiExpKV, pg8::StaticOrder, false>(lds, WSP(bf16_t, WS_CKV), WSP(bf16_t, WS_WUKV) + (size_t)l * 768 * 128, 128, S, E); }
            __syncthreads(); asm volatile("" ::: "memory");
            { CArgs* A = kargs(); unsigned char* ws = A->ws;
              lru::WaveCtx W; lru::load_ctx(W, l, WSP(bf16_t, WS_WG), A->in[8], A->in[9], A->in[11], A->in[13], A->in[14]);
              lru::run_chunks<false>(lds, W, vcu, G, NCHUNK, WSP(bf16_t, WS_XL), WSP(bf16_t, WS_GG), WSP(float, WS_LSUM), WSP(float, WS_LCAR), WSP(bf16_t, WS_MIX));
              __syncthreads(); }
        }
        SEAM(pb + 1);
        if (PHON(4) && IN(pb + 2)) { CArgs* A = kargs(); unsigned char* ws = A->ws; lru::carry(WSP(float, WS_LSUM), WSP(float, WS_LCAR)); }
        SEAM(pb + 2);
        if (PHON(5) && IN(pb + 3)) {
            { CArgs* A = kargs(); unsigned char* ws = A->ws;
              lru::WaveCtx W; lru::load_ctx(W, l, WSP(bf16_t, WS_WG), A->in[8], A->in[9], A->in[11], A->in[13], A->in[14]);
              const int nch = need_ctx ? NCHUNK : NCHUNK_LAT;
              lru::run_chunks<true>(lds, W, vcu, G, nch, WSP(bf16_t, WS_XL), WSP(bf16_t, WS_GG), WSP(float, WS_LSUM), WSP(float, WS_LCAR), WSP(bf16_t, WS_MIX));
              __syncthreads(); }
            asm volatile("" ::: "memory");
            for (int ph_ = 0; ph_ < 2; ++ph_) {
            const bool mla_now = ((ph_ ^ (vcu >> 5)) & 1) != 0;
            asm volatile("" ::: "memory");
            if (!mla_now)
            { CArgs* A = kargs(); unsigned char* ws = A->ws;
              const float lam_init = 0.8f - 0.6f * expf(-0.3f * (float)l);
              attd::Tens T{WSP(bf16_t, WS_QD), 384, 0, WSP(bf16_t, WS_KD), nullptr, WSP(bf16_t, WS_VD), 0, WSP(bf16_t, WS_MIX), 256, WSP(float, WS_ROT)[1024 + l], 1.0f - lam_init, A->in[16] + l * 64};
              for (int i = 0; i < 6; ++i) { const int uidx = vcu + 256 * i; if (uidx < 1536) { const int bh = uidx >> 4, qb = uidx & 15, b = bh / 6, h = bh % 6;
                  T.qcol = h * 64; T.kvcol = h * 64; T.ocol = 256 + h * 64; attd::attn_unit<0>(lds, T, b, false, qb); } }
              if (need_ctx && vcu < 96) { const int b = vcu / 6, h = vcu % 6; T.qcol = h * 64; T.kvcol = h * 64; T.ocol = 256 + h * 64; attd::attn_unit<0>(lds, T, b, true, 0); } }
            else
            { CArgs* A = kargs(); unsigned char* ws = A->ws;
              atts::Src S1{WSP(bf16_t, WS_QM), 576, 0, WSP(bf16_t, WS_KN), 0, WSP(bf16_t, WS_KR), WSP(bf16_t, WS_VM), 0};
              for (int i = 0; i < 7; ++i) {
                  const bool cx = (i == 6); if (cx && !(need_ctx && vcu >= 96 && vcu < 192)) break;
                  const int uidx = vcu + 256 * i; const int bh = cx ? vcu - 96 : (uidx >> 4), qb = cx ? 0 : (uidx & 15), b = bh / 6, h = bh % 6;
                  f32x16 oa[2]; atts::Sm sa;
                  S1.qcol = h * 96; S1.kcol = h * 64; S1.vcol = h * 64;
                  atts::attn_pass<1>(lds, S1, b, cx, qb, oa, sa);
                  atts::attn_store<false>(lds, oa, sa, oa, sa, 0.f, 0.f, nullptr, WSP(bf16_t, WS_MIX), 640 + h * 64, b, cx, qb);
              } }
            }
        }
        SEAM(pb + 3);
        if (PHON(6) && IN(pb + 4)) {
            CArgs* A = kargs(); unsigned char* ws = A->ws;
            pg8::StaticOrder S; S.init(mrows, 1024, G, bx); EpiPlain E{WSP(bf16_t, WS_O), 1024};
            pg8::gemm_phase<EpiPlain, pg8::StaticOrder, false>(lds, WSP(bf16_t, WS_MIX), WSP(bf16_t, WS_WOUT) + (size_t)l * 1024 * 1024, 1024, S, E);
        }
        SEAM(pb + 4);
        if (PHON(7) && IN(pb + 5)) {
            CArgs* A = kargs(); unsigned char* ws = A->ws;
            lnp::ln1_router(lds, l, mrows, A->in[0], A->in[2], WSP(bf16_t, WS_XB), WSP(bf16_t, WS_O), WSP(float, WS_MOD), A->in[21], A->in[22], A->in[25], A->in[26],
                            WSP(bf16_t, WS_V), WSP(float, WS_ROUTE), WSP(unsigned, WS_LIST), WSP(unsigned, WS_CTL) + CW_CNT + 64 * l);
        }
        SEAM(pb + 5);
        if (PHON(8) && (IN(pb + 6) || IN(pb + 7))) {
            CArgs* A = kargs(); unsigned char* ws = A->ws;
            LAS int* tb = (LAS int*)(lds + MISC_OFF + 256);
            __syncthreads();
            if (otid() == 0) { gu32* gcnt = (gu32*)WSP(unsigned, WS_CTL) + CW_CNT + 64 * l; int off = 0, toff = 0;
                for (int e = 0; e < 16; ++e) { const int c = (int)__hip_atomic_load(gcnt + e, __ATOMIC_RELAXED, __HIP_MEMORY_SCOPE_AGENT); tb[e] = c; tb[16 + e] = off; tb[33 + e] = toff; off += c; toff += (c + 255) >> 8; }
                tb[32] = off; tb[49] = toff; }
            __syncthreads();
            if (IN(pb + 6)) {
                MoeSched S{tb, WSP(unsigned, WS_LIST), G, bx, 2}; EpiMoeUp E{WSP(bf16_t, WS_H)};
                pg8::gemm_phase<EpiMoeUp, MoeSched, true>(lds, WSP(bf16_t, WS_V), WSP(bf16_t, WS_W13) + (size_t)l * NEXP * 512 * 1024, 1024, S, E);
            }
        }
        SEAM(pb + 6);
        if (PHON(9) && IN(pb + 7)) {
            CArgs* A = kargs(); unsigned char* ws = A->ws;
            LAS int* tb = (LAS int*)(lds + MISC_OFF + 256);
            MoeSched S{tb, WSP(unsigned, WS_LIST), G, bx, 4}; EpiMoeDown E{WSP(bf16_t, WS_F0), WSP(bf16_t, WS_F1), WSP(unsigned, WS_LIST), WSP(float, WS_ROUTE)};
            pg8::gemm_phase<EpiMoeDown, MoeSched, false>(lds, WSP(bf16_t, WS_H), WSP(bf16_t, WS_W2) + (size_t)l * NEXP * 1024 * 256, 256, S, E);
        }
        SEAM(pb + 7);
        if (PHON(10) && IN(pb + 8)) {
            CArgs* A = kargs(); unsigned char* ws = A->ws; const int wave = __builtin_amdgcn_readfirstlane(otid() >> 6);
            lnp::ln2(l, mrows, A->out, WSP(bf16_t, WS_XB), WSP(bf16_t, WS_F0), WSP(bf16_t, WS_F1), WSP(float, WS_MOD), A->in[23], A->in[24], WSP(bf16_t, WS_U), vcu * NWAVES + wave, G * NWAVES);
        }
        SEAM(pb + 8);
    }
#undef IN
#undef SEAM
}

#ifndef MK_SPLIT
#define MK_SPLIT 0
#endif
extern "C" void kernel_launch(void* const* d_in, const int* in_sizes, int n_in, void* d_out, int out_size, void* d_ws, size_t ws_size, hipStream_t stream) {
    static int grid = 0;
    if (grid == 0) {
        if (n_in != 30 || out_size != NLAT * DM || ws_size < WS_END) { fprintf(stderr, "kernel_launch: unexpected problem (n_in %d out %d ws %zu)\n", n_in, out_size, ws_size); grid = -1; return; }
        int dev = 0, cus = 0;
        if (hipGetDevice(&dev) != hipSuccess || hipDeviceGetAttribute(&cus, hipDeviceAttributeMultiprocessorCount, dev) != hipSuccess) { grid = -1; return; }
        if (hipFuncSetAttribute((const void*)fwd_kernel, hipFuncAttributeMaxDynamicSharedMemorySize, LDS_BYTES) != hipSuccess) { fprintf(stderr, "kernel_launch: hipFuncSetAttribute failed\n"); grid = -1; return; }
        int per_cu = 0;
        if (hipOccupancyMaxActiveBlocksPerMultiprocessor(&per_cu, (const void*)fwd_kernel, NTHREADS, LDS_BYTES) != hipSuccess || per_cu < 1) fprintf(stderr, "kernel_launch: occupancy query says %d\n", per_cu);
        (void)hipGetLastError();
        grid = cus;
        if (grid != 256) { fprintf(stderr, "kernel_launch: built for 256 CUs, device has %d\n", cus); grid = -1; return; }
    }
    if (grid < 0) return;
    if (hipMemsetAsync((char*)d_ws + WS_CTL, 0, CTL_ZERO_BYTES, stream) != hipSuccess) return;
    Args a{};
    for (int i = 0; i < 30; ++i) a.in[i] = (const float*)d_in[i];
    a.out = (float*)d_out; a.ws = (unsigned char*)d_ws;
#if MK_SPLIT
    for (int p = 0; p < NPHASE; ++p) { a.ph_lo = p; a.ph_hi = p + 1; hipLaunchKernelGGL(fwd_kernel, dim3(grid), dim3(NTHREADS), LDS_BYTES, stream, a); }
#else
    a.ph_lo = 0; a.ph_hi = NPHASE; hipLaunchKernelGGL(fwd_kernel, dim3(grid), dim3(NTHREADS), LDS_BYTES, stream, a);
#endif
}
```

```cpp
#include <hip/hip_runtime.h>
#include <cstdio>
#include <cstdint>

#define LAS __attribute__((address_space(3)))
#define GAS __attribute__((address_space(1)))
typedef unsigned short bf16_t;
typedef short bf16x8 __attribute__((ext_vector_type(8)));
typedef short s16x4 __attribute__((ext_vector_type(4)));
typedef float f32x2 __attribute__((ext_vector_type(2)));
typedef float f32x4 __attribute__((ext_vector_type(4)));
typedef float f32x16 __attribute__((ext_vector_type(16)));
typedef unsigned u32x2 __attribute__((ext_vector_type(2)));
typedef unsigned u32x4 __attribute__((ext_vector_type(4)));
typedef GAS unsigned gu32;

constexpr int DM = 1024, NBATCH = 16, SEQ = 4096, DEPTH = 4, CTXL = 256;
constexpr int NLAT = NBATCH * SEQ, NCTX = NBATCH * CTXL, NTOK = NLAT + NCTX;
constexpr int D_IN = 2080, NIN_PAD = 2304;
constexpr int NEXP = 16, DEXP = 256;
constexpr int NWAVES = 8, NTHREADS = 512;
constexpr float LN_EPS = 1e-5f, RMS_EPS = 1e-6f;
constexpr float DN_ALPHA = 1.6817928305074292f;
constexpr float LOG2E = 1.4426950408889634f;
constexpr float DA_QSCALE = 0.17677669529663687f * LOG2E;
constexpr float MLA_QSCALE = 0.10206207261596577f * LOG2E;
constexpr int NCHUNK_LAT = NLAT / 32, NCHUNK = NTOK / 32;

constexpr size_t MiB = 1u << 20;
constexpr size_t WS_CTL = 0, CTL_ZERO_BYTES = 1 * MiB;
constexpr size_t WS_MOD = 1 * MiB;
constexpr size_t WS_ROT = 3 * MiB;
constexpr size_t WS_SSQ = 4 * MiB;
constexpr size_t WS_ROUTE = 7 * MiB;
constexpr size_t WS_LIST = 154 * MiB;
constexpr size_t WS_LSUM = 14 * MiB;
constexpr size_t WS_LCAR = 23 * MiB;
constexpr size_t WS_WG = 28 * MiB;
constexpr size_t WS_WUQ = 29 * MiB;
constexpr size_t WS_WUKV = 31 * MiB;
constexpr size_t WS_WIN = 32 * MiB;
constexpr size_t WS_WOUT = 50 * MiB;
constexpr size_t WS_W13 = 58 * MiB;
constexpr size_t WS_W2 = 122 * MiB;
constexpr size_t WS_XC = 154 * MiB;
constexpr size_t WS_R1 = 170 * MiB;
constexpr size_t WS_R2 = 306 * MiB;
constexpr size_t WS_R3 = 442 * MiB;
constexpr size_t WS_R4 = 578 * MiB;
constexpr size_t WS_U = WS_R1, WS_MIX = WS_R1;
constexpr size_t WS_O = WS_R2, WS_F0 = WS_R2, WS_QD = WS_R2, WS_KD = WS_R2 + 51 * MiB, WS_XL = WS_R2 + 102 * MiB;
constexpr size_t WS_V = WS_R3, WS_F1 = WS_R3, WS_VD = WS_R3, WS_KN = WS_R3 + 51 * MiB, WS_GG = WS_R3 + 102 * MiB;
constexpr size_t WS_VM = WS_R4, WS_QM = WS_R4 + 51 * MiB, WS_CQ = WS_R4 + 128 * MiB, WS_CKV = WS_R4 + 162 * MiB, WS_KR = WS_R4 + 179 * MiB, WS_H = WS_R4;
constexpr size_t WS_XB = WS_R4 + 184 * MiB;
constexpr size_t WS_SSP = WS_XB + 136 * MiB;
constexpr size_t WS_END = WS_SSP + 4 * MiB;
static_assert((size_t)NTOK * 384 * 2 <= 51 * MiB && (size_t)NTOK * 256 * 2 <= 34 * MiB && (size_t)NTOK * 576 * 2 <= 77 * MiB && (size_t)NTOK * 1024 * 2 == 136 * MiB, "ws map");
static_assert((size_t)(2 * NTOK + 256) * 256 * 2 <= 128 * MiB, "H overlay");
constexpr int CW_BAR = 4096;
constexpr int CW_CNT = 2048;

constexpr int RING_BYTES = 155648;
constexpr int ROT_OFF = RING_BYTES;
constexpr int MISC_OFF = ROT_OFF + 4096;

constexpr int LDS_BYTES = 163840;

#define LDS_WAIT() asm volatile("s_waitcnt lgkmcnt(0)" ::: "memory")
#define VM_WAIT() asm volatile("s_waitcnt vmcnt(0)" ::: "memory")
__device__ __forceinline__ unsigned f2bf(float f) { unsigned u = __builtin_bit_cast(unsigned, f); return (u + 0x7fffu + ((u >> 16) & 1u)) >> 16; }
__device__ __forceinline__ unsigned pk2(float lo, float hi) { return f2bf(lo) | (f2bf(hi) << 16); }
typedef float f32x2_t __attribute__((ext_vector_type(2))); typedef __bf16 bf16x2_t __attribute__((ext_vector_type(2)));
__device__ __forceinline__ unsigned cvt_pk_bf16(float lo, float hi) { f32x2_t v = {lo, hi}; bf16x2_t b = __builtin_convertvector(v, bf16x2_t); return __builtin_bit_cast(unsigned, b); }
__device__ __forceinline__ float bf2f(unsigned h) { return __uint_as_float(h << 16); }
__device__ __forceinline__ float bflo(unsigned w) { return __uint_as_float(w << 16); }
__device__ __forceinline__ float bfhi(unsigned w) { return __uint_as_float(w & 0xffff0000u); }
template <int CTRL> __device__ __forceinline__ float dpp_f(float v) { return __builtin_bit_cast(float, __builtin_amdgcn_update_dpp(0, __builtin_bit_cast(int, v), CTRL, 0xF, 0xF, true)); }
__device__ __forceinline__ float wave_sum(float v) {
    v += dpp_f<0xB1>(v); v += dpp_f<0x4E>(v); v += dpp_f<0x124>(v); v += dpp_f<0x128>(v);
    { auto rr = __builtin_amdgcn_permlane16_swap(__float_as_uint(v), __float_as_uint(v), false, false); v = __uint_as_float(rr[0]) + __uint_as_float(rr[1]); }
    { auto rr = __builtin_amdgcn_permlane32_swap(__float_as_uint(v), __float_as_uint(v), false, false); v = __uint_as_float(rr[0]) + __uint_as_float(rr[1]); }
    return v;
}
__device__ __forceinline__ float fast_exp2(float x) { return __builtin_amdgcn_exp2f(x); }
__device__ __forceinline__ float fast_rcp(float x) { return __builtin_amdgcn_rcpf(x); }
__device__ __forceinline__ float sigmoidf_(float x) { return fast_rcp(1.0f + fast_exp2(-LOG2E * x)); }
__device__ __forceinline__ float gelu_tanh(float x) { const float z = 0.7978845608028654f * (x + 0.044715f * x * x * x); return x * fast_rcp(1.0f + fast_exp2(-2.0f * LOG2E * z)); }
constexpr int WIDTAB_OFF = 159744 + 512;
__device__ __forceinline__ int otid() {
    const unsigned hw = (unsigned)__builtin_amdgcn_s_getreg((5 << 11) | (0 << 6) | 4) & 63u;
    int w = ((const LAS int*)(size_t)WIDTAB_OFF)[hw];
    int t = (w << 6) | (int)__builtin_amdgcn_mbcnt_hi(~0u, __builtin_amdgcn_mbcnt_lo(~0u, 0u));
    asm volatile("" : "+v"(t)); return t; }
__device__ __forceinline__ int crow(int r, int hi) { return (r & 3) + 8 * (r >> 2) + 4 * hi; }
__device__ __forceinline__ f32x16 mfma32(bf16x8 a, bf16x8 b, f32x16 c) { return __builtin_amdgcn_mfma_f32_32x32x16_bf16(a, b, c, 0, 0, 0); }

#define XB_TMO      128
#define XB_XCNT(j)  (256  + 64 * (j))
#define XB_XSUB(j)  (1280 + 64 * (j))
#define XB_XGEN(j)  (2304 + 64 * (j))
#define XB_TOP      3328
#define XB_TOPGEN   3392
#define XCD_BAR_WORDS 3456
#define XB_SPIN_CAP (1u << 18)

__device__ __forceinline__ unsigned xb_ld(unsigned* p)              { return __hip_atomic_load(p, __ATOMIC_RELAXED, __HIP_MEMORY_SCOPE_AGENT); }
__device__ __forceinline__ unsigned xb_add(unsigned* p, unsigned v) { return __hip_atomic_fetch_add(p, v, __ATOMIC_RELAXED, __HIP_MEMORY_SCOPE_AGENT); }
__device__ __forceinline__ unsigned xb_xcc_id() { return (unsigned)__builtin_amdgcn_s_getreg((3 << 11) | 20) & 0xFu; }
#define XB_SPIN(cond, bar) do { unsigned _sp = 0; while (cond) { __builtin_amdgcn_s_sleep(1); \
    if ((++_sp & 255u) == 0u) { if (xb_ld(&(bar)[XB_TMO])) break; if (_sp > XB_SPIN_CAP) { atomicAdd(&(bar)[XB_TMO], 1u); break; } } } } while (0)

struct XcdBarrier {
    unsigned* bar; unsigned x;
    volatile LAS unsigned* st;
};

__device__ __forceinline__ XcdBarrier xcd_barrier_post(unsigned* bar, volatile LAS unsigned* st) {
    XcdBarrier b; b.bar = bar; b.x = xb_xcc_id(); b.st = st;
    if (threadIdx.x == 0) (void)xb_add(&bar[XB_XCNT(b.x)], 1u);
    return b;
}
__device__ __forceinline__ void xcd_barrier_complete(unsigned* bar, unsigned x, unsigned& nloc, unsigned& nx) {
    const unsigned G = gridDim.x * gridDim.y * gridDim.z;
    unsigned sum, cnt, mine, sp = 0u;
    for (;;) {
        sum = 0u; cnt = 0u; mine = 0u;
#pragma unroll
        for (unsigned j = 0; j < 16; ++j) { const unsigned c = xb_ld(&bar[XB_XCNT(j)]); sum += c; cnt += (c > 0u) ? 1u : 0u; mine = (j == x) ? c : mine; }
        if (sum == G) break;
        __builtin_amdgcn_s_sleep(1);
        if ((++sp & 255u) == 0u) { if (xb_ld(&bar[XB_TMO])) break; if (sp > XB_SPIN_CAP) { atomicAdd(&bar[XB_TMO], 1u); break; } }
    }
    nloc = mine > 0u ? mine : 1u; nx = cnt > 0u ? cnt : 1u;
}

__device__ __forceinline__ void xcd_barrier(const XcdBarrier& b) {
    asm volatile("s_waitcnt vmcnt(0)" ::: "memory");
    __syncthreads();
    if (otid() == 0) {
        unsigned* bar = b.bar; unsigned bx_ = b.x; asm volatile("" : "+s"(bar), "+s"(bx_));
        __builtin_amdgcn_s_waitcnt(0);
        unsigned nloc = b.st[0], nx = b.st[1];
        if (nloc == 0u) { xcd_barrier_complete(bar, bx_, nloc, nx); b.st[0] = nloc; b.st[1] = nx; }
        const unsigned old = xb_add(&bar[XB_XSUB(bx_)], 1u);
        const unsigned gen = old / nloc;
        if (old + 1u == (gen + 1u) * nloc) {
            __builtin_amdgcn_fence(__ATOMIC_RELEASE, "agent");
            asm volatile("s_waitcnt vmcnt(0)" ::: "memory");
            const unsigned og = xb_add(&bar[XB_TOP], 1u);
            const unsigned tg = og / nx;
            if (og + 1u == (tg + 1u) * nx) xb_add(&bar[XB_TOPGEN], 1u);
            else XB_SPIN(xb_ld(&bar[XB_TOPGEN]) == tg, bar);
            __builtin_amdgcn_fence(__ATOMIC_ACQUIRE, "agent");
            xb_add(&bar[XB_XGEN(bx_)], 1u);
            asm volatile("s_waitcnt vmcnt(0)" ::: "memory");
        } else {
            XB_SPIN(xb_ld(&bar[XB_XGEN(bx_)]) == gen, bar);
            __builtin_amdgcn_fence(__ATOMIC_ACQUIRE, "agent");
            asm volatile("s_waitcnt vmcnt(0)" ::: "memory");
        }
    }
    __syncthreads();
}

namespace pg8 {
constexpr int BM = 256, BK = 64, HALF = 128, HTB = HALF * BK * 2  , STAGE_BYTES = 8 * HTB, NXCD = 8, WGM = 8;
__host__ __device__ __forceinline__ int lds_byte(int r, int c) { const int st = (r >> 4) * 2 + (c >> 5), rr = r & 15, cc = c & 31, ob = rr * 64 + cc * 2; return st * 1024 + (ob ^ (((ob >> 9) & 1) << 5)); }
__host__ __device__ __forceinline__ void stage_rc(int b, int& R, int& C) { const int st = b / 1024, sb = b % 1024, swz = sb ^ (((sb >> 9) & 1) << 5); R = (st >> 1) * 16 + swz / 64; C = (st & 1) * 32 + (swz % 64) / 2; }
__host__ __device__ __forceinline__ int perm32(int rho) { const int n = rho >> 4, i = rho & 15; return 8 * (i >> 2) + 4 * n + (i & 3); }

struct Unit { int arow, brow, pm, pn, e, nvalid; };

struct StaticOrder {
    int nM, nN, nwg, G, c;
    __device__ void init(int M, int N, int G_, int c_) { nM = M / BM; nN = N / BM; nwg = nM * nN; G = G_; c = c_; }
    __device__ bool next(int i, Unit& u) const {
        const long L = (long)i * G + c; if (L >= nwg) return false;
        int wgid = (int)L; { const int q = nwg / NXCD, r = nwg % NXCD, xcd = wgid % NXCD, off = wgid / NXCD; wgid = (xcd < r ? xcd * (q + 1) : r * (q + 1) + (xcd - r) * q) + off; }
        const int nig = WGM * nN, gid = wgid / nig, fm = gid * WGM, gsz = (nM - fm) < WGM ? (nM - fm) : WGM;
        u.pm = fm + ((wgid % nig) % gsz); u.pn = (wgid % nig) / gsz; u.arow = u.pm * BM; u.brow = u.pn * BM; u.e = 0; u.nvalid = BM; return true;
    }
    __device__ __forceinline__ unsigned goff(const Unit&, int) const { return 0u; }
};

template <class Epi, class Sched, bool GATHER>
__device__ __forceinline__ void gemm_phase(LAS unsigned char* lds, const bf16_t* Ag, const bf16_t* Btg, const int K_, const Sched& S, const Epi& E) {
    int K = K_; asm volatile("" : "+s"(K));
    const int tid = otid(), wid = __builtin_amdgcn_readfirstlane(tid >> 6), lane = tid & 63, wr = wid >> 2, wc = wid & 3, fr = lane & 15, fq = lane >> 4;
    const int nt = K / BK;
    unsigned voffA[2], voffB[2];
#pragma unroll
    for (int i = 0; i < 2; ++i) { int R, C; stage_rc(tid * 16 + i * 8192, R, C); const int Rb = (R & ~31) + perm32(R & 31);
        voffA[i] = (unsigned)(R * K + C) * 2u; voffB[i] = (unsigned)(Rb * K + C) * 2u; }
    const size_t kstep = (size_t)(BK * 2);
    const size_t hstep = (size_t)HALF * K * 2;
    const unsigned ldsw = (unsigned)wid * 1024u;
    const int aoff = lds_byte(wr * 64 + fr, fq * 8), boff = lds_byte(wc * 32 + fr, fq * 8);
    unsigned vAc[2][2], vAn[2][2];
#define PG8_SA(b, h) (((b) * 2 + (h)) * HTB)
#define PG8_SB(b, h) ((4 + (b) * 2 + (h)) * HTB)
#define PG8_STAGE(bufoff, gbase, voff) do { _Pragma("unroll") for (int _i = 0; _i < 2; ++_i) \
        __builtin_amdgcn_global_load_lds((const unsigned*)((const char*)(gbase) + (voff)[_i]), (LAS unsigned*)(lds + (bufoff) + ldsw + _i * 8192), 16, 0, 0); } while (0)
#define PG8_STAGE_A(bufoff, base, h, nx) do { if constexpr (GATHER) { _Pragma("unroll") for (int _i = 0; _i < 2; ++_i) \
        __builtin_amdgcn_global_load_lds((const unsigned*)((const char*)(base) + ((nx) ? vAn[h][_i] : vAc[h][_i])), (LAS unsigned*)(lds + (bufoff) + ldsw + _i * 8192), 16, 0, 0); } \
        else { PG8_STAGE(bufoff, (const char*)(base) + (h) * hstep, voffA); } } while (0)
#define PG8_LDA(dst, b, h) do { _Pragma("unroll") for (int m = 0; m < 4; ++m) _Pragma("unroll") for (int k = 0; k < 2; ++k) dst[m][k] = *(const LAS bf16x8*)(lds + PG8_SA(b, h) + aoff + m * 2048 + k * 1024); } while (0)
#define PG8_LDB(dst, b, h) do { _Pragma("unroll") for (int n = 0; n < 2; ++n) _Pragma("unroll") for (int k = 0; k < 2; ++k) dst[n][k] = *(const LAS bf16x8*)(lds + PG8_SB(b, h) + boff + n * 2048 + k * 1024); } while (0)
#define PG8_MMA(ai, bj, At, Bt) do { __builtin_amdgcn_s_setprio(1); _Pragma("unroll") for (int m = 0; m < 4; ++m) _Pragma("unroll") for (int n = 0; n < 2; ++n) _Pragma("unroll") for (int k = 0; k < 2; ++k) \
        acc[ai][bj][m][n] = __builtin_amdgcn_mfma_f32_16x16x32_bf16(Bt[n][k], At[m][k], acc[ai][bj][m][n], 0, 0, 0); __builtin_amdgcn_s_setprio(0); } while (0)
#define PG8_WAIT_V(n) asm volatile("s_waitcnt vmcnt(" #n ")" ::: "memory")
#define PG8_WAIT_L(n) asm volatile("s_waitcnt lgkmcnt(" #n ")" ::: "memory")
#define PG8_BAR __builtin_amdgcn_s_barrier()
#define PG8_SCHED __builtin_amdgcn_sched_barrier(0)
#define PG8_GOFF(u, v) do { if constexpr (GATHER) { const int _t = otid(); _Pragma("unroll") for (int _i = 0; _i < 2; ++_i) { int _R, _C; stage_rc(_t * 16 + _i * 8192, _R, _C); \
        _Pragma("unroll") for (int _h = 0; _h < 2; ++_h) v[_h][_i] = (S.goff(u, _h * HALF + _R) + (unsigned)_C) * 2u; } } } while (0)
    Unit cur, nxt; int ui = 0;
    if (!S.next(0, cur)) return;
    f32x4 acc[2][2][4][2];
#pragma unroll
    for (int a = 0; a < 2; ++a)
#pragma unroll
        for (int b = 0; b < 2; ++b)
#pragma unroll
            for (int m = 0; m < 4; ++m)
#pragma unroll
                for (int n = 0; n < 2; ++n) acc[a][b][m][n] = (f32x4){0.f, 0.f, 0.f, 0.f};
    bf16x8 At[4][2], B0[2][2], B1[2][2];
    PG8_GOFF(cur, vAc);
#pragma unroll
    for (int _h = 0; _h < 2; ++_h)
#pragma unroll
        for (int _i = 0; _i < 2; ++_i) vAn[_h][_i] = vAc[_h][_i];
    const char* cA = GATHER ? (const char*)Ag : (const char*)Ag + (size_t)cur.arow * K * 2; const char* cB = (const char*)Btg + (size_t)cur.brow * K * 2;
    PG8_STAGE(PG8_SB(0, 0), cB, voffB); PG8_STAGE(PG8_SB(0, 1), cB + hstep, voffB); PG8_STAGE_A(PG8_SA(0, 0), cA, 0, false); PG8_STAGE_A(PG8_SA(0, 1), cA, 1, false);
    if (wr == 1) PG8_BAR;
    PG8_WAIT_V(2); PG8_BAR;
    PG8_STAGE(PG8_SB(1, 0), cB + kstep, voffB); PG8_STAGE_A(PG8_SA(1, 0), cA + kstep, 0, false); PG8_STAGE(PG8_SB(1, 1), cB + hstep + kstep, voffB);
    PG8_WAIT_V(6); PG8_BAR;
    for (;;) {
        const bool has_next = S.next(ui + 1, nxt);
        if (has_next) { PG8_GOFF(nxt, vAn); }
        const char* nA = GATHER ? (const char*)Ag : (has_next ? (const char*)Ag + (size_t)nxt.arow * K * 2 : cA); const char* nB = has_next ? (const char*)Btg + (size_t)nxt.brow * K * 2 : cB;
#pragma nounroll
        for (int t = 0; t < nt; t += 2) {
            const bool last = (t == nt - 2);
            const char* a1 = cA + (size_t)(t + 1) * kstep;
            const char* a2 = last ? nA : cA + (size_t)(t + 2) * kstep; const char* b2 = last ? nB : cB + (size_t)(t + 2) * kstep;
            const char* a3 = a2 + kstep; const char* b3 = b2 + kstep;
            PG8_LDB(B0, 0, 0); PG8_LDB(B1, 0, 1); PG8_SCHED; PG8_LDA(At, 0, 0); PG8_STAGE_A(PG8_SA(1, 1), a1, 1, false);
            PG8_WAIT_V(8); PG8_WAIT_L(0); PG8_BAR; PG8_MMA(0, 0, At, B0); PG8_MMA(0, 1, At, B1); PG8_BAR; PG8_SCHED;
            PG8_LDA(At, 0, 1); PG8_STAGE(PG8_SB(0, 0), b2, voffB); PG8_STAGE(PG8_SB(0, 1), b2 + hstep, voffB); PG8_STAGE_A(PG8_SA(0, 0), a2, 0, last);
            PG8_WAIT_V(8); PG8_WAIT_L(0); PG8_BAR; PG8_MMA(1, 0, At, B0); PG8_MMA(1, 1, At, B1); PG8_BAR; PG8_SCHED;
            PG8_LDB(B0, 1, 0); PG8_LDB(B1, 1, 1); PG8_SCHED; PG8_LDA(At, 1, 0); PG8_STAGE_A(PG8_SA(0, 1), a2, 1, last);
            PG8_WAIT_V(8); PG8_WAIT_L(0); PG8_BAR; PG8_MMA(0, 0, At, B0); PG8_MMA(0, 1, At, B1); PG8_BAR; PG8_SCHED;
            PG8_LDA(At, 1, 1); PG8_STAGE(PG8_SB(1, 0), b3, voffB); PG8_STAGE(PG8_SB(1, 1), b3 + hstep, voffB); PG8_STAGE_A(PG8_SA(1, 0), a3, 0, last);
            PG8_WAIT_V(8); PG8_WAIT_L(0); PG8_BAR; PG8_MMA(1, 0, At, B0); PG8_MMA(1, 1, At, B1); PG8_BAR; PG8_SCHED;
        }
        if (wr == 0) PG8_BAR;
        E(acc, cur, wr, wc, fr, fq);
        if (!has_next) break;
#pragma unroll
        for (int a = 0; a < 2; ++a)
#pragma unroll
            for (int b = 0; b < 2; ++b)
#pragma unroll
                for (int m = 0; m < 4; ++m)
#pragma unroll
                    for (int n = 0; n < 2; ++n) acc[a][b][m][n] = (f32x4){0.f, 0.f, 0.f, 0.f};
        cur = nxt; cA = nA; cB = nB; ++ui;
#pragma unroll
        for (int _h = 0; _h < 2; ++_h)
#pragma unroll
            for (int _i = 0; _i < 2; ++_i) vAc[_h][_i] = vAn[_h][_i];
        if (wr == 1) PG8_BAR;
    }
    PG8_WAIT_V(0);
    PG8_BAR;
#undef PG8_SA
#undef PG8_SB
#undef PG8_STAGE
#undef PG8_STAGE_A
#undef PG8_LDA
#undef PG8_LDB
#undef PG8_MMA
#undef PG8_WAIT_V
#undef PG8_WAIT_L
#undef PG8_BAR
#undef PG8_SCHED
#undef PG8_GOFF
}
}

using pg8::Unit;
__device__ __forceinline__ void st16(bf16_t* p, f32x4 v0, f32x4 v1) { u32x4 w; w.x = cvt_pk_bf16(v0[0], v0[1]); w.y = cvt_pk_bf16(v0[2], v0[3]); w.z = cvt_pk_bf16(v1[0], v1[1]); w.w = cvt_pk_bf16(v1[2], v1[3]); *(u32x4*)p = w; }
__device__ __forceinline__ void st8(bf16_t* p, f32x4 v) { u32x2 w; w.x = cvt_pk_bf16(v[0], v[1]); w.y = cvt_pk_bf16(v[2], v[3]); *(u32x2*)p = w; }

__device__ __forceinline__ void rot4(f32x4& x1, f32x4& x2, const LAS float* rot, int row, int fq) {
    const int t = row & (SEQ - 1), pos = (fq < 2) ? (t >> 6) : (t & 63);
    const f32x4 c = *(const LAS f32x4*)(rot + pos * 8 + 4 * (fq & 1)), s = *(const LAS f32x4*)(rot + 512 + pos * 8 + 4 * (fq & 1));
    const f32x4 a = x1 * c - x2 * s, b = x1 * s + x2 * c; x1 = a; x2 = b;
}

struct EpiInProj {
    bf16_t *XL, *GG, *QD, *KD, *VD, *CQ, *CKV, *KR; float* ssq; const LAS float* rot;
    __device__ __forceinline__ void operator()(const f32x4 (&acc)[2][2][4][2], const Unit& u, int wr, int wc, int fr, int fq) const {
#pragma unroll
        for (int bj = 0; bj < 2; ++bj) {
            const int g = u.pn * 8 + bj * 4 + wc;
            if (g >= 65) continue;
            bf16_t* dst; int pitch, gl, kind = 0, sq = -1; float sc = 1.0f;
            if (g < 8) { dst = XL; pitch = 256; gl = g; }
            else if (g < 16) { dst = GG; pitch = 256; gl = g - 8; kind = 1; }
            else if (g < 28) { dst = QD; pitch = 384; gl = g - 16; kind = 2; sc = DA_QSCALE; }
            else if (g < 40) { dst = KD; pitch = 384; gl = g - 28; kind = 2; }
            else if (g < 52) { dst = VD; pitch = 384; gl = g - 40; }
            else if (g < 60) { dst = CQ; pitch = 256; gl = g - 52; sq = 0; }
            else if (g < 64) { dst = CKV; pitch = 128; gl = g - 60; sq = 1; }
            else { dst = KR; pitch = 32; gl = 0; kind = 2; }
#pragma unroll
            for (int ai = 0; ai < 2; ++ai)
#pragma unroll
                for (int m = 0; m < 4; ++m) {
                    const int row = u.pm * 256 + ai * 128 + wr * 64 + m * 16 + fr;
                    f32x4 v0 = acc[ai][bj][m][0], v1 = acc[ai][bj][m][1];
                    bf16_t* rp = dst + (size_t)row * pitch + gl * 32;
                    if (kind == 2) {
                        if (row < NLAT) rot4(v0, v1, rot, row, fq);
                        v0 = v0 * sc; v1 = v1 * sc;
                        st8(rp + 4 * fq, v0); st8(rp + 16 + 4 * fq, v1);
                    } else {
                        if (kind == 1) {
#pragma unroll
                            for (int j = 0; j < 4; ++j) { v0[j] = gelu_tanh(v0[j]); v1[j] = gelu_tanh(v1[j]); }
                        }
                        if (sq >= 0) {
                            float s = (v0[0] * v0[0] + v0[1] * v0[1]) + (v0[2] * v0[2] + v0[3] * v0[3]) + (v1[0] * v1[0] + v1[1] * v1[1]) + (v1[2] * v1[2] + v1[3] * v1[3]);
                            s += __shfl_xor(s, 16); s += __shfl_xor(s, 32);
                            if (fq == 0) ssq[(size_t)row * 12 + (g - 52)] = s;
                        }
                        st16(rp + 8 * fq, v0, v1);
                    }
                }
        }
    }
};

struct EpiExpQ {
    bf16_t* QM; const float* ssq; const LAS float* rot;
    __device__ __forceinline__ void operator()(const f32x4 (&acc)[2][2][4][2], const Unit& u, int wr, int wc, int fr, int fq) const {
        float rs[2][4];
#pragma unroll
        for (int ai = 0; ai < 2; ++ai)
#pragma unroll
            for (int m = 0; m < 4; ++m) { const int row = u.pm * 256 + ai * 128 + wr * 64 + m * 16 + fr; const f32x4 pa_ = *(const f32x4*)(ssq + (size_t)row * 12), pb_ = *(const f32x4*)(ssq + (size_t)row * 12 + 4);
                rs[ai][m] = rsqrtf((((pa_[0] + pa_[1]) + (pa_[2] + pa_[3])) + ((pb_[0] + pb_[1]) + (pb_[2] + pb_[3]))) * (1.0f / 256.0f) + RMS_EPS) * MLA_QSCALE; }
#pragma unroll
        for (int bj = 0; bj < 2; ++bj) {
            const int g = u.pn * 8 + bj * 4 + wc;
            if (g >= 18) continue;
            const int head = g / 3, part = g % 3;
#pragma unroll
            for (int ai = 0; ai < 2; ++ai)
#pragma unroll
                for (int m = 0; m < 4; ++m) {
                    const int row = u.pm * 256 + ai * 128 + wr * 64 + m * 16 + fr;
                    f32x4 v0 = acc[ai][bj][m][0] * rs[ai][m], v1 = acc[ai][bj][m][1] * rs[ai][m];
                    bf16_t* rp = QM + (size_t)row * 576 + head * 96 + part * 32;
                    if (part == 2) { if (row < NLAT) rot4(v0, v1, rot, row, fq); st8(rp + 4 * fq, v0); st8(rp + 16 + 4 * fq, v1); }
                    else st16(rp + 8 * fq, v0, v1);
                }
        }
    }
};
struct EpiExpKV {
    bf16_t *KN, *VM; const float* ssq;
    __device__ __forceinline__ void operator()(const f32x4 (&acc)[2][2][4][2], const Unit& u, int wr, int wc, int fr, int fq) const {
        float rs[2][4];
#pragma unroll
        for (int ai = 0; ai < 2; ++ai)
#pragma unroll
            for (int m = 0; m < 4; ++m) { const int row = u.pm * 256 + ai * 128 + wr * 64 + m * 16 + fr; const f32x4 pc_ = *(const f32x4*)(ssq + (size_t)row * 12 + 8);
                rs[ai][m] = rsqrtf(((pc_[0] + pc_[1]) + (pc_[2] + pc_[3])) * (1.0f / 128.0f) + RMS_EPS); }
#pragma unroll
        for (int bj = 0; bj < 2; ++bj) {
            const int g = u.pn * 8 + bj * 4 + wc;
            const int head = g >> 2, part = g & 3;
            bf16_t* base = (part < 2 ? KN : VM) + head * 64 + (part & 1) * 32 + 8 * fq;
#pragma unroll
            for (int ai = 0; ai < 2; ++ai)
#pragma unroll
                for (int m = 0; m < 4; ++m) {
                    const int row = u.pm * 256 + ai * 128 + wr * 64 + m * 16 + fr;
                    st16(base + (size_t)row * 384, acc[ai][bj][m][0] * rs[ai][m], acc[ai][bj][m][1] * rs[ai][m]);
                }
        }
    }
};
struct EpiPlain {
    bf16_t* O; int ldc;
    __device__ __forceinline__ void operator()(const f32x4 (&acc)[2][2][4][2], const Unit& u, int wr, int wc, int fr, int fq) const {
#pragma unroll
        for (int ai = 0; ai < 2; ++ai)
#pragma unroll
            for (int m = 0; m < 4; ++m) {
                bf16_t* rp = O + (size_t)(u.pm * 256 + ai * 128 + wr * 64 + m * 16 + fr) * ldc + u.pn * 256 + wc * 32 + 8 * fq;
#pragma unroll
                for (int bj = 0; bj < 2; ++bj) st16(rp + bj * 128, acc[ai][bj][m][0], acc[ai][bj][m][1]);
            }
    }
};

struct MoeSched {
    const LAS int* tb;
    const unsigned* list;
    int G, c, ncol;
    __device__ bool next(int i, Unit& u) const {
        const int L = i * G + c, T = tb[33 + 16];
        if (L >= T * ncol) return false;
        const int tl = L / ncol; u.pn = L % ncol;
        int e = 0;
#pragma unroll
        for (int k = 1; k < 16; ++k) e += (tl >= tb[33 + k]) ? 1 : 0;
        u.e = e; u.pm = tl - tb[33 + e]; u.nvalid = tb[e] - u.pm * 256; if (u.nvalid > 256) u.nvalid = 256;
        u.arow = tb[16 + e] + u.pm * 256; u.brow = (e * ncol + u.pn) * 256;
        return true;
    }
    __device__ __forceinline__ unsigned goff(const Unit& u, int r) const {
        const int rc = r < u.nvalid ? r : u.nvalid - 1; const unsigned ent = list[((size_t)u.e * NTOK + u.pm * 256 + rc) * 2];
        return (ent >> 1) * 1024u;
    }
};
struct EpiMoeUp {
    bf16_t* H;
    __device__ __forceinline__ void operator()(const f32x4 (&acc)[2][2][4][2], const Unit& u, int wr, int wc, int fr, int fq) const {
#pragma unroll
        for (int ai = 0; ai < 2; ++ai)
#pragma unroll
            for (int m = 0; m < 4; ++m) {
                const int r = ai * 128 + wr * 64 + m * 16 + fr;
                if (r < u.nvalid) {
                    bf16_t* rp = H + (size_t)(u.arow + r) * 256 + (u.pn & 1) * 128 + wc * 16 + 4 * fq;
#pragma unroll
                    for (int bj = 0; bj < 2; ++bj) { const f32x4 a = acc[ai][bj][m][0], b = acc[ai][bj][m][1]; f32x4 h;
#pragma unroll
                        for (int j = 0; j < 4; ++j) h[j] = a[j] * sigmoidf_(a[j]) * b[j];
                        st8(rp + bj * 64, h); }
                }
            }
    }
};
struct EpiMoeDown {
    bf16_t *F0, *F1; const unsigned* list; const float* route;
    __device__ __forceinline__ void operator()(const f32x4 (&acc)[2][2][4][2], const Unit& u, int wr, int wc, int fr, int fq) const {
        const u32x2* lp = (const u32x2*)list + (size_t)u.e * NTOK + u.pm * 256;
#pragma unroll
        for (int ai = 0; ai < 2; ++ai) {
            u32x2 ew[4];
#pragma unroll
            for (int m = 0; m < 4; ++m) { const int r = ai * 128 + wr * 64 + m * 16 + fr; const int rc = r < u.nvalid ? r : u.nvalid - 1; ew[m] = lp[rc]; }
#pragma unroll
            for (int m = 0; m < 4; ++m) {
                const int r = ai * 128 + wr * 64 + m * 16 + fr;
                if (r < u.nvalid) {
                    const unsigned tok = ew[m].x >> 1, kk = ew[m].x & 1u; const float ww = __uint_as_float(ew[m].y);
                    bf16_t* rp = F0 + (size_t)kk * (size_t)(F1 - F0) + (size_t)tok * 1024 + u.pn * 256 + wc * 32 + 8 * fq;
#pragma unroll
                    for (int bj = 0; bj < 2; ++bj) st16(rp + bj * 128, acc[ai][bj][m][0] * ww, acc[ai][bj][m][1] * ww);
                }
            }
            asm volatile("" ::: "memory");
        }
    }
};


__device__ __forceinline__ unsigned cvtpk_s(float lo, float hi) { f32x2_t v = {lo, hi}; bf16x2_t b = __builtin_convertvector(v, bf16x2_t); return __builtin_bit_cast(unsigned, b); }
__device__ __forceinline__ float max3f(float a, float b, float c) { float r; asm("v_max3_f32 %0, %1, %2, %3" : "=v"(r) : "v"(a), "v"(b), "v"(c)); return r; }
__device__ __forceinline__ float max2f(float a, float b) { float r; asm("v_max_f32_e32 %0, %1, %2" : "=v"(r) : "v"(a), "v"(b)); return r; }
__device__ __forceinline__ float mx2(float a, float b) { return __builtin_elementwise_maximum(a, b); }
__device__ __forceinline__ float rowmax32_fast(f32x16& p0, f32x16& p1) {
    float a = mx2(mx2(p0[0], p0[1]), p1[0]), b = mx2(mx2(p0[2], p0[3]), p1[1]); a = mx2(mx2(a, p1[2]), p1[3]);
#pragma unroll
    for (int r = 4; r < 16; r += 4) { a = mx2(mx2(a, p0[r]), p0[r + 1]); b = mx2(mx2(b, p0[r + 2]), p0[r + 3]); a = mx2(mx2(a, p1[r]), p1[r + 1]); b = mx2(mx2(b, p1[r + 2]), p1[r + 3]); }
    const float m = mx2(a, b);
    auto rr = __builtin_amdgcn_permlane32_swap(__float_as_uint(m), __float_as_uint(m), false, false);
    return mx2(__uint_as_float(rr[0]), __uint_as_float(rr[1]));
}
__device__ __forceinline__ bf16x8 pack8(const f32x16& p, const int b) { u32x4 w; w.x = cvtpk_s(p[b], p[b + 1]); w.y = cvtpk_s(p[b + 2], p[b + 3]); w.z = cvtpk_s(p[b + 4], p[b + 5]); w.w = cvtpk_s(p[b + 6], p[b + 7]); return __builtin_bit_cast(bf16x8, w); }
#define VTR_RD(dst, addr, off) asm volatile("ds_read_b64_tr_b16 %0, %1 offset:%c2" : "=&v"(dst) : "v"(addr), "i"(off) : "memory")
#define PV_BLOCK(vb_, db_, BODY) do { s16x4 lo_[4], hi_[4]; \
    _Pragma("unroll") for (int ks = 0; ks < 4; ++ks) { VTR_RD(lo_[ks], vb_, (db_) * 4096 + ks * 1024); VTR_RD(hi_[ks], vb_, (db_) * 4096 + ks * 1024 + 512); } \
    asm volatile("s_waitcnt lgkmcnt(0)" ::: "memory"); __builtin_amdgcn_sched_barrier(0); \
    _Pragma("unroll") for (int ks = 0; ks < 4; ++ks) { const bf16x8 vf = (bf16x8){lo_[ks][0], lo_[ks][1], lo_[ks][2], lo_[ks][3], hi_[ks][0], hi_[ks][1], hi_[ks][2], hi_[ks][3]}; BODY; } } while (0)
namespace attd {
typedef short v4i16_t __attribute__((ext_vector_type(4)));
constexpr float THR = 6.0f;
__device__ __forceinline__ float rowmax32(f32x16& p0, f32x16& p1) { return rowmax32_fast(p0, p1); }
struct Sm { float mhat, l; };
__device__ __forceinline__ void softmax_tile(f32x16& p0, f32x16& p1, Sm& st, f32x16 (&o)[2], const bool first, LAS float* wsf, const int r32, const int hi, bf16x8 (&pa)[4], f32x16& negm) {
    const float rm = rowmax32(p0, p1);
    if (first || __any(rm > THR)) {
        const float dl = first ? rm : fmaxf(rm, 0.f);
        st.mhat += dl;
#pragma unroll
        for (int r = 0; r < 16; ++r) { p0[r] -= dl; p1[r] -= dl; negm[r] = -st.mhat; }
        const float f = fminf(fast_exp2(-dl), 3.0e38f); st.l *= f;
        if (hi == 0) wsf[r32] = f;
        LDS_WAIT();
#pragma unroll
        for (int r = 0; r < 16; ++r) { const float fr_ = wsf[crow(r, hi)]; o[0][r] *= fr_; o[1][r] *= fr_; }
    }
    float s = 0.f;
#pragma unroll
    for (int r = 0; r < 16; ++r) { p0[r] = fast_exp2(p0[r]); p1[r] = fast_exp2(p1[r]); s = (s + p0[r]) + p1[r]; }
    st.l += s;
    pa[0] = pack8(p0, 0); pa[1] = pack8(p0, 8); pa[2] = pack8(p1, 0); pa[3] = pack8(p1, 8);
}
__device__ __forceinline__ void glds16(const bf16_t* src, LAS unsigned char* dst) { __builtin_amdgcn_global_load_lds((const unsigned*)src, (LAS unsigned*)dst, 16, 0, 0); }

#define KRD16(dst, addr, off) asm volatile("ds_read_b128 %0, %1 offset:%c2" : "=&v"(dst) : "v"(addr), "i"(off) : "memory")
#define MFMA_C(D, A, B, C) asm("v_mfma_f32_32x32x16_bf16 %0, %1, %2, %3" : "=&v"(D) : "v"(A), "v"(B), "v"(C))
struct Tens {
    const bf16_t* Q; int qpitch, qcol;
    const bf16_t* K; const bf16_t* KR; const bf16_t* V; int kvcol;
    bf16_t* O; int ocol;
    float lam, onem; const float* dn;
};
template <int MODE>
__device__ __forceinline__ void attn_unit(LAS unsigned char* lds, const Tens& T, const int b, const bool ctxq, const int qb) {
    constexpr int NCH = MODE ? 12 : 8, KSLOT = NCH * 1024, SLOT = KSLOT + 8192, NSLOT = 6;
    constexpr int WS_OFF = NSLOT * SLOT, OST_OFF = 0, QS_OFF = WS_OFF + 8 * 512;
    static_assert((MODE == 1 ? WS_OFF + 8 * 512 : QS_OFF + 8 * 4096) <= RING_BYTES && 8 * 8192 <= WS_OFF, "attention LDS");
    const int tid = otid(), lane = tid & 63, r32 = lane & 31, hi = lane >> 5, wid = __builtin_amdgcn_readfirstlane(tid >> 6);
    const int NT = ctxq ? 4 : 68;
    const int krow_ctx = NLAT + b * CTXL, krow_lat = b * SEQ;
    const int qrow0 = (ctxq ? krow_ctx : krow_lat + qb * 256) + wid * 32;
    LAS float* wsf = (LAS float*)(lds + WS_OFF + wid * 512);
    LAS float* stg = (LAS float*)(lds + OST_OFF + wid * 8192);
    static_assert(MODE == 0, "attd: differential attention only");
    const int kswz = (4 * (wid & 1) + (lane >> 4)) & 7;
#define ATT_ISSUE(t_) do { const int kr_ = ((t_) < 4) ? krow_ctx + 64 * (t_) : krow_lat + 64 * ((t_) - 4); const int so_ = ((t_) % NSLOT) * SLOT; \
        glds16(T.K + (size_t)(kr_ + 8 * wid + (lane >> 3)) * 384 + T.kvcol + (((lane & 7) ^ kswz) << 3), lds + so_ + wid * 1024); \
        glds16(T.V + (size_t)(kr_ + 16 * (wid & 3) + (lane >> 2)) * 384 + T.kvcol + (wid >> 2) * 32 + (lane & 3) * 8, lds + so_ + KSLOT + wid * 1024); } while (0)
    constexpr int NQ = MODE ? 6 : 4;
    bf16x8 qr[NQ];
    { const bf16_t* qp = T.Q + (size_t)(qrow0 + r32) * T.qpitch + T.qcol + hi * 8;
#pragma unroll
      for (int d0 = 0; d0 < NQ; ++d0) { const bf16x8 q = *(const bf16x8*)(qp + d0 * 16); if (MODE == 1) qr[d0] = q; else *(LAS bf16x8*)(lds + QS_OFF + wid * 4096 + d0 * 1024 + lane * 16) = q; } }
    const LAS unsigned char* ql = lds + QS_OFF + wid * 4096 + lane * 16;
    ATT_ISSUE(0); ATT_ISSUE(1); ATT_ISSUE(2); ATT_ISSUE(3);
    Sm st1{0.f, 0.f}, st2{0.f, 0.f};
    f32x16 o1[2], o2[2];
#pragma unroll
    for (int r = 0; r < 16; ++r) { o1[0][r] = 0.f; o1[1][r] = 0.f; o2[0][r] = 0.f; o2[1][r] = 0.f; }
    const int vlane = ((lane >> 4) & 1) * 32 + (lane & 3) * 8 + (4 * hi + ((lane & 15) >> 2)) * 64;
    f32x16 negm1, negm2;
#pragma unroll
    for (int r = 0; r < 16; ++r) { negm1[r] = 0.f; negm2[r] = 0.f; }
    for (int tp = 0; tp < NT; tp += 2) {
        if (tp + 2 < NT) { if (MODE == 1 && wid < 4) asm volatile("s_waitcnt vmcnt(6)" ::: "memory"); else asm volatile("s_waitcnt vmcnt(4)" ::: "memory"); }
        else asm volatile("s_waitcnt vmcnt(0)" ::: "memory");
        LDS_WAIT(); __builtin_amdgcn_s_barrier(); asm volatile("" ::: "memory");
        if (tp + 4 < NT) { ATT_ISSUE(tp + 4); ATT_ISSUE(tp + 5); }
#pragma unroll 1
      for (int t = tp; t < tp + 2; ++t) {
        const int s_cur = (t % NSLOT) * SLOT;
        const unsigned ka0 = (unsigned)(size_t)lds + s_cur + r32 * 128 + (((((r32 >> 1) & 7) ^ hi)) << 4);
        const unsigned vb = (unsigned)(size_t)(lds + s_cur + KSLOT + vlane);
        bf16x8 pa1[4], pa2[4];
        {
            f32x16 p10, p11, p20, p21; s16x4 vlo[4], vhi[4];
            { bf16x8 kf[8], qf[4]; const unsigned qb_ = (unsigned)(size_t)ql;
#pragma unroll
              for (int d0 = 0; d0 < 4; ++d0) { const unsigned kb_ = ka0 ^ (d0 << 5); KRD16(kf[2 * d0], kb_, 0); KRD16(kf[2 * d0 + 1], kb_, 4096); KRD16(qf[d0], qb_, d0 * 1024); }
              asm volatile("s_waitcnt lgkmcnt(6)" ::: "memory"); __builtin_amdgcn_sched_barrier(0);
              MFMA_C(p10, kf[0], qf[0], negm1); MFMA_C(p11, kf[1], qf[0], negm1); p10 = mfma32(kf[2], qf[1], p10); p11 = mfma32(kf[3], qf[1], p11);
              __builtin_amdgcn_sched_barrier(0);
#pragma unroll
              for (int ks = 0; ks < 4; ++ks) { VTR_RD(vlo[ks], vb, ks * 1024); VTR_RD(vhi[ks], vb, ks * 1024 + 512); }
              asm volatile("s_waitcnt lgkmcnt(8)" ::: "memory"); __builtin_amdgcn_sched_barrier(0);
              MFMA_C(p20, kf[4], qf[2], negm2); MFMA_C(p21, kf[5], qf[2], negm2); p20 = mfma32(kf[6], qf[3], p20); p21 = mfma32(kf[7], qf[3], p21);
              asm volatile("s_waitcnt lgkmcnt(0)" ::: "memory"); __builtin_amdgcn_sched_barrier(0); }
            softmax_tile(p10, p11, st1, o1, t == 0, wsf, r32, hi, pa1, negm1);
            softmax_tile(p20, p21, st2, o2, t == 0, wsf + 32, r32, hi, pa2, negm2);
            __builtin_amdgcn_sched_barrier(0);
            { s16x4 wlo[4], whi[4];
#pragma unroll
              for (int ks = 0; ks < 4; ++ks) { VTR_RD(wlo[ks], vb, 4096 + ks * 1024); VTR_RD(whi[ks], vb, 4096 + ks * 1024 + 512); }
#pragma unroll
              for (int ks = 0; ks < 4; ++ks) { const bf16x8 vf = (bf16x8){vlo[ks][0], vlo[ks][1], vlo[ks][2], vlo[ks][3], vhi[ks][0], vhi[ks][1], vhi[ks][2], vhi[ks][3]};
                  o1[0] = mfma32(pa1[ks], vf, o1[0]); o2[0] = mfma32(pa2[ks], vf, o2[0]); }
              asm volatile("s_waitcnt lgkmcnt(0)" ::: "memory"); __builtin_amdgcn_sched_barrier(0);
#pragma unroll
              for (int ks = 0; ks < 4; ++ks) { const bf16x8 vf = (bf16x8){wlo[ks][0], wlo[ks][1], wlo[ks][2], wlo[ks][3], whi[ks][0], whi[ks][1], whi[ks][2], whi[ks][3]};
                  o1[1] = mfma32(pa1[ks], vf, o1[1]); o2[1] = mfma32(pa2[ks], vf, o2[1]); } }
        }
      }
    }
#undef ATT_ISSUE
    LDS_WAIT(); __builtin_amdgcn_s_barrier(); asm volatile("" ::: "memory");
    { const float l1 = st1.l + __shfl_xor(st1.l, 32), l2 = st2.l + __shfl_xor(st2.l, 32);
      if (hi == 0) { wsf[64 + r32] = l1; if (MODE == 0) wsf[96 + r32] = l2; }
      LDS_WAIT();
#pragma unroll
      for (int r = 0; r < 16; ++r) { const int q = crow(r, hi); const float rl1 = fast_rcp(wsf[64 + q]);
          if (MODE == 1) { stg[q * 64 + r32] = o1[0][r] * rl1; stg[q * 64 + 32 + r32] = o1[1][r] * rl1; }
          else { const float rl2 = T.lam * fast_rcp(wsf[96 + q]);
              stg[q * 64 + r32] = o1[0][r] * rl1 - o2[0][r] * rl2; stg[q * 64 + 32 + r32] = o1[1][r] * rl1 - o2[1][r] * rl2; } }
      LDS_WAIT();
      const int ch = lane & 7;
      f32x4 g0 = (f32x4){1.f, 1.f, 1.f, 1.f}, g1 = g0;
      if (MODE == 0) { g0 = *(const f32x4*)(T.dn + ch * 8) * T.onem; g1 = *(const f32x4*)(T.dn + ch * 8 + 4) * T.onem; }
#pragma unroll
      for (int i = 0; i < 4; ++i) { const int row = i * 8 + (lane >> 3);
          f32x4 a = *(const LAS f32x4*)(stg + row * 64 + ch * 8), c = *(const LAS f32x4*)(stg + row * 64 + ch * 8 + 4);
          if (MODE == 0) { float ss = (a[0] * a[0] + a[1] * a[1]) + (a[2] * a[2] + a[3] * a[3]) + (c[0] * c[0] + c[1] * c[1]) + (c[2] * c[2] + c[3] * c[3]);
              ss += __shfl_xor(ss, 1); ss += __shfl_xor(ss, 2); ss += __shfl_xor(ss, 4);
              const float rstd = rsqrtf(ss * (1.0f / 64.0f) + RMS_EPS); a = a * rstd * g0; c = c * rstd * g1; }
          st16(T.O + (size_t)(qrow0 + row) * 1024 + T.ocol + ch * 8, a, c); } }
    LDS_WAIT(); __builtin_amdgcn_s_barrier(); asm volatile("" ::: "memory");
}
}

namespace atts {
constexpr float THR = 6.0f;
#define SB0() __builtin_amdgcn_sched_barrier(0)
struct Sm { float mhat, l; };
__device__ __forceinline__ void exp_pack(f32x16& p0, f32x16& p1, Sm& st, bf16x8 (&pa)[4]) {
    float s = 0.f;
#pragma unroll
    for (int r = 0; r < 16; ++r) { p0[r] = fast_exp2(p0[r]); p1[r] = fast_exp2(p1[r]); s = (s + p0[r]) + p1[r]; }
    st.l += s;
    pa[0] = pack8(p0, 0); pa[1] = pack8(p0, 8); pa[2] = pack8(p1, 0); pa[3] = pack8(p1, 8);
}
__device__ __forceinline__ void exp_head(f32x16& p0, float& s) {
#pragma unroll
    for (int r = 0; r < 8; ++r) { p0[r] = fast_exp2(p0[r]); s += p0[r]; }
}
__device__ __forceinline__ void exp_tail(f32x16& p0, f32x16& p1, float& s, Sm& st, bf16x8 (&pa)[4]) {
#pragma unroll
    for (int r = 8; r < 16; ++r) { p0[r] = fast_exp2(p0[r]); s += p0[r]; }
#pragma unroll
    for (int r = 0; r < 16; ++r) { p1[r] = fast_exp2(p1[r]); s += p1[r]; }
    st.l += s;
    pa[0] = pack8(p0, 0); pa[1] = pack8(p0, 8); pa[2] = pack8(p1, 0); pa[3] = pack8(p1, 8);
}
__device__ __forceinline__ void rescale(f32x16& p0, f32x16& p1, Sm& st, f32x16 (&o)[2], const float rm, LAS float* wsf, const int r32, const int hi, f32x16& negm) {
    if (__any(rm > THR)) {
        const float dl = fmaxf(rm, 0.f);
        st.mhat += dl;
#pragma unroll
        for (int r = 0; r < 16; ++r) negm[r] = -st.mhat;
#pragma unroll
        for (int r = 0; r < 16; ++r) { p0[r] -= dl; p1[r] -= dl; }
        const float f = fast_exp2(-dl); st.l *= f;
        if (hi == 0) wsf[r32] = f;
        LDS_WAIT();
#pragma unroll
        for (int r = 0; r < 16; ++r) { const float fr_ = wsf[crow(r, hi)]; o[0][r] *= fr_; o[1][r] *= fr_; }
    }
}
__device__ __forceinline__ void glds16(const bf16_t* src, LAS unsigned char* dst) { __builtin_amdgcn_global_load_lds((const unsigned*)src, (LAS unsigned*)dst, 16, 0, 0); }
#ifndef KRD16
#define KRD16(dst, addr, off) asm volatile("ds_read_b128 %0, %1 offset:%c2" : "=&v"(dst) : "v"(addr), "i"(off) : "memory")
#endif
struct Src {
    const bf16_t* Q; int qpitch, qcol;
    const bf16_t* K; int kcol;
    const bf16_t* KR;
    const bf16_t* V; int vcol;
};
template <int KIND>
__device__ __forceinline__ void attn_pass(LAS unsigned char* lds, const Src& T, const int b, const bool ctxq, const int qb, f32x16 (&o1)[2], Sm& st1) {
    constexpr int NCH = KIND ? 12 : 4, NKW = KIND ? 8 : 4, ND = KIND ? 6 : 2, KSLOT = NCH * 1024, SLOT = KSLOT + 8192, NSLOT = 4;
    constexpr int WS_OFF = 90112;
    static_assert(NSLOT * SLOT <= WS_OFF && WS_OFF + 8 * 512 <= RING_BYTES, "attention LDS");
    const int tid = otid(), lane = tid & 63, r32 = lane & 31, hi = lane >> 5, wid = __builtin_amdgcn_readfirstlane(tid >> 6);
    const int NT = ctxq ? 4 : 68;
    const int krow_ctx = NLAT + b * CTXL, krow_lat = b * SEQ;
    const int qrow0 = (ctxq ? krow_ctx : krow_lat + qb * 256) + wid * 32;
    LAS float* wsf = (LAS float*)(lds + WS_OFF + wid * 512);
#define ATT_ISSUE(t_) do { const int kr_ = ((t_) < 4) ? krow_ctx + 64 * (t_) : krow_lat + 64 * ((t_) - 4); const int so_ = ((t_) & 3) * SLOT; \
        if (wid < NKW) glds16(T.K + (size_t)(kr_ + lane) * 384 + T.kcol + wid * 8, lds + so_ + wid * 1024); \
        if (KIND == 1 && wid < 4) glds16(T.KR + (size_t)(kr_ + lane) * 32 + wid * 8, lds + so_ + (8 + wid) * 1024); \
        glds16(T.V + (size_t)(kr_ + 16 * (wid & 3) + (lane >> 2)) * 384 + T.vcol + (wid >> 2) * 32 + (lane & 3) * 8, lds + so_ + KSLOT + wid * 1024); } while (0)
#define ATT_WAITN(n) do { const int np_ = (KIND == 1) ? (wid < 4 ? 3 : 2) : (wid < 4 ? 2 : 1); \
        if ((n) == 0) asm volatile("s_waitcnt vmcnt(0)" ::: "memory"); \
        else if (np_ * (n) == 1) asm volatile("s_waitcnt vmcnt(1)" ::: "memory"); else if (np_ * (n) == 2) asm volatile("s_waitcnt vmcnt(2)" ::: "memory"); \
        else if (np_ * (n) == 3) asm volatile("s_waitcnt vmcnt(3)" ::: "memory"); else if (np_ * (n) == 4) asm volatile("s_waitcnt vmcnt(4)" ::: "memory"); \
        else asm volatile("s_waitcnt vmcnt(6)" ::: "memory"); } while (0)
#define ATT_BAR() do { LDS_WAIT(); __builtin_amdgcn_s_barrier(); asm volatile("" ::: "memory"); } while (0)
    bf16x8 qr[ND];
    { const bf16_t* qp = T.Q + (size_t)(qrow0 + r32) * T.qpitch + T.qcol + hi * 8;
#pragma unroll
      for (int d0 = 0; d0 < ND; ++d0) qr[d0] = *(const bf16x8*)(qp + d0 * 16); }
    ATT_ISSUE(0); ATT_ISSUE(1); ATT_ISSUE(2);
    st1.mhat = 0.f; st1.l = 0.f;
#pragma unroll
    for (int r = 0; r < 16; ++r) { o1[0][r] = 0.f; o1[1][r] = 0.f; }
    const unsigned klane = (unsigned)(size_t)lds + hi * 1024 + r32 * 16;
    const unsigned vlane = (unsigned)(size_t)lds + KSLOT + ((lane >> 4) & 1) * 32 + (lane & 3) * 8 + (4 * hi + ((lane & 15) >> 2)) * 64;
    f32x16 a0, a1, n0, n1, negm1;
#define ATT_KRD(t_, kf) do { const unsigned kb_ = klane + ((t_) & 3) * SLOT; \
        _Pragma("unroll") for (int d = 0; d < ND; ++d) { KRD16(kf[2 * d], kb_, d * 2048); KRD16(kf[2 * d + 1], kb_, d * 2048 + 512); } } while (0)
#define ATT_MM(kf, P0, P1) do { asm volatile("s_waitcnt lgkmcnt(0)" ::: "memory"); SB0(); \
        P0 = mfma32(kf[0], qr[0], negm1); P1 = mfma32(kf[1], qr[0], negm1); \
        _Pragma("unroll") for (int d = 1; d < ND; ++d) { P0 = mfma32(kf[2 * d], qr[d], P0); P1 = mfma32(kf[2 * d + 1], qr[d], P1); } } while (0)
#define ATT_QK(t_, P0, P1) do { bf16x8 kf_[2 * ND]; ATT_KRD(t_, kf_); ATT_MM(kf_, P0, P1); } while (0)
#pragma unroll
    for (int r = 0; r < 16; ++r) negm1[r] = 0.f;
    ATT_WAITN(2); ATT_BAR();
    ATT_QK(0, a0, a1);
    { const float rm = rowmax32_fast(a0, a1); st1.mhat = rm;
#pragma unroll
      for (int r = 0; r < 16; ++r) { a0[r] -= rm; a1[r] -= rm; negm1[r] = -rm; } }
#define ATT_STEP(t_, A0, A1, N0, N1) do { const int tt = (t_); \
        if (tt + 2 < NT) ATT_WAITN(1); else ATT_WAITN(0); \
        ATT_BAR();                                                  \
        if (tt + 3 < NT) ATT_ISSUE(tt + 3); \
        const unsigned vb_ = vlane + (tt & 3) * SLOT; \
        bf16x8 pa1[4]; bf16x8 kf_[2 * ND]; float es_ = 0.f; \
        ATT_KRD(tt + 1, kf_); SB0(); \
        exp_head(A0, es_); SB0();                                    \
        ATT_MM(kf_, N0, N1); \
        exp_tail(A0, A1, es_, st1, pa1); \
        _Pragma("unroll") for (int sg = 0; sg < 2 * ND; ++sg) { __builtin_amdgcn_sched_group_barrier(0x8, 1, 0); __builtin_amdgcn_sched_group_barrier(0x2, KIND ? 6 : 16, 0); } \
        SB0(); \
        PV_BLOCK(vb_, 0, o1[0] = mfma32(pa1[ks], vf, o1[0])); PV_BLOCK(vb_, 1, o1[1] = mfma32(pa1[ks], vf, o1[1])); \
        const float rm1 = rowmax32_fast(N0, N1);                    \
        _Pragma("unroll") for (int sg = 0; sg < 4; ++sg) { __builtin_amdgcn_sched_group_barrier(0x8, 1, 0); __builtin_amdgcn_sched_group_barrier(0x2, 5, 0); } \
        SB0(); \
        rescale(N0, N1, st1, o1, rm1, wsf, r32, hi, negm1); } while (0)
    for (int t = 0; t < NT - 2; t += 2) {
        ATT_STEP(t, a0, a1, n0, n1);
        ATT_STEP(t + 1, n0, n1, a0, a1);
    }
    ATT_STEP(NT - 2, a0, a1, n0, n1);
    { bf16x8 pa1[4]; const unsigned vb_ = vlane + ((NT - 1) & 3) * SLOT;
      exp_pack(n0, n1, st1, pa1);
      PV_BLOCK(vb_, 0, o1[0] = mfma32(pa1[ks], vf, o1[0])); PV_BLOCK(vb_, 1, o1[1] = mfma32(pa1[ks], vf, o1[1])); }
    ATT_BAR();
#undef ATT_STEP
#undef ATT_QK
#undef ATT_ISSUE
#undef ATT_WAITN
}
template <bool DIFF>
__device__ __forceinline__ void attn_store(LAS unsigned char* lds, const f32x16 (&o1)[2], const Sm& st1, const f32x16 (&o2)[2], const Sm& st2, const float lam, const float onem, const float* dn,
        bf16_t* O, const int ocol, const int b, const bool ctxq, const int qb) {
    const int tid = otid(), lane = tid & 63, r32 = lane & 31, hi = lane >> 5, wid = __builtin_amdgcn_readfirstlane(tid >> 6);
    const int qrow0 = (ctxq ? NLAT + b * CTXL : b * SEQ + qb * 256) + wid * 32;
    LAS float* wsf = (LAS float*)(lds + 90112 + wid * 512);
    LAS float* stg = (LAS float*)(lds + wid * 8192);
    const float l1 = st1.l + __shfl_xor(st1.l, 32), l2 = DIFF ? st2.l + __shfl_xor(st2.l, 32) : 1.f;
    if (hi == 0) { wsf[64 + r32] = l1; if (DIFF) wsf[96 + r32] = l2; }
    LDS_WAIT();
#pragma unroll
    for (int r = 0; r < 16; ++r) { const int q = crow(r, hi); const float rl1 = fast_rcp(wsf[64 + q]);
        if (!DIFF) { stg[q * 64 + r32] = o1[0][r] * rl1; stg[q * 64 + 32 + r32] = o1[1][r] * rl1; }
        else { const float rl2 = lam * fast_rcp(wsf[96 + q]);
            stg[q * 64 + r32] = o1[0][r] * rl1 - o2[0][r] * rl2; stg[q * 64 + 32 + r32] = o1[1][r] * rl1 - o2[1][r] * rl2; } }
    LDS_WAIT();
    const int ch = lane & 7;
    f32x4 g0 = (f32x4){1.f, 1.f, 1.f, 1.f}, g1 = g0;
    if (DIFF) { g0 = *(const f32x4*)(dn + ch * 8) * onem; g1 = *(const f32x4*)(dn + ch * 8 + 4) * onem; }
#pragma unroll
    for (int i = 0; i < 4; ++i) { const int row = i * 8 + (lane >> 3);
        f32x4 a = *(const LAS f32x4*)(stg + row * 64 + ch * 8), c = *(const LAS f32x4*)(stg + row * 64 + ch * 8 + 4);
        if (DIFF) { float ss = (a[0] * a[0] + a[1] * a[1]) + (a[2] * a[2] + a[3] * a[3]) + (c[0] * c[0] + c[1] * c[1]) + (c[2] * c[2] + c[3] * c[3]);
            ss += __shfl_xor(ss, 1); ss += __shfl_xor(ss, 2); ss += __shfl_xor(ss, 4);
            const float rstd = rsqrtf(ss * (1.0f / 64.0f) + RMS_EPS); a = a * rstd * g0; c = c * rstd * g1; }
        st16(O + (size_t)(qrow0 + row) * 1024 + ocol + ch * 8, a, c); }
    LDS_WAIT(); __builtin_amdgcn_s_barrier(); asm volatile("" ::: "memory");
}
#undef ATT_BAR
#undef SB0
}

namespace attp {
typedef short v4i16_t __attribute__((ext_vector_type(4)));
constexpr float THR = 6.0f;
#define SB0() __builtin_amdgcn_sched_barrier(0)
__device__ __forceinline__ float rowmax32(f32x16& p0, f32x16& p1) { return rowmax32_fast(p0, p1); }
struct Sm { float mhat, l; };
__device__ __forceinline__ void exp_pack(f32x16& p0, f32x16& p1, Sm& st, bf16x8 (&pa)[4]) {
    float s = 0.f;
#pragma unroll
    for (int r = 0; r < 16; ++r) { p0[r] = fast_exp2(p0[r]); p1[r] = fast_exp2(p1[r]); s = (s + p0[r]) + p1[r]; }
    st.l += s;
    pa[0] = pack8(p0, 0); pa[1] = pack8(p0, 8); pa[2] = pack8(p1, 0); pa[3] = pack8(p1, 8);
}
__device__ __forceinline__ void rescale(f32x16& p0, f32x16& p1, Sm& st, f32x16 (&o)[2], const float rm, LAS float* wsf, const int r32, const int hi, f32x16& negm) {
    if (__any(rm > THR)) {
        const float dl = fmaxf(rm, 0.f);
        st.mhat += dl;
#pragma unroll
        for (int r = 0; r < 16; ++r) negm[r] = -st.mhat;
#pragma unroll
        for (int r = 0; r < 16; ++r) { p0[r] -= dl; p1[r] -= dl; }
        const float f = fast_exp2(-dl); st.l *= f;
        if (hi == 0) wsf[r32] = f;
        LDS_WAIT();
#pragma unroll
        for (int r = 0; r < 16; ++r) { const float fr_ = wsf[crow(r, hi)]; o[0][r] *= fr_; o[1][r] *= fr_; }
    }
}
__device__ __forceinline__ void glds16(const bf16_t* src, LAS unsigned char* dst) { __builtin_amdgcn_global_load_lds((const unsigned*)src, (LAS unsigned*)dst, 16, 0, 0); }

#define KRD16(dst, addr, off) asm volatile("ds_read_b128 %0, %1 offset:%c2" : "=&v"(dst) : "v"(addr), "i"(off) : "memory")
struct Tens {
    const bf16_t* Q; int qpitch, qcol;
    const bf16_t* K; const bf16_t* KR; const bf16_t* V; int kvcol;
    bf16_t* O; int ocol;
    float lam, onem; const float* dn;
};
template <int D0, int ND>
__device__ __forceinline__ void qk_tile(f32x16& p0, f32x16& p1, const LAS unsigned char* kp, const bf16x8* qr, const float mhat) {
    f32x16 c;
#pragma unroll
    for (int r = 0; r < 16; ++r) c[r] = -mhat;
#pragma unroll
    for (int d = 0; d < ND; ++d) { const bf16x8 k0 = *(const LAS bf16x8*)(kp + (D0 + d) * 2048), k1 = *(const LAS bf16x8*)(kp + (D0 + d) * 2048 + 512);
        if (d == 0) { p0 = mfma32(k0, qr[D0], c); p1 = mfma32(k1, qr[D0], c); } else { p0 = mfma32(k0, qr[D0 + d], p0); p1 = mfma32(k1, qr[D0 + d], p1); } }
}
template <int D0, int ND>
__device__ __forceinline__ void qk_tile_l(f32x16& p0, f32x16& p1, const LAS unsigned char* kp, const LAS unsigned char* ql, const float mhat) {
#pragma unroll
    for (int r = 0; r < 16; ++r) { p0[r] = -mhat; p1[r] = -mhat; }
#pragma unroll
    for (int d = 0; d < ND; ++d) { const bf16x8 k0 = *(const LAS bf16x8*)(kp + (D0 + d) * 2048), k1 = *(const LAS bf16x8*)(kp + (D0 + d) * 2048 + 512);
        const bf16x8 q = *(const LAS bf16x8*)(ql + (D0 + d) * 1024);
        p0 = mfma32(k0, q, p0); p1 = mfma32(k1, q, p1); }
}
template <int MODE>
__device__ __forceinline__ void attn_unit(LAS unsigned char* lds, const Tens& T, const int b, const bool ctxq, const int qb) {
    constexpr int NCH = MODE ? 12 : 8, KSLOT = NCH * 1024, SLOT = KSLOT + 8192, NSLOT = 4;
    constexpr int WS_OFF = NSLOT * SLOT, OST_OFF = 0, QS_OFF = WS_OFF + 8 * 512;
    static_assert(QS_OFF + 8 * 4096 <= RING_BYTES && 8 * 8192 <= WS_OFF, "attention LDS");
    const int tid = otid(), lane = tid & 63, r32 = lane & 31, hi = lane >> 5, wid = __builtin_amdgcn_readfirstlane(tid >> 6);
    const int NT = ctxq ? 4 : 68;
    const int krow_ctx = NLAT + b * CTXL, krow_lat = b * SEQ;
    const int qrow0 = (ctxq ? krow_ctx : krow_lat + qb * 256) + wid * 32;
    LAS float* wsf = (LAS float*)(lds + WS_OFF + wid * 512);
    LAS float* stg = (LAS float*)(lds + OST_OFF + wid * 8192);
#define ATT_ISSUE(t_) do { const int kr_ = ((t_) < 4) ? krow_ctx + 64 * (t_) : krow_lat + 64 * ((t_) - 4); const int so_ = ((t_) & 3) * SLOT; \
        glds16(T.K + (size_t)(kr_ + lane) * 384 + T.kvcol + wid * 8, lds + so_ + wid * 1024); \
        if (MODE == 1 && wid < 4) glds16(T.KR + (size_t)(kr_ + lane) * 32 + wid * 8, lds + so_ + (8 + wid) * 1024); \
        glds16(T.V + (size_t)(kr_ + 16 * (wid & 3) + (lane >> 2)) * 384 + T.kvcol + (wid >> 2) * 32 + (lane & 3) * 8, lds + so_ + KSLOT + wid * 1024); } while (0)
#define ATT_WAIT(n2, n3) do { if (MODE == 1 && wid < 4) asm volatile("s_waitcnt vmcnt(" #n3 ")" ::: "memory"); else asm volatile("s_waitcnt vmcnt(" #n2 ")" ::: "memory"); } while (0)
#define ATT_BAR() do { LDS_WAIT(); __builtin_amdgcn_s_barrier(); asm volatile("" ::: "memory"); } while (0)
    constexpr int NQ = MODE ? 6 : 4;
    bf16x8 qr[NQ];
    const LAS unsigned char* ql = lds + QS_OFF + wid * 4096 + lane * 16;
    { const bf16_t* qp = T.Q + (size_t)(qrow0 + r32) * T.qpitch + T.qcol + hi * 8;
#pragma unroll
      for (int d0 = 0; d0 < NQ; ++d0) { const bf16x8 q = *(const bf16x8*)(qp + d0 * 16); if (MODE == 1) qr[d0] = q; else *(LAS bf16x8*)(lds + QS_OFF + wid * 4096 + d0 * 1024 + lane * 16) = q; } }
    ATT_ISSUE(0); ATT_ISSUE(1); ATT_ISSUE(2);
    Sm st1{0.f, 0.f}, st2{0.f, 0.f};
    f32x16 o1[2], o2[2];
#pragma unroll
    for (int r = 0; r < 16; ++r) { o1[0][r] = 0.f; o1[1][r] = 0.f; o2[0][r] = 0.f; o2[1][r] = 0.f; }
    const int klane = hi * 1024 + r32 * 16;
    const int vlane = KSLOT + ((lane >> 4) & 1) * 32 + (lane & 3) * 8 + (4 * hi + ((lane & 15) >> 2)) * 64;
    f32x16 a0, a1, c0, c1;
    ATT_WAIT(4, 6); ATT_BAR();
    { const LAS unsigned char* kp = lds + klane;
      if (MODE == 1) { qk_tile<0, 6>(a0, a1, kp, qr, 0.f); }
      else { qk_tile_l<0, 2>(a0, a1, kp, ql, 0.f); qk_tile_l<2, 2>(c0, c1, kp, ql, 0.f); }
      { const float rm = rowmax32(a0, a1); st1.mhat = rm;
#pragma unroll
        for (int r = 0; r < 16; ++r) { a0[r] -= rm; a1[r] -= rm; } }
      if (MODE == 0) { const float rm = rowmax32(c0, c1); st2.mhat = rm;
#pragma unroll
        for (int r = 0; r < 16; ++r) { c0[r] -= rm; c1[r] -= rm; } } }
    f32x16 n0, n1, m0, m1;
    f32x16 negm1, negm2;
#pragma unroll
    for (int r = 0; r < 16; ++r) { negm1[r] = -st1.mhat; negm2[r] = -st2.mhat; }
#define ATT_PV1(vb_) do { PV_BLOCK(vb_, 0, o1[0] = mfma32(pa1[ks], vf, o1[0])); PV_BLOCK(vb_, 1, o1[1] = mfma32(pa1[ks], vf, o1[1])); } while (0)
#define ATT_PV2(vb_) do { PV_BLOCK(vb_, 0, o1[0] = mfma32(pa1[ks], vf, o1[0]); o2[0] = mfma32(pa2[ks], vf, o2[0])); PV_BLOCK(vb_, 1, o1[1] = mfma32(pa1[ks], vf, o1[1]); o2[1] = mfma32(pa2[ks], vf, o2[1])); } while (0)
#define ATT_STEP(t_, A0, A1, C0, C1, N0, N1, M0, M1) do { const int tt = (t_); \
        if (tt + 2 < NT) ATT_WAIT(2, 3); else asm volatile("s_waitcnt vmcnt(0)" ::: "memory"); \
        ATT_BAR();                                                  \
        if (tt + 3 < NT) ATT_ISSUE(tt + 3); \
        const LAS unsigned char* kpn = lds + ((tt + 1) & 3) * SLOT + klane; \
        const unsigned vp = (unsigned)(size_t)(lds + (tt & 3) * SLOT + vlane); \
        bf16x8 pa1[4], pa2[4]; \
        if (MODE == 1) { \
            { const unsigned kb_ = (unsigned)(size_t)kpn; bf16x8 kf[12]; \
              _Pragma("unroll") for (int d = 0; d < 6; ++d) { KRD16(kf[2 * d], kb_, d * 2048); KRD16(kf[2 * d + 1], kb_, d * 2048 + 512); } \
              asm volatile("s_waitcnt lgkmcnt(0)" ::: "memory"); SB0(); \
              N0 = mfma32(kf[0], qr[0], negm1); N1 = mfma32(kf[1], qr[0], negm1); \
              _Pragma("unroll") for (int d = 1; d < 6; ++d) { N0 = mfma32(kf[2 * d], qr[d], N0); N1 = mfma32(kf[2 * d + 1], qr[d], N1); } } \
            exp_pack(A0, A1, st1, pa1); \
            _Pragma("unroll") for (int sg = 0; sg < 12; ++sg) { __builtin_amdgcn_sched_group_barrier(0x8, 1, 0); __builtin_amdgcn_sched_group_barrier(0x2, 7, 0); } \
            SB0(); \
            const float rm1 = rowmax32(N0, N1); \
            ATT_PV1(vp); \
            SB0(); \
            rescale(N0, N1, st1, o1, rm1, wsf, r32, hi, negm1); \
        } else { \
            qk_tile_l<0, 2>(N0, N1, kpn, ql, st1.mhat); \
            exp_pack(A0, A1, st1, pa1); \
            SB0(); \
            qk_tile_l<2, 2>(M0, M1, kpn, ql, st2.mhat); \
            exp_pack(C0, C1, st2, pa2); \
            SB0(); \
            const float rm1 = rowmax32(N0, N1), rm2 = rowmax32(M0, M1); \
            ATT_PV2(vp); \
            SB0(); \
            rescale(N0, N1, st1, o1, rm1, wsf, r32, hi, negm1); rescale(M0, M1, st2, o2, rm2, wsf + 32, r32, hi, negm2); \
        } } while (0)
    for (int t = 0; t < NT - 2; t += 2) {
        ATT_STEP(t, a0, a1, c0, c1, n0, n1, m0, m1);
        ATT_STEP(t + 1, n0, n1, m0, m1, a0, a1, c0, c1);
    }
    ATT_STEP(NT - 2, a0, a1, c0, c1, n0, n1, m0, m1);
    { bf16x8 pa1[4], pa2[4]; const unsigned vp = (unsigned)(size_t)(lds + ((NT - 1) & 3) * SLOT + vlane);
      exp_pack(n0, n1, st1, pa1);
      if (MODE == 1) { ATT_PV1(vp); } else { exp_pack(m0, m1, st2, pa2); ATT_PV2(vp); } }
#undef ATT_PV1
#undef ATT_PV2
#undef ATT_STEP
#undef ATT_ISSUE
#undef ATT_WAIT
    ATT_BAR();
    { const float l1 = st1.l + __shfl_xor(st1.l, 32), l2 = st2.l + __shfl_xor(st2.l, 32);
      if (hi == 0) { wsf[64 + r32] = l1; if (MODE == 0) wsf[96 + r32] = l2; }
      LDS_WAIT();
#pragma unroll
      for (int r = 0; r < 16; ++r) { const int q = crow(r, hi); const float rl1 = fast_rcp(wsf[64 + q]);
          if (MODE == 1) { stg[q * 64 + r32] = o1[0][r] * rl1; stg[q * 64 + 32 + r32] = o1[1][r] * rl1; }
          else { const float rl2 = T.lam * fast_rcp(wsf[96 + q]);
              stg[q * 64 + r32] = o1[0][r] * rl1 - o2[0][r] * rl2; stg[q * 64 + 32 + r32] = o1[1][r] * rl1 - o2[1][r] * rl2; } }
      LDS_WAIT();
      const int ch = lane & 7;
      f32x4 g0 = (f32x4){1.f, 1.f, 1.f, 1.f}, g1 = g0;
      if (MODE == 0) { g0 = *(const f32x4*)(T.dn + ch * 8) * T.onem; g1 = *(const f32x4*)(T.dn + ch * 8 + 4) * T.onem; }
#pragma unroll
      for (int i = 0; i < 4; ++i) { const int row = i * 8 + (lane >> 3);
          f32x4 a = *(const LAS f32x4*)(stg + row * 64 + ch * 8), c = *(const LAS f32x4*)(stg + row * 64 + ch * 8 + 4);
          if (MODE == 0) { float ss = (a[0] * a[0] + a[1] * a[1]) + (a[2] * a[2] + a[3] * a[3]) + (c[0] * c[0] + c[1] * c[1]) + (c[2] * c[2] + c[3] * c[3]);
              ss += __shfl_xor(ss, 1); ss += __shfl_xor(ss, 2); ss += __shfl_xor(ss, 4);
              const float rstd = rsqrtf(ss * (1.0f / 64.0f) + RMS_EPS); a = a * rstd * g0; c = c * rstd * g1; }
          st16(T.O + (size_t)(qrow0 + row) * 1024 + T.ocol + ch * 8, a, c); } }
    ATT_BAR();
#undef ATT_BAR
#undef SB0
}
}

namespace lru {
constexpr int YP = 264;
constexpr int YBUF = 32 * YP * 2;
struct WaveCtx { bf16x8 wf[2][2][4]; float ba[2], bi[2], c8[2]; float cw[4], cb; };

__device__ __forceinline__ void load_ctx(WaveCtx& W, const int l, const bf16_t* WG, const float* conv_w, const float* conv_b, const float* lba, const float* lbi, const float* llam) {
    const int tid = otid(), lane = tid & 63, r32 = lane & 31, hi = lane >> 5, wid = __builtin_amdgcn_readfirstlane(tid >> 6);
    const int hb = wid & 3, half = wid >> 2, c2 = 64 * hb + 32 * half + r32;
#pragma unroll
    for (int d = 0; d < 2; ++d)
#pragma unroll
        for (int gt = 0; gt < 2; ++gt)
#pragma unroll
            for (int ks = 0; ks < 4; ++ks)
                W.wf[d][gt][ks] = *(const bf16x8*)(WG + ((size_t)(l * 1024 + hb * 256 + d * 128 + gt * 64 + 32 * half + r32)) * 64 + 16 * ks + 8 * hi);
#pragma unroll
    for (int d = 0; d < 2; ++d) { W.ba[d] = lba[(l * 2 + d) * 256 + c2]; W.bi[d] = lbi[(l * 2 + d) * 256 + c2];
        const float lam = llam[(l * 2 + d) * 256 + c2]; W.c8[d] = -8.0f * LOG2E * log1pf(expf(-lam)); }
    const int c = tid & 255;
#pragma unroll
    for (int k = 0; k < 4; ++k) W.cw[k] = conv_w[(l * 4 + k) * 256 + c];
    W.cb = conv_b[l * 256 + c];
}

struct ChunkPos { int seqbase, seqlen, tl0; };
__device__ __forceinline__ ChunkPos chunk_pos(const int cid) { ChunkPos p;
    if (cid < NCHUNK_LAT) { p.seqbase = (cid >> 7) * SEQ; p.seqlen = SEQ; p.tl0 = (cid & 127) * 32; }
    else { const int cc = cid - NCHUNK_LAT; p.seqbase = NLAT + (cc >> 3) * CTXL; p.seqlen = CTXL; p.tl0 = (cc & 7) * 32; }
    return p; }
__device__ __forceinline__ void conv_load(unsigned (&xr)[19], const int cid, const bf16_t* XL, const int tid) {
    const ChunkPos p = chunk_pos(cid); const int c = tid & 255, th = tid >> 8;
#pragma unroll
    for (int k = 0; k < 19; ++k) { int tl = p.tl0 + th * 16 - 2 + k; tl = tl < 0 ? 0 : (tl >= p.seqlen ? p.seqlen - 1 : tl); xr[k] = XL[(size_t)(p.seqbase + tl) * 256 + c]; }
}
__device__ __forceinline__ void conv_store(const unsigned (&xr)[19], const int cid, const WaveCtx& W, LAS bf16_t* Y, const int tid) {
    const ChunkPos p = chunk_pos(cid); const int c = tid & 255, th = tid >> 8; float xv[19];
#pragma unroll
    for (int k = 0; k < 19; ++k) { const int tl = p.tl0 + th * 16 - 2 + k; xv[k] = (tl >= 0 && tl < p.seqlen) ? bf2f(xr[k]) : 0.f; }
#pragma unroll
    for (int i = 0; i < 16; ++i) { const float y = W.cb + W.cw[0] * xv[i] + W.cw[1] * xv[i + 1] + W.cw[2] * xv[i + 2] + W.cw[3] * xv[i + 3]; Y[(th * 16 + i) * YP + c] = (bf16_t)f2bf(y); }
}
template <bool FINAL>
__device__ __forceinline__ void chunk(LAS unsigned char* ybuf, LAS unsigned char* ynbuf, const WaveCtx& W, const int cid, const int ncid, const bf16_t* XL, const bf16_t* GG, float* LSUM, const float* LCAR, bf16_t* MIX) {
    const int tid = otid(), lane = tid & 63, r32 = lane & 31, hi = lane >> 5, wid = __builtin_amdgcn_readfirstlane(tid >> 6);
    const int hb = wid & 3, half = wid >> 2, c2 = 64 * hb + 32 * half + r32;
    const ChunkPos p = chunk_pos(cid); const int seqbase = p.seqbase, tl0 = p.tl0;
    LAS bf16_t* Y = (LAS bf16_t*)ybuf;
    float hc[2] = {0.f, 0.f}; unsigned gr[16];
    if (FINAL) { hc[0] = LCAR[((size_t)cid * 2 + 0) * 256 + c2]; hc[1] = LCAR[((size_t)cid * 2 + 1) * 256 + c2];
#pragma unroll
        for (int r = 0; r < 16; ++r) gr[r] = GG[(size_t)(seqbase + tl0 + crow(r, hi)) * 256 + c2]; }
    unsigned xr[19];
    conv_load(xr, ncid >= 0 ? ncid : cid, XL, tid);
    float yv[16], hsum[16];
#pragma unroll
    for (int r = 0; r < 16; ++r) { yv[r] = bf2f(Y[crow(r, hi) * YP + c2]); hsum[r] = 0.f; }
#pragma unroll
    for (int d = 0; d < 2; ++d) {
        f32x16 acc[2];
#pragma unroll
        for (int r = 0; r < 16; ++r) { acc[0][r] = 0.f; acc[1][r] = 0.f; }
#pragma unroll
        for (int ks = 0; ks < 4; ++ks) { const bf16x8 a = *(const LAS bf16x8*)(Y + r32 * YP + 64 * hb + 16 * ks + 8 * hi);
            acc[0] = mfma32(a, W.wf[d][0][ks], acc[0]); acc[1] = mfma32(a, W.wf[d][1][ks], acc[1]); }
        float ca[16], hl[16];
#pragma unroll
        for (int r = 0; r < 16; ++r) { const float rg = sigmoidf_(acc[0][r] + W.ba[d]), ig = sigmoidf_(acc[1][r] + W.bi[d]);
            const float a = fast_exp2(W.c8[d] * rg); ca[r] = a; hl[r] = __builtin_amdgcn_sqrtf(fmaxf(1.0f - a * a, 0.f)) * (ig * yv[r]); }
        float sA[4], sH[4];
        if (d == 0) {
#pragma unroll
            for (int q = 0; q < 4; ++q) {
#pragma unroll
                for (int j = 1; j < 4; ++j) { hl[4 * q + j] = ca[4 * q + j] * hl[4 * q + j - 1] + hl[4 * q + j]; ca[4 * q + j] = ca[4 * q + j] * ca[4 * q + j - 1]; }
                sA[q] = ca[4 * q + 3]; sH[q] = hl[4 * q + 3]; }
        } else {
#pragma unroll
            for (int q = 0; q < 4; ++q) {
#pragma unroll
                for (int j = 2; j >= 0; --j) { hl[4 * q + j] = ca[4 * q + j] * hl[4 * q + j + 1] + hl[4 * q + j]; ca[4 * q + j] = ca[4 * q + j] * ca[4 * q + j + 1]; }
                sA[q] = ca[4 * q]; sH[q] = hl[4 * q]; }
        }
        float h = FINAL ? hc[d] : 0.f;
        float hbef[4];
        if (d == 0) {
#pragma unroll
            for (int q = 0; q < 4; ++q) { const float hb0 = h; const float t0 = sA[q] * h + sH[q]; const float hm = __shfl(t0, r32); const float t1 = sA[q] * hm + sH[q]; h = __shfl(t1, r32 + 32); hbef[q] = hi ? hm : hb0; }
        } else {
#pragma unroll
            for (int q = 3; q >= 0; --q) { const float hb1 = h; const float t1 = sA[q] * h + sH[q]; const float hm = __shfl(t1, r32 + 32); const float t0 = sA[q] * hm + sH[q]; h = __shfl(t0, r32); hbef[q] = hi ? hb1 : hm; }
        }
        if (!FINAL) {
            float at = (sA[0] * sA[1]) * (sA[2] * sA[3]); at *= __shfl_xor(at, 32);
            if (hi == 0) *(f32x2*)(LSUM + (((size_t)cid * 2 + d) * 256 + c2) * 2) = (f32x2){at, h};
        } else {
#pragma unroll
            for (int r = 0; r < 16; ++r) hsum[r] += ca[r] * hbef[r >> 2] + hl[r];
        }
    }
    if (FINAL) {
#pragma unroll
        for (int r = 0; r < 16; ++r) { const size_t row = (size_t)(seqbase + tl0 + crow(r, hi)); MIX[row * 1024 + c2] = (bf16_t)f2bf(hsum[r] * bf2f(gr[r])); }
    }
    if (ncid >= 0) conv_store(xr, ncid, W, (LAS bf16_t*)ynbuf, tid);
}
template <bool FINAL>
__device__ __forceinline__ void run_chunks(LAS unsigned char* lds, const WaveCtx& W, const int first, const int stride, const int nch, const bf16_t* XL, const bf16_t* GG, float* LSUM, const float* LCAR, bf16_t* MIX) {
    if (first < nch) { unsigned xr[19]; const int tid = otid(); conv_load(xr, first, XL, tid); conv_store(xr, first, W, (LAS bf16_t*)lds, tid); }
    int it = 0;
    for (int cid = first; cid < nch; cid += stride, ++it) {
        __syncthreads();
        const int ncid = (cid + stride < nch) ? cid + stride : -1;
        chunk<FINAL>(lds + (it & 1) * YBUF, lds + ((it + 1) & 1) * YBUF, W, cid, ncid, XL, GG, LSUM, LCAR, MIX);
    }
}

__device__ __forceinline__ void carry(const float* LSUM, float* LCAR) {
    if (blockIdx.x < NBATCH) {
        const int tid_ = otid(); const int b = blockIdx.x, d = tid_ >> 8, c = tid_ & 255;
        float h = 0.f;
#pragma unroll 8
        for (int n = 0; n < 136; ++n) {
            int cid;
            if (d == 0) cid = (n < 8) ? NCHUNK_LAT + b * 8 + n : b * 128 + (n - 8);
            else cid = (n < 8) ? NCHUNK_LAT + b * 8 + (7 - n) : b * 128 + (135 - n);
            const f32x2 ah = *(const f32x2*)(LSUM + (((size_t)cid * 2 + d) * 256 + c) * 2);
            LCAR[((size_t)cid * 2 + d) * 256 + c] = h;
            h = ah.x * h + ah.y;
        }
    }
}
}

namespace lnp {
struct Vec { f32x4 v[4]; };
__device__ __forceinline__ Vec ldv(const float* p, int lane) { Vec r;
#pragma unroll
    for (int j = 0; j < 4; ++j) r.v[j] = *(const f32x4*)(p + 4 * lane + 256 * j);
    return r; }
__device__ __forceinline__ Vec ldbf(const bf16_t* p, int lane) { Vec r;
#pragma unroll
    for (int j = 0; j < 4; ++j) { const u32x2 w = *(const u32x2*)(p + 4 * lane + 256 * j); r.v[j] = (f32x4){bflo(w.x), bfhi(w.x), bflo(w.y), bfhi(w.y)}; }
    return r; }
__device__ __forceinline__ void stf(float* p, int lane, const Vec& a) {
#pragma unroll
    for (int j = 0; j < 4; ++j) *(f32x4*)(p + 4 * lane + 256 * j) = a.v[j]; }
__device__ __forceinline__ void stbf(bf16_t* p, int lane, const Vec& a) {
#pragma unroll
    for (int j = 0; j < 4; ++j) st8(p + 4 * lane + 256 * j, a.v[j]); }
__device__ __forceinline__ void normalize(Vec& y) {
    float s = 0.f;
#pragma unroll
    for (int j = 0; j < 4; ++j) s += (y.v[j][0] + y.v[j][1]) + (y.v[j][2] + y.v[j][3]);
    const float mean = wave_sum(s) * (1.0f / DM); float q = 0.f;
#pragma unroll
    for (int j = 0; j < 4; ++j) { y.v[j] = y.v[j] - mean; q += (y.v[j][0] * y.v[j][0] + y.v[j][1] * y.v[j][1]) + (y.v[j][2] * y.v[j][2] + y.v[j][3] * y.v[j][3]); }
    const float rstd = rsqrtf(wave_sum(q) * (1.0f / DM) + LN_EPS);
#pragma unroll
    for (int j = 0; j < 4; ++j) y.v[j] = y.v[j] * rstd;
}

constexpr int LG_OFF = 65536, CNT_OFF = 86016, BASE_OFF = 86080;
__device__ __forceinline__ f32x4 cvt4u(const u32x2 w) { return (f32x4){bflo(w.x), bfhi(w.x), bflo(w.y), bfhi(w.y)}; }
__device__ __forceinline__ f32x4 cvt4b(const f32x4 r) { const unsigned a = __float_as_uint(r[0]), b = __float_as_uint(r[1]); return (f32x4){bflo(a), bfhi(a), bflo(b), bfhi(b)}; }
struct Raw2 { f32x4 x[4]; u32x2 o[4]; };
struct Ln1Par { Vec gate, gg, bb, m4, m3; int cur_bi; };
__device__ __forceinline__ float swap32_sum(const float x, const float y) { auto rr = __builtin_amdgcn_permlane32_swap(__float_as_uint(x), __float_as_uint(y), false, false); return __uint_as_float(rr[0]) + __uint_as_float(rr[1]); }
__device__ __forceinline__ float swap16_sum(const float x, const float y) { auto rr = __builtin_amdgcn_permlane16_swap(__float_as_uint(x), __float_as_uint(y), false, false); return __uint_as_float(rr[0]) + __uint_as_float(rr[1]); }
__device__ __forceinline__ void ln1_ld(Raw2& R, const int l, const int r_, const int rl, const float* xin_lat, const float* xin_ctx, const bf16_t* XB, const bf16_t* O, const int lane) {
    const int rr = (r_ < rl) ? r_ : rl;
    if (l == 0) { const float* xp = (rr < NLAT ? xin_lat + (size_t)rr * 1024 : xin_ctx + (size_t)(rr - NLAT) * 1024) + 4 * lane;
#pragma unroll
        for (int j = 0; j < 4; ++j) R.x[j] = *(const f32x4*)(xp + 256 * j); }
    else { const bf16_t* xp = XB + (size_t)rr * 1024 + 4 * lane;
#pragma unroll
        for (int j = 0; j < 4; ++j) { const u32x2 w = *(const u32x2*)(xp + 256 * j); R.x[j][0] = __uint_as_float(w.x); R.x[j][1] = __uint_as_float(w.y); } }
    const bf16_t* op = O + (size_t)rr * 1024 + 4 * lane;
#pragma unroll
    for (int j = 0; j < 4; ++j) R.o[j] = *(const u32x2*)(op + 256 * j);
}
__device__ __forceinline__ void ln1_row(const Raw2& R, Ln1Par& P, const int l, const int row, const int i, bf16_t* XB, const float* mod, const float* g1, const float* b1, bf16_t* V,
        const LAS float* Wl, LAS float* lg, const int lane) {
    const bool lat = row < NLAT; const int bi = lat ? (row >> 12) : 16;
    if (bi != P.cur_bi) { P.cur_bi = bi; const float* mb = mod + ((size_t)(l * 17 + bi) * 6) * 1024;
        P.gate = ldv(mb + 2 * 1024, lane); P.m3 = ldv(mb + 3 * 1024, lane); P.m4 = ldv(mb + 4 * 1024, lane); P.gg = ldv(g1 + l * 1024, lane); P.bb = ldv(b1 + l * 1024, lane);
#pragma unroll
        for (int j = 0; j < 4; ++j) P.m4.v[j] = P.m4.v[j] + 1.0f;
        __builtin_amdgcn_s_waitcnt(0x0F70); }
    Vec y;
#pragma unroll
    for (int j = 0; j < 4; ++j) y.v[j] = ((l == 0) ? R.x[j] : cvt4b(R.x[j])) * DN_ALPHA + P.gate.v[j] * cvt4u(R.o[j]);
    normalize(y);
    Vec v;
#pragma unroll
    for (int j = 0; j < 4; ++j) { y.v[j] = y.v[j] * P.gg.v[j] + P.bb.v[j]; v.v[j] = y.v[j] * P.m4.v[j] + P.m3.v[j]; }
    stbf(XB + (size_t)row * 1024, lane, y); stbf(V + (size_t)row * 1024, lane, v);
    f32x4 a[4];
#pragma unroll
    for (int q = 0; q < 4; ++q) a[q] = (f32x4){0.f, 0.f, 0.f, 0.f};
#pragma unroll
    for (int j = 0; j < 4; ++j)
#pragma unroll
        for (int e4 = 0; e4 < 4; ++e4) { const float vv = v.v[j][e4]; const int jj = j * 4 + e4;
#pragma unroll
            for (int q = 0; q < 4; ++q) a[q] += vv * *(const LAS f32x4*)(Wl + (((jj * 4 + q) * 64 + lane) << 2)); }
    float r8[8], r4[4], r2[2], r1;
#pragma unroll
    for (int k = 0; k < 8; ++k) r8[k] = swap32_sum(a[k >> 2][k & 3], a[2 + (k >> 2)][k & 3]);
#pragma unroll
    for (int k = 0; k < 4; ++k) r4[k] = swap16_sum(r8[k], r8[4 + k]);
    { const bool up = lane & 2;
#pragma unroll
      for (int k = 0; k < 2; ++k) { const float mine = up ? r4[2 + k] : r4[k], theirs = up ? r4[k] : r4[2 + k]; r2[k] = mine + dpp_f<0x4E>(theirs); } }
    { const bool up = lane & 1; const float mine = up ? r2[1] : r2[0], theirs = up ? r2[0] : r2[1]; r1 = mine + dpp_f<0xB1>(theirs); }
    r1 += dpp_f<0x124>(r1); r1 += dpp_f<0x128>(r1);
    if ((lane & 12) == 0) lg[i * 16 + (((lane >> 4) << 2) | (lane & 3))] = r1;
}
__device__ __forceinline__ void ln1_router(LAS unsigned char* lds, const int l, const int nrows, const float* xin_lat, const float* xin_ctx, bf16_t* XB, const bf16_t* O,
        const float* mod, const float* g1, const float* b1, const float* router_w, const float* router_b, bf16_t* V, float* route, unsigned* list, unsigned* gcnt) {
    const int tid = otid(), lane = tid & 63, wid = __builtin_amdgcn_readfirstlane(tid >> 6);
    LAS float* Wl = (LAS float*)lds; LAS float* lg = (LAS float*)(lds + LG_OFF) + wid * (34 * 16);
    LAS unsigned* cnt = (LAS unsigned*)(lds + CNT_OFF); LAS unsigned* base = (LAS unsigned*)(lds + BASE_OFF);
    for (int i = tid; i < 1024 * 16; i += NTHREADS) { const int k = i >> 4, e = i & 15, ln = (k & 255) >> 2, jj = (k >> 8) * 4 + (k & 3);
        Wl[(((jj * 4 + (e >> 2)) * 64 + ln) << 2) + (e & 3)] = router_w[i]; }
    if (tid < 16) cnt[tid] = 0u;
    __syncthreads();
    const int rpw = nrows / 256, rpv = rpw / 8;
    const int row0 = blockIdx.x * rpw + wid * rpv, rl = row0 + rpv - 1;
    Ln1Par P; P.cur_bi = -1;
    Raw2 RA, RB, RC;
    ln1_ld(RA, l, row0, rl, xin_lat, xin_ctx, XB, O, lane); ln1_ld(RB, l, row0 + 1, rl, xin_lat, xin_ctx, XB, O, lane);
    for (int i = 0; i < rpv; i += 3) {
        ln1_ld(RC, l, row0 + i + 2, rl, xin_lat, xin_ctx, XB, O, lane);
        ln1_row(RA, P, l, row0 + i, i, XB, mod, g1, b1, V, Wl, lg, lane);
        if (i + 1 >= rpv) break;
        ln1_ld(RA, l, row0 + i + 3, rl, xin_lat, xin_ctx, XB, O, lane);
        ln1_row(RB, P, l, row0 + i + 1, i + 1, XB, mod, g1, b1, V, Wl, lg, lane);
        if (i + 2 >= rpv) break;
        ln1_ld(RB, l, row0 + i + 4, rl, xin_lat, xin_ctx, XB, O, lane);
        ln1_row(RC, P, l, row0 + i + 2, i + 2, XB, mod, g1, b1, V, Wl, lg, lane);
    }
    LDS_WAIT();
    int e0 = 0, e1 = 0; float w0 = 0.f, w1 = 0.f; unsigned lp0 = 0, lp1 = 0;
    if (lane < rpv) {
        float sc[16], sel[16];
#pragma unroll
        for (int e = 0; e < 16; ++e) { sc[e] = 1.0f / (1.0f + __expf(-lg[lane * 16 + e])); sel[e] = sc[e] + router_b[e]; }
        float gs[4];
#pragma unroll
        for (int g = 0; g < 4; ++g) { const float s0 = sel[4 * g], s1 = sel[4 * g + 1], s2 = sel[4 * g + 2], s3 = sel[4 * g + 3];
            gs[g] = fmaxf(fmaxf(fmaxf(s0 + s1, s0 + s2), fmaxf(s0 + s3, s1 + s2)), fmaxf(s1 + s3, s2 + s3)); }
        int best = 0; float bv = gs[0];
#pragma unroll
        for (int g = 1; g < 4; ++g) if (gs[g] > bv) { bv = gs[g]; best = g; }
        float a4[4], c4[4];
#pragma unroll
        for (int k = 0; k < 4; ++k) { a4[k] = sel[k]; c4[k] = sc[k]; }
#pragma unroll
        for (int g = 1; g < 4; ++g) if (best == g) {
#pragma unroll
            for (int k = 0; k < 4; ++k) { a4[k] = sel[4 * g + k]; c4[k] = sc[4 * g + k]; } }
        int i0 = 0; float v0 = a4[0], s0 = c4[0];
#pragma unroll
        for (int k = 1; k < 4; ++k) if (a4[k] > v0) { v0 = a4[k]; i0 = k; s0 = c4[k]; }
        int i1 = -1; float v1 = 0.f, s1 = 0.f;
#pragma unroll
        for (int k = 0; k < 4; ++k) if (k != i0 && (i1 < 0 || a4[k] > v1)) { v1 = a4[k]; i1 = k; s1 = c4[k]; }
        e0 = best * 4 + i0; e1 = best * 4 + i1; const float inv = 1.0f / (s0 + s1); w0 = s0 * inv; w1 = s1 * inv;
        lp0 = atomicAdd((unsigned*)(cnt + e0), 1u); lp1 = atomicAdd((unsigned*)(cnt + e1), 1u);
    }
    __syncthreads();
    if (tid < 16) base[tid] = atomicAdd(gcnt + tid, cnt[tid]);
    __syncthreads();
    if (lane < rpv) { const int row = row0 + lane;
        ((u32x2*)list)[(size_t)e0 * NTOK + base[e0] + lp0] = (u32x2){(unsigned)row * 2u, __float_as_uint(w0)}; ((u32x2*)list)[(size_t)e1 * NTOK + base[e1] + lp1] = (u32x2){(unsigned)row * 2u + 1u, __float_as_uint(w1)};
        *(f32x4*)(route + (size_t)row * 4) = (f32x4){__int_as_float(e0), __int_as_float(e1), w0, w1}; }
    __syncthreads();
}

struct Raw3 { u32x2 x[4], f0[4], f1[4]; };
__device__ __forceinline__ void ld_raw3(Raw3& r, const bf16_t* XB, const bf16_t* F0, const bf16_t* F1, const int row, const int lane) {
    const size_t o = (size_t)row * 1024 + 4 * lane;
#pragma unroll
    for (int j = 0; j < 4; ++j) { r.x[j] = *(const u32x2*)(XB + o + 256 * j); r.f0[j] = *(const u32x2*)(F0 + o + 256 * j); r.f1[j] = *(const u32x2*)(F1 + o + 256 * j); } }
__device__ __forceinline__ f32x4 cvt4(const u32x2 w) { return (f32x4){bflo(w.x), bfhi(w.x), bflo(w.y), bfhi(w.y)}; }
struct Ln2Par { Vec gate, gg, bb, s1, s0; int cur_bi; };
__device__ __forceinline__ void ln2_row(const Raw3& R, Ln2Par& P, const int l, const int row, float* out_lat, bf16_t* XB, const float* mod, const float* g2, const float* b2, bf16_t* U, const int lane) {
    const bool lat = row < NLAT; const int bi = lat ? (row >> 12) : 16;
    if (bi != P.cur_bi) { P.cur_bi = bi; const float* mb = mod + ((size_t)(l * 17 + bi) * 6) * 1024;
        P.gate = ldv(mb + 5 * 1024, lane); P.gg = ldv(g2 + l * 1024, lane); P.bb = ldv(b2 + l * 1024, lane);
        if (l + 1 < DEPTH) { const float* mn = mod + ((size_t)((l + 1) * 17 + bi) * 6) * 1024; P.s0 = ldv(mn, lane); P.s1 = ldv(mn + 1024, lane);
#pragma unroll
            for (int j = 0; j < 4; ++j) P.s1.v[j] = P.s1.v[j] + 1.0f; }
        __builtin_amdgcn_s_waitcnt(0x0F70); }
    Vec y;
#pragma unroll
    for (int j = 0; j < 4; ++j) y.v[j] = cvt4(R.x[j]) * DN_ALPHA + P.gate.v[j] * (cvt4(R.f0[j]) + cvt4(R.f1[j]));
    normalize(y);
#pragma unroll
    for (int j = 0; j < 4; ++j) y.v[j] = y.v[j] * P.gg.v[j] + P.bb.v[j];
    if (l + 1 < DEPTH) stbf(XB + (size_t)row * 1024, lane, y); else stf(out_lat + (size_t)row * 1024, lane, y);
    if (l + 1 < DEPTH) { Vec u;
#pragma unroll
        for (int j = 0; j < 4; ++j) u.v[j] = y.v[j] * P.s1.v[j] + P.s0.v[j];
        stbf(U + (size_t)row * 1024, lane, u); }
}
__device__ __forceinline__ void ln2(const int l, const int nrows, float* out_lat, bf16_t* XB, const bf16_t* F0, const bf16_t* F1, const float* mod, const float* g2, const float* b2, bf16_t* U, const int gw, const int ngw) {
    const int lane = otid() & 63;
    const int per = (nrows + ngw - 1) / ngw;
    const int r0 = gw * per, rend = (r0 + per < nrows) ? r0 + per : nrows;
    Ln2Par P; P.cur_bi = -1;
    if (r0 >= rend) return;
    const int rl = rend - 1;
    Raw3 A, B, C;
    ld_raw3(A, XB, F0, F1, r0, lane);
    ld_raw3(B, XB, F0, F1, (r0 + 1 < rl) ? r0 + 1 : rl, lane);
    for (int row = r0; row < rend; row += 3) {
        ld_raw3(C, XB, F0, F1, (row + 2 < rl) ? row + 2 : rl, lane);
        ln2_row(A, P, l, row, out_lat, XB, mod, g2, b2, U, lane);
        if (row + 1 >= rend) break;
        ld_raw3(A, XB, F0, F1, (row + 3 < rl) ? row + 3 : rl, lane);
        ln2_row(B, P, l, row + 1, out_lat, XB, mod, g2, b2, U, lane);
        if (row + 2 >= rend) break;
        ld_raw3(B, XB, F0, F1, (row + 4 < rl) ? row + 4 : rl, lane);
        ln2_row(C, P, l, row + 2, out_lat, XB, mod, g2, b2, U, lane);
    }
}
}

namespace pro {
template <class Src>
__device__ __forceinline__ void tr_item(const Src& src, bf16_t* WT, const int K, const int n0, const int k0, LAS float* scr, const int lane) {
    float tv[32];
#pragma unroll
    for (int i = 0; i < 32; ++i) tv[i] = src(n0 + (lane & 31), k0 + 2 * i + (lane >> 5));
#pragma unroll
    for (int i = 0; i < 32; ++i) { const int kk = 2 * i + (lane >> 5); scr[kk * 33 + (lane & 31)] = tv[i]; }
    LDS_WAIT(); asm volatile("" ::: "memory");
    const int c = lane & 7;
#pragma unroll
    for (int j = 0; j < 4; ++j) { const int n = (lane >> 3) + 8 * j; const LAS float* s = scr + (8 * c) * 33 + n;
        u32x4 o; o.x = pk2(s[0 * 33], s[1 * 33]); o.y = pk2(s[2 * 33], s[3 * 33]); o.z = pk2(s[4 * 33], s[5 * 33]); o.w = pk2(s[6 * 33], s[7 * 33]);
        *(u32x4*)(WT + (size_t)(n0 + n) * K + k0 + 8 * c) = o; }
    LDS_WAIT(); asm volatile("" ::: "memory");
}
__device__ __forceinline__ int rotperm(int p) { return 16 * ((p >> 2) & 1) + 4 * (p >> 3) + (p & 3); }
struct SrcIn { const float* w; __device__ float operator()(int n, int k) const { if (n >= D_IN) return 0.f; const int g = n >> 5; const bool rt = (g >= 16 && g < 40) || g == 64;
    const int col = rt ? (g * 32 + rotperm(n & 31)) : n; return w[(size_t)k * D_IN + col]; } };
struct SrcOut { const float* w; __device__ float operator()(int n, int k) const { return w[(size_t)k * 1024 + n]; } };
struct Src13 { const float* w1; const float* w3; __device__ float operator()(int n, int k) const { const int g = n >> 5, p = n & 31, col = 16 * g + 4 * (p >> 3) + (p & 3);
    const float a = w1[(size_t)k * 256 + col], b = w3[(size_t)k * 256 + col]; return ((p >> 2) & 1) ? b : a; } };
struct Src2 { const float* w; __device__ float operator()(int n, int k) const { return w[(size_t)k * 1024 + n]; } };
struct SrcUQ { const float* w; const float* g; __device__ float operator()(int n, int k) const { if (n >= 576) return 0.f; const int gr = n >> 5, head = gr / 3, part = gr % 3;
    const int col = head * 96 + part * 32 + (part == 2 ? rotperm(n & 31) : (n & 31)); return g[k] * w[(size_t)k * 576 + col]; } };
struct SrcUKV { const float* w; const float* g; __device__ float operator()(int n, int k) const { return g[k] * w[(size_t)k * 768 + n]; } };
struct SrcG { const float* wa; const float* wi; __device__ float operator()(int n, int k) const { const int hb = n >> 8, o = n & 255, d = o >> 7, gt = (o >> 6) & 1, ch = o & 63;
    const size_t ix = (((size_t)d * 4 + hb) * 64 + k) * 64 + ch; const float a = wa[ix], b = wi[ix]; return gt ? b : a; } };
}


struct Args { const float* in[30]; float* out; unsigned char* ws; int ph_lo, ph_hi; };
constexpr int NPHASE = 2 + 9 * DEPTH;
typedef __attribute__((address_space(4))) const Args CArgs;
__device__ __forceinline__ CArgs* kargs() { CArgs* p = (CArgs*)__builtin_amdgcn_kernarg_segment_ptr(); asm volatile("" : "+s"(p)); return p; }
#define WSP(T, off) ((T*)(ws + (off)))
#ifndef PHMASK
#define PHMASK 0xFFFFFFFFu
#endif
#define PHON(j) ((PHMASK >> (j)) & 1u)

__global__ void __launch_bounds__(NTHREADS, 2) fwd_kernel(Args args_unused) {
    extern __shared__ __attribute__((aligned(16))) unsigned char lds_raw[];
    LAS unsigned char* lds = (LAS unsigned char*)lds_raw;
    const int tid = threadIdx.x;
    const int G = gridDim.x, bx = blockIdx.x; const int vcu = (G % 8 == 0) ? (bx % 8) * (G / 8) + bx / 8 : bx;
    static_assert(WIDTAB_OFF == MISC_OFF + 512 && WIDTAB_OFF + 256 <= LDS_BYTES, "wave-id table");
    for (int u = tid; u < (LDS_BYTES - MISC_OFF) / 4; u += NTHREADS) ((LAS unsigned*)(lds + MISC_OFF))[u] = 0u;
    __syncthreads();
    if ((tid & 63) == 0) { const unsigned hw = (unsigned)__builtin_amdgcn_s_getreg((5 << 11) | (0 << 6) | 4) & 63u; ((LAS int*)(lds + WIDTAB_OFF))[hw] = tid >> 6; }
    __syncthreads();
    int lo, hi;
    XcdBarrier bar;
    { CArgs* A = kargs(); lo = A->ph_lo; hi = A->ph_hi; unsigned* bw = (unsigned*)(A->ws + WS_CTL) + CW_BAR;
      bar.bar = bw; bar.x = 0; bar.st = nullptr;
      if (hi - lo > 1) bar = xcd_barrier_post(bw, (volatile LAS unsigned*)(lds + MISC_OFF) + 8); }
#define IN(k) (lo <= (k) && (k) < hi)
#define SEAM(k) do { if (IN(k) && IN((k) + 1)) xcd_barrier(bar); } while (0)

    if (PHON(0) && IN(0)) {
        CArgs* A = kargs(); unsigned char* ws = A->ws;
        const int lane = tid & 63, wave = __builtin_amdgcn_readfirstlane(tid >> 6); const int gw = vcu * NWAVES + wave, NGW = G * NWAVES;
        if (bx == G - 1) {
            float* ROT = WSP(float, WS_ROT); const float* diff_lambda = A->in[15];
            for (int i = tid; i < 512; i += NTHREADS) { const int pos = i >> 3, f = i & 7; const float inv = exp2f(-(float)f * (13.287712379549449f / 8.0f)); const float ang = (float)pos * inv;
                ROT[i] = __cosf(ang); ROT[512 + i] = __sinf(ang); }
            if (tid < DEPTH) { const float* lv = diff_lambda + tid * 128; float s01 = 0.f, s23 = 0.f; for (int k = 0; k < 32; ++k) { s01 += lv[k] * lv[32 + k]; s23 += lv[64 + k] * lv[96 + k]; }
                ROT[1024 + tid] = expf(s01) - expf(s23) + (0.8f - 0.6f * expf(-0.3f * (float)tid)); }
        }
        if (bx < 192) {
            const float* c_in = A->in[1]; const float* cctx_in = A->in[3]; const float* w_mod = A->in[4]; const float* b_mod = A->in[5]; float* MOD = WSP(float, WS_MOD);
            LAS float* S = (LAS float*)lds;
            LAS float* red = (LAS float*)(lds + 81920);
            for (int i = tid; i < 17 * 1024; i += NTHREADS) { const int bi = i >> 10, k = i & 1023; const float cv = (bi < 16) ? c_in[bi * 1024 + k] : cctx_in[k]; S[k * 20 + bi] = cv / (1.0f + __expf(-cv)); }
            __syncthreads();
            for (int item = bx; item < 192; item += G) {
                const int l = item / 48, n0 = (item % 48) * 128, kg = tid >> 7, cl = tid & 127;
                float acc[17];
#pragma unroll
                for (int b = 0; b < 17; ++b) acc[b] = 0.f;
                const float* wp = w_mod + ((size_t)l * 1024 + kg * 256) * 6144 + n0 + cl;
#pragma unroll 16
                for (int k = 0; k < 256; ++k) { const float w = wp[(size_t)k * 6144]; const LAS float* sp = S + (kg * 256 + k) * 20;
                    const f32x4 s0 = *(const LAS f32x4*)sp, s1 = *(const LAS f32x4*)(sp + 4), s2 = *(const LAS f32x4*)(sp + 8), s3 = *(const LAS f32x4*)(sp + 12); const float s4 = sp[16];
#pragma unroll
                    for (int b = 0; b < 4; ++b) { acc[b] += s0[b] * w; acc[4 + b] += s1[b] * w; acc[8 + b] += s2[b] * w; acc[12 + b] += s3[b] * w; }
                    acc[16] += s4 * w; }
#pragma unroll
                for (int b = 0; b < 17; ++b) red[(kg * 17 + b) * 128 + cl] = acc[b];
                __syncthreads();
                for (int i = tid; i < 17 * 128; i += NTHREADS) { const int b = i >> 7, c = i & 127; const float v = red[(0 * 17 + b) * 128 + c] + red[(1 * 17 + b) * 128 + c] + red[(2 * 17 + b) * 128 + c] + red[(3 * 17 + b) * 128 + c];
                    const int n = n0 + c, j = n >> 10, col = n & 1023; MOD[((size_t)(l * 17 + b) * 6 + j) * 1024 + col] = v + b_mod[l * 6144 + n]; }
                __syncthreads();
            }
        }
        __syncthreads();
        { LAS float* scr = (LAS float*)(lds + wave * 8448);
          constexpr int I_IN = 72 * 16, I_OUT = 32 * 16, I_13 = 16 * 16, I_2 = 32 * 4, I_UQ = 24 * 4, I_UKV = 24 * 2, I_G = 32;
          constexpr int T_IN = DEPTH * I_IN, T_OUT = DEPTH * I_OUT, T_13 = DEPTH * NEXP * I_13, T_2 = DEPTH * NEXP * I_2, T_UQ = DEPTH * I_UQ, T_UKV = DEPTH * I_UKV, T_G = DEPTH * I_G;
          constexpr int NITEMS = T_IN + T_OUT + T_13 + T_2 + T_UQ + T_UKV + T_G;
          for (int it = gw; it < NITEMS; it += NGW) {
              int r = it;
              if (r < T_IN) { const int l = r / I_IN, q = r % I_IN; pro::tr_item(pro::SrcIn{A->in[6] + (size_t)l * 1024 * D_IN}, WSP(bf16_t, WS_WIN) + (size_t)l * NIN_PAD * 1024, 1024, (q >> 4) * 32, (q & 15) * 64, scr, lane); continue; } r -= T_IN;
              if (r < T_OUT) { const int l = r / I_OUT, q = r % I_OUT; pro::tr_item(pro::SrcOut{A->in[7] + (size_t)l * 1024 * 1024}, WSP(bf16_t, WS_WOUT) + (size_t)l * 1024 * 1024, 1024, (q >> 4) * 32, (q & 15) * 64, scr, lane); continue; } r -= T_OUT;
              if (r < T_13) { const int le = r / I_13, q = r % I_13; pro::tr_item(pro::Src13{A->in[27] + (size_t)le * 1024 * 256, A->in[28] + (size_t)le * 1024 * 256}, WSP(bf16_t, WS_W13) + (size_t)le * 512 * 1024, 1024, (q >> 4) * 32, (q & 15) * 64, scr, lane); continue; } r -= T_13;
              if (r < T_2) { const int le = r / I_2, q = r % I_2; pro::tr_item(pro::Src2{A->in[29] + (size_t)le * 256 * 1024}, WSP(bf16_t, WS_W2) + (size_t)le * 1024 * 256, 256, (q >> 2) * 32, (q & 3) * 64, scr, lane); continue; } r -= T_2;
              if (r < T_UQ) { const int l = r / I_UQ, q = r % I_UQ; pro::tr_item(pro::SrcUQ{A->in[19] + (size_t)l * 256 * 576, A->in[17] + l * 256}, WSP(bf16_t, WS_WUQ) + (size_t)l * 768 * 256, 256, (q >> 2) * 32, (q & 3) * 64, scr, lane); continue; } r -= T_UQ;
              if (r < T_UKV) { const int l = r / I_UKV, q = r % I_UKV; pro::tr_item(pro::SrcUKV{A->in[20] + (size_t)l * 128 * 768, A->in[18] + l * 128}, WSP(bf16_t, WS_WUKV) + (size_t)l * 768 * 128, 128, (q >> 1) * 32, (q & 1) * 64, scr, lane); continue; } r -= T_UKV;
              { const int l = r / I_G, q = r % I_G; pro::tr_item(pro::SrcG{A->in[10] + (size_t)l * 2 * 4 * 64 * 64, A->in[12] + (size_t)l * 2 * 4 * 64 * 64}, WSP(bf16_t, WS_WG) + (size_t)l * 1024 * 64, 64, q * 32, 0, scr, lane); }
          } }
        __syncthreads();
    }
    SEAM(0);
    if (PHON(1) && IN(1)) {
        CArgs* A = kargs(); unsigned char* ws = A->ws; const float* x_in = A->in[0]; const float* ctx_in = A->in[2]; const float* MOD = WSP(float, WS_MOD); bf16_t* U = WSP(bf16_t, WS_U);
        const int lane = tid & 63, wave = __builtin_amdgcn_readfirstlane(tid >> 6); const int gw = vcu * NWAVES + wave, NGW = G * NWAVES;
        const int per = NTOK / NGW;
        int cur_bi = -1; lnp::Vec s0, s1;
        const int r0 = gw * per, rl = r0 + per - 1;
#define PB_LD(R, r_) do { const int rr_ = ((r_) < rl) ? (r_) : rl; R = lnp::ldv(rr_ < NLAT ? x_in + (size_t)rr_ * 1024 : ctx_in + (size_t)(rr_ - NLAT) * 1024, lane); } while (0)
#define PB_ROW(R, row_) do { const int row = (row_); const bool lat = row < NLAT; const int bi = lat ? (row >> 12) : 16; \
            if (bi != cur_bi) { cur_bi = bi; const float* mb = MOD + ((size_t)bi * 6) * 1024; s0 = lnp::ldv(mb, lane); s1 = lnp::ldv(mb + 1024, lane); \
                _Pragma("unroll") for (int j = 0; j < 4; ++j) s1.v[j] = s1.v[j] + 1.0f; \
                __builtin_amdgcn_s_waitcnt(0x0F70); } \
            lnp::Vec xv; _Pragma("unroll") for (int j = 0; j < 4; ++j) xv.v[j] = R.v[j] * s1.v[j] + s0.v[j]; \
            lnp::stbf(U + (size_t)row * 1024, lane, xv); } while (0)
        lnp::Vec RA, RB, RC; PB_LD(RA, r0); PB_LD(RB, r0 + 1);
        for (int i = 0; i < per; i += 3) {
            PB_LD(RC, r0 + i + 2); PB_ROW(RA, r0 + i);
            if (i + 1 >= per) break;
            PB_LD(RA, r0 + i + 3); PB_ROW(RB, r0 + i + 1);
            if (i + 2 >= per) break;
            PB_LD(RB, r0 + i + 4); PB_ROW(RC, r0 + i + 2);
        }
#undef PB_LD
#undef PB_ROW
    }
    SEAM(1);

    for (int l = 0; l < DEPTH; ++l) {
        const int pb = 2 + 9 * l;
        const bool need_ctx = l < DEPTH - 1;
        const int mrows = need_ctx ? NTOK : NLAT;
        if (PHON(2) && IN(pb)) {
            CArgs* A = kargs(); unsigned char* ws = A->ws;
            { const float* ROT = WSP(float, WS_ROT); for (int i = otid(); i < 1024; i += NTHREADS) ((LAS float*)(lds + ROT_OFF))[i] = ROT[i]; }
            __syncthreads();
            pg8::StaticOrder S; S.init(NTOK, NIN_PAD, G, bx);
            EpiInProj E{WSP(bf16_t, WS_XL), WSP(bf16_t, WS_GG), WSP(bf16_t, WS_QD), WSP(bf16_t, WS_KD), WSP(bf16_t, WS_VD), WSP(bf16_t, WS_CQ), WSP(bf16_t, WS_CKV), WSP(bf16_t, WS_KR),
                        WSP(float, WS_SSP), (const LAS float*)(lds + ROT_OFF)};
            pg8::gemm_phase<EpiInProj, pg8::StaticOrder, false>(lds, WSP(bf16_t, WS_U), WSP(bf16_t, WS_WIN) + (size_t)l * NIN_PAD * 1024, 1024, S, E);
        }
        SEAM(pb);
        if (PHON(3) && IN(pb + 1)) {
            { CArgs* A = kargs(); unsigned char* ws = A->ws;
              { const float* ROT = WSP(float, WS_ROT); for (int i = otid(); i < 1024; i += NTHREADS) ((LAS float*)(lds + ROT_OFF))[i] = ROT[i]; }
              __syncthreads();
              pg8::StaticOrder S; S.init(NTOK, 768, G, bx); EpiExpQ E{WSP(bf16_t, WS_QM), WSP(float, WS_SSP), (const LAS float*)(lds + ROT_OFF)};
              pg8::gemm_phase<EpiExpQ, pg8::StaticOrder, false>(lds, WSP(bf16_t, WS_CQ), WSP(bf16_t, WS_WUQ) + (size_t)l * 768 * 256, 256, S, E); }
            __syncthreads(); asm volatile("" ::: "memory");
            { CArgs* A = kargs(); unsigned char* ws = A->ws;
              pg8::StaticOrder S; S.init(NTOK, 768, G, (bx + G / 2) % G); EpiExpKV E{
              WSP(bf16_t, WS_KN), WSP(bf16_t, WS_VM), WSP(float, WS_SSP)};
              pg8::gemm_phase<EpiExpKV, pg8::StaticOrder, false>(lds, WSP(bf16_t, WS_CKV), WSP(bf16_t, WS_WUKV) + (size_t)l * 768 * 128, 128, S, E); }
            __syncthreads(); asm volatile("" ::: "memory");
            { CArgs* A = kargs(); unsigned char* ws = A->ws;
              lru::WaveCtx W; lru::load_ctx(W, l, WSP(bf16_t, WS_WG), A->in[8], A->in[9], A->in[11], A->in[13], A->in[14]);
              lru::run_chunks<false>(lds, W, vcu, G, NCHUNK, WSP(bf16_t, WS_XL), WSP(bf16_t, WS_GG), WSP(float, WS_LSUM), WSP(float, WS_LCAR), WSP(bf16_t, WS_MIX));
              __syncthreads(); }
        }
        SEAM(pb + 1);
        if (PHON(4) && IN(pb + 2)) { CArgs* A = kargs(); unsigned char* ws = A->ws; lru::carry(WSP(float, WS_LSUM), WSP(float, WS_LCAR)); }
        SEAM(pb + 2);
        if (PHON(5) && IN(pb + 3)) {
            { CArgs* A = kargs(); unsigned char* ws = A->ws;
              lru::WaveCtx W; lru::load_ctx(W, l, WSP(bf16_t, WS_WG), A->in[8], A->in[9], A->in[11], A->in[13], A->in[14]);
              const int nch = need_ctx ? NCHUNK : NCHUNK_LAT;
              lru::run_chunks<true>(lds, W, vcu, G, nch, WSP(bf16_t, WS_XL), WSP(bf16_t, WS_GG), WSP(float, WS_LSUM), WSP(float, WS_LCAR), WSP(bf16_t, WS_MIX));
              __syncthreads(); }
            asm volatile("" ::: "memory");
            for (int ph_ = 0; ph_ < 2; ++ph_) {
            const bool mla_now = ((ph_ ^ (vcu >> 5)) & 1) != 0;
            asm volatile("" ::: "memory");
            if (!mla_now)
            { CArgs* A = kargs(); unsigned char* ws = A->ws;
              const float lam_init = 0.8f - 0.6f * expf(-0.3f * (float)l);
              attd::Tens T{WSP(bf16_t, WS_QD), 384, 0, WSP(bf16_t, WS_KD), nullptr, WSP(bf16_t, WS_VD), 0, WSP(bf16_t, WS_MIX), 256, WSP(float, WS_ROT)[1024 + l], 1.0f - lam_init, A->in[16] + l * 64};
              for (int i = 0; i < 6; ++i) { const int uidx = vcu + 256 * i; if (uidx < 1536) { const int bh = uidx >> 4, qb = uidx & 15, b = bh / 6, h = bh % 6;
                  T.qcol = h * 64; T.kvcol = h * 64; T.ocol = 256 + h * 64; attd::attn_unit<0>(lds, T, b, false, qb); } }
              if (need_ctx && vcu < 96) { const int b = vcu / 6, h = vcu % 6; T.qcol = h * 64; T.kvcol = h * 64; T.ocol = 256 + h * 64; attd::attn_unit<0>(lds, T, b, true, 0); } }
            else
            { CArgs* A = kargs(); unsigned char* ws = A->ws;
              atts::Src S1{WSP(bf16_t, WS_QM), 576, 0, WSP(bf16_t, WS_KN), 0, WSP(bf16_t, WS_KR), WSP(bf16_t, WS_VM), 0};
              for (int i = 0; i < 7; ++i) {
                  const bool cx = (i == 6); if (cx && !(need_ctx && vcu >= 96 && vcu < 192)) break;
                  const int uidx = vcu + 256 * i; const int bh = cx ? vcu - 96 : (uidx >> 4), qb = cx ? 0 : (uidx & 15), b = bh / 6, h = bh % 6;
                  f32x16 oa[2]; atts::Sm sa;
                  S1.qcol = h * 96; S1.kcol = h * 64; S1.vcol = h * 64;
                  atts::attn_pass<1>(lds, S1, b, cx, qb, oa, sa);
                  atts::attn_store<false>(lds, oa, sa, oa, sa, 0.f, 0.f, nullptr, WSP(bf16_t, WS_MIX), 640 + h * 64, b, cx, qb);
              } }
            }
        }
        SEAM(pb + 3);
        if (PHON(6) && IN(pb + 4)) {
            CArgs* A = kargs(); unsigned char* ws = A->ws;
            pg8::StaticOrder S; S.init(mrows, 1024, G, bx); EpiPlain E{WSP(bf16_t, WS_O), 1024};
            pg8::gemm_phase<EpiPlain, pg8::StaticOrder, false>(lds, WSP(bf16_t, WS_MIX), WSP(bf16_t, WS_WOUT) + (size_t)l * 1024 * 1024, 1024, S, E);
        }
        SEAM(pb + 4);
        if (PHON(7) && IN(pb + 5)) {
            CArgs* A = kargs(); unsigned char* ws = A->ws;
            lnp::ln1_router(lds, l, mrows, A->in[0], A->in[2], WSP(bf16_t, WS_XB), WSP(bf16_t, WS_O), WSP(float, WS_MOD), A->in[21], A->in[22], A->in[25], A->in[26],
                            WSP(bf16_t, WS_V), WSP(float, WS_ROUTE), WSP(unsigned, WS_LIST), WSP(unsigned, WS_CTL) + CW_CNT + 64 * l);
        }
        SEAM(pb + 5);
        if (PHON(8) && (IN(pb + 6) || IN(pb + 7))) {
            CArgs* A = kargs(); unsigned char* ws = A->ws;
            LAS int* tb = (LAS int*)(lds + MISC_OFF + 256);
            __syncthreads();
            if (otid() == 0) { gu32* gcnt = (gu32*)WSP(unsigned, WS_CTL) + CW_CNT + 64 * l; int off = 0, toff = 0;
                for (int e = 0; e < 16; ++e) { const int c = (int)__hip_atomic_load(gcnt + e, __ATOMIC_RELAXED, __HIP_MEMORY_SCOPE_AGENT); tb[e] = c; tb[16 + e] = off; tb[33 + e] = toff; off += c; toff += (c + 255) >> 8; }
                tb[32] = off; tb[49] = toff; }
            __syncthreads();
            if (IN(pb + 6)) {
                MoeSched S{tb, WSP(unsigned, WS_LIST), G, bx, 2}; EpiMoeUp E{WSP(bf16_t, WS_H)};
                pg8::gemm_phase<EpiMoeUp, MoeSched, true>(lds, WSP(bf16_t, WS_V), WSP(bf16_t, WS_W13) + (size_t)l * NEXP * 512 * 1024, 1024, S, E);
            }
        }
        SEAM(pb + 6);
        if (PHON(9) && IN(pb + 7)) {
            CArgs* A = kargs(); unsigned char* ws = A->ws;
            LAS int* tb = (LAS int*)(lds + MISC_OFF + 256);
            MoeSched S{tb, WSP(unsigned, WS_LIST), G, bx, 4}; EpiMoeDown E{WSP(bf16_t, WS_F0), WSP(bf16_t, WS_F1), WSP(unsigned, WS_LIST), WSP(float, WS_ROUTE)};
            pg8::gemm_phase<EpiMoeDown, MoeSched, false>(lds, WSP(bf16_t, WS_H), WSP(bf16_t, WS_W2) + (size_t)l * NEXP * 1024 * 256, 256, S, E);
        }
        SEAM(pb + 7);
        if (PHON(10) && IN(pb + 8)) {
            CArgs* A = kargs(); unsigned char* ws = A->ws; const int wave = __builtin_amdgcn_readfirstlane(otid() >> 6);
            lnp::ln2(l, mrows, A->out, WSP(bf16_t, WS_XB), WSP(bf16_t, WS_F0), WSP(bf16_t, WS_F1), WSP(float, WS_MOD), A->in[23], A->in[24], WSP(bf16_t, WS_U), vcu * NWAVES + wave, G * NWAVES);
        }
        SEAM(pb + 8);
    }
#undef IN
#undef SEAM
}

#ifndef MK_SPLIT
#define MK_SPLIT 0
#endif
extern "C" void kernel_launch(void* const* d_in, const int* in_sizes, int n_in, void* d_out, int out_size, void* d_ws, size_t ws_size, hipStream_t stream) {
    static int grid = 0;
    if (grid == 0) {
        if (n_in != 30 || out_size != NLAT * DM || ws_size < WS_END) { fprintf(stderr, "kernel_launch: unexpected problem (n_in %d out %d ws %zu)\n", n_in, out_size, ws_size); grid = -1; return; }
        int dev = 0, cus = 0;
        if (hipGetDevice(&dev) != hipSuccess || hipDeviceGetAttribute(&cus, hipDeviceAttributeMultiprocessorCount, dev) != hipSuccess) { grid = -1; return; }
        if (hipFuncSetAttribute((const void*)fwd_kernel, hipFuncAttributeMaxDynamicSharedMemorySize, LDS_BYTES) != hipSuccess) { fprintf(stderr, "kernel_launch: hipFuncSetAttribute failed\n"); grid = -1; return; }
        int per_cu = 0;
        if (hipOccupancyMaxActiveBlocksPerMultiprocessor(&per_cu, (const void*)fwd_kernel, NTHREADS, LDS_BYTES) != hipSuccess || per_cu < 1) fprintf(stderr, "kernel_launch: occupancy query says %d\n", per_cu);
        (void)hipGetLastError();
        grid = cus;
        if (grid != 256) { fprintf(stderr, "kernel_launch: built for 256 CUs, device has %d\n", cus); grid = -1; return; }
    }
    if (grid < 0) return;
    if (hipMemsetAsync((char*)d_ws + WS_CTL, 0, CTL_ZERO_BYTES, stream) != hipSuccess) return;
    Args a{};
    for (int i = 0; i < 30; ++i) a.in[i] = (const float*)d_in[i];
    a.out = (float*)d_out; a.ws = (unsigned char*)d_ws;
#if MK_SPLIT
    for (int p = 0; p < NPHASE; ++p) { a.ph_lo = p; a.ph_hi = p + 1; hipLaunchKernelGGL(fwd_kernel, dim3(grid), dim3(NTHREADS), LDS_BYTES, stream, a); }
#else
    a.ph_lo = 0; a.ph_hi = NPHASE; hipLaunchKernelGGL(fwd_kernel, dim3(grid), dim3(NTHREADS), LDS_BYTES, stream, a);
#endif
}
```

```cpp
#include <hip/hip_runtime.h>
#include <cstdio>
#include <cstdint>

#define LAS __attribute__((address_space(3)))
#define GAS __attribute__((address_space(1)))
typedef unsigned short bf16_t;
typedef short bf16x8 __attribute__((ext_vector_type(8)));
typedef short s16x4 __attribute__((ext_vector_type(4)));
typedef float f32x2 __attribute__((ext_vector_type(2)));
typedef float f32x4 __attribute__((ext_vector_type(4)));
typedef float f32x16 __attribute__((ext_vector_type(16)));
typedef unsigned u32x2 __attribute__((ext_vector_type(2)));
typedef unsigned u32x4 __attribute__((ext_vector_type(4)));
typedef GAS unsigned gu32;

constexpr int DM = 1024, NBATCH = 16, SEQ = 4096, DEPTH = 4, CTXL = 256;
constexpr int NLAT = NBATCH * SEQ, NCTX = NBATCH * CTXL, NTOK = NLAT + NCTX;
constexpr int D_IN = 2080, NIN_PAD = 2304;
constexpr int NEXP = 16, DEXP = 256;
constexpr int NWAVES = 8, NTHREADS = 512;
constexpr float LN_EPS = 1e-5f, RMS_EPS = 1e-6f;
constexpr float DN_ALPHA = 1.6817928305074292f;
constexpr float LOG2E = 1.4426950408889634f;
constexpr float DA_QSCALE = 0.17677669529663687f * LOG2E;
constexpr float MLA_QSCALE = 0.10206207261596577f * LOG2E;
constexpr int NCHUNK_LAT = NLAT / 32, NCHUNK = NTOK / 32;

constexpr size_t MiB = 1u << 20;
constexpr size_t WS_CTL = 0, CTL_ZERO_BYTES = 1 * MiB;
constexpr size_t WS_MOD = 1 * MiB;
constexpr size_t WS_ROT = 3 * MiB;
constexpr size_t WS_SSQ = 4 * MiB;
constexpr size_t WS_KMX = WS_SSQ;
constexpr size_t WS_KMN = WS_SSQ + 128 * 1024;
constexpr size_t WS_ROUTE = 7 * MiB;
constexpr size_t WS_LIST = 154 * MiB;
constexpr size_t WS_LSUM = 14 * MiB;
constexpr size_t WS_LCAR = 23 * MiB;
constexpr size_t WS_WG = 28 * MiB;
constexpr size_t WS_WUQ = 29 * MiB;
constexpr size_t WS_WUKV = 31 * MiB;
constexpr size_t WS_WIN = 32 * MiB;
constexpr size_t WS_WOUT = 50 * MiB;
constexpr size_t WS_W13 = 58 * MiB;
constexpr size_t WS_W2 = 122 * MiB;
constexpr size_t WS_XC = 154 * MiB;
constexpr size_t WS_R1 = 170 * MiB;
constexpr size_t WS_R2 = 306 * MiB;
constexpr size_t WS_R3 = 442 * MiB;
constexpr size_t WS_R4 = 578 * MiB;
constexpr size_t WS_U = WS_R1, WS_MIX = WS_R1;
constexpr size_t WS_O = WS_R2, WS_F0 = WS_R2, WS_QD = WS_R2, WS_KD = WS_R2 + 51 * MiB, WS_XL = WS_R2 + 102 * MiB;
constexpr size_t WS_V = WS_R3, WS_F1 = WS_R3, WS_VD = WS_R3, WS_KN = WS_R3 + 51 * MiB, WS_GG = WS_R3 + 102 * MiB;
constexpr size_t WS_VM = WS_R4, WS_QM = WS_R4 + 51 * MiB, WS_CQ = WS_R4 + 128 * MiB, WS_CKV = WS_R4 + 162 * MiB, WS_KR = WS_R4 + 179 * MiB, WS_H = WS_R4;
constexpr size_t WS_XB = WS_R4 + 184 * MiB;
constexpr size_t WS_SSP = WS_XB + 136 * MiB;
constexpr size_t WS_END = WS_SSP + 4 * MiB;
static_assert((size_t)NTOK * 384 * 2 <= 51 * MiB && (size_t)NTOK * 256 * 2 <= 34 * MiB && (size_t)NTOK * 576 * 2 <= 77 * MiB && (size_t)NTOK * 1024 * 2 == 136 * MiB, "ws map");
static_assert((size_t)(2 * NTOK + 256) * 256 * 2 <= 128 * MiB, "H overlay");
constexpr int CW_BAR = 4096;
constexpr int CW_CNT = 2048;

constexpr int RING_BYTES = 155648;
constexpr int ROT_OFF = RING_BYTES;
constexpr int MISC_OFF = ROT_OFF + 4096;

constexpr int LDS_BYTES = 163840;

#define LDS_WAIT() asm volatile("s_waitcnt lgkmcnt(0)" ::: "memory")
#define VM_WAIT() asm volatile("s_waitcnt vmcnt(0)" ::: "memory")
__device__ __forceinline__ unsigned f2bf(float f) { unsigned u = __builtin_bit_cast(unsigned, f); return (u + 0x7fffu + ((u >> 16) & 1u)) >> 16; }
__device__ __forceinline__ unsigned pk2(float lo, float hi) { return f2bf(lo) | (f2bf(hi) << 16); }
typedef float f32x2_t __attribute__((ext_vector_type(2))); typedef __bf16 bf16x2_t __attribute__((ext_vector_type(2)));
__device__ __forceinline__ unsigned cvt_pk_bf16(float lo, float hi) { f32x2_t v = {lo, hi}; bf16x2_t b = __builtin_convertvector(v, bf16x2_t); return __builtin_bit_cast(unsigned, b); }
__device__ __forceinline__ float bf2f(unsigned h) { return __uint_as_float(h << 16); }
__device__ __forceinline__ float bflo(unsigned w) { return __uint_as_float(w << 16); }
__device__ __forceinline__ float bfhi(unsigned w) { return __uint_as_float(w & 0xffff0000u); }
template <int CTRL> __device__ __forceinline__ float dpp_f(float v) { return __builtin_bit_cast(float, __builtin_amdgcn_update_dpp(0, __builtin_bit_cast(int, v), CTRL, 0xF, 0xF, true)); }
__device__ __forceinline__ float wave_sum(float v) {
    v += dpp_f<0xB1>(v); v += dpp_f<0x4E>(v); v += dpp_f<0x124>(v); v += dpp_f<0x128>(v);
    { auto rr = __builtin_amdgcn_permlane16_swap(__float_as_uint(v), __float_as_uint(v), false, false); v = __uint_as_float(rr[0]) + __uint_as_float(rr[1]); }
    { auto rr = __builtin_amdgcn_permlane32_swap(__float_as_uint(v), __float_as_uint(v), false, false); v = __uint_as_float(rr[0]) + __uint_as_float(rr[1]); }
    return v;
}
__device__ __forceinline__ float fast_exp2(float x) { return __builtin_amdgcn_exp2f(x); }
__device__ __forceinline__ float fast_rcp(float x) { return __builtin_amdgcn_rcpf(x); }
__device__ __forceinline__ float sigmoidf_(float x) { return fast_rcp(1.0f + fast_exp2(-LOG2E * x)); }
__device__ __forceinline__ float gelu_tanh(float x) { const float z = 0.7978845608028654f * (x + 0.044715f * x * x * x); return x * fast_rcp(1.0f + fast_exp2(-2.0f * LOG2E * z)); }
constexpr int WIDTAB_OFF = 159744 + 512;
__device__ __forceinline__ int otid() {
    const unsigned hw = (unsigned)__builtin_amdgcn_s_getreg((5 << 11) | (0 << 6) | 4) & 63u;
    int w = ((const LAS int*)(size_t)WIDTAB_OFF)[hw];
    int t = (w << 6) | (int)__builtin_amdgcn_mbcnt_hi(~0u, __builtin_amdgcn_mbcnt_lo(~0u, 0u));
    asm volatile("" : "+v"(t)); return t; }
__device__ __forceinline__ int crow(int r, int hi) { return (r & 3) + 8 * (r >> 2) + 4 * hi; }
__device__ __forceinline__ f32x16 mfma32(bf16x8 a, bf16x8 b, f32x16 c) { return __builtin_amdgcn_mfma_f32_32x32x16_bf16(a, b, c, 0, 0, 0); }

#define XB_TMO      128
#define XB_XCNT(j)  (256  + 64 * (j))
#define XB_XSUB(j)  (1280 + 64 * (j))
#define XB_XGEN(j)  (2304 + 64 * (j))
#define XB_TOP      3328
#define XB_TOPGEN   3392
#define XCD_BAR_WORDS 3456
#define XB_SPIN_CAP (1u << 18)

__device__ __forceinline__ unsigned xb_ld(unsigned* p)              { return __hip_atomic_load(p, __ATOMIC_RELAXED, __HIP_MEMORY_SCOPE_AGENT); }
__device__ __forceinline__ unsigned xb_add(unsigned* p, unsigned v) { return __hip_atomic_fetch_add(p, v, __ATOMIC_RELAXED, __HIP_MEMORY_SCOPE_AGENT); }
__device__ __forceinline__ unsigned xb_xcc_id() { return (unsigned)__builtin_amdgcn_s_getreg((3 << 11) | 20) & 0xFu; }
#define XB_SPIN(cond, bar) do { unsigned _sp = 0; while (cond) { __builtin_amdgcn_s_sleep(1); \
    if ((++_sp & 255u) == 0u) { if (xb_ld(&(bar)[XB_TMO])) break; if (_sp > XB_SPIN_CAP) { atomicAdd(&(bar)[XB_TMO], 1u); break; } } } } while (0)

struct XcdBarrier {
    unsigned* bar; unsigned x;
    volatile LAS unsigned* st;
};

__device__ __forceinline__ XcdBarrier xcd_barrier_post(unsigned* bar, volatile LAS unsigned* st) {
    XcdBarrier b; b.bar = bar; b.x = xb_xcc_id(); b.st = st;
    if (threadIdx.x == 0) (void)xb_add(&bar[XB_XCNT(b.x)], 1u);
    return b;
}
__device__ __forceinline__ void xcd_barrier_complete(unsigned* bar, unsigned x, unsigned& nloc, unsigned& nx) {
    const unsigned G = gridDim.x * gridDim.y * gridDim.z;
    unsigned sum, cnt, mine, sp = 0u;
    for (;;) {
        sum = 0u; cnt = 0u; mine = 0u;
#pragma unroll
        for (unsigned j = 0; j < 16; ++j) { const unsigned c = xb_ld(&bar[XB_XCNT(j)]); sum += c; cnt += (c > 0u) ? 1u : 0u; mine = (j == x) ? c : mine; }
        if (sum == G) break;
        __builtin_amdgcn_s_sleep(1);
        if ((++sp & 255u) == 0u) { if (xb_ld(&bar[XB_TMO])) break; if (sp > XB_SPIN_CAP) { atomicAdd(&bar[XB_TMO], 1u); break; } }
    }
    nloc = mine > 0u ? mine : 1u; nx = cnt > 0u ? cnt : 1u;
}

__device__ __forceinline__ void xcd_barrier(const XcdBarrier& b) {
    asm volatile("s_waitcnt vmcnt(0)" ::: "memory");
    __syncthreads();
    if (otid() == 0) {
        unsigned* bar = b.bar; unsigned bx_ = b.x; asm volatile("" : "+s"(bar), "+s"(bx_));
        __builtin_amdgcn_s_waitcnt(0);
        unsigned nloc = b.st[0], nx = b.st[1];
        if (nloc == 0u) { xcd_barrier_complete(bar, bx_, nloc, nx); b.st[0] = nloc; b.st[1] = nx; }
        const unsigned old = xb_add(&bar[XB_XSUB(bx_)], 1u);
        const unsigned gen = old / nloc;
        if (old + 1u == (gen + 1u) * nloc) {
            __builtin_amdgcn_fence(__ATOMIC_RELEASE, "agent");
            asm volatile("s_waitcnt vmcnt(0)" ::: "memory");
            const unsigned og = xb_add(&bar[XB_TOP], 1u);
            const unsigned tg = og / nx;
            if (og + 1u == (tg + 1u) * nx) xb_add(&bar[XB_TOPGEN], 1u);
            else XB_SPIN(xb_ld(&bar[XB_TOPGEN]) == tg, bar);
            __builtin_amdgcn_fence(__ATOMIC_ACQUIRE, "agent");
            xb_add(&bar[XB_XGEN(bx_)], 1u);
            asm volatile("s_waitcnt vmcnt(0)" ::: "memory");
        } else {
            XB_SPIN(xb_ld(&bar[XB_XGEN(bx_)]) == gen, bar);
            __builtin_amdgcn_fence(__ATOMIC_ACQUIRE, "agent");
            asm volatile("s_waitcnt vmcnt(0)" ::: "memory");
        }
    }
    __syncthreads();
}

namespace pg8 {
constexpr int BM = 256, BK = 64, HALF = 128, HTB = HALF * BK * 2  , STAGE_BYTES = 8 * HTB, NXCD = 8, WGM = 8;
__host__ __device__ __forceinline__ int lds_byte(int r, int c) { const int st = (r >> 4) * 2 + (c >> 5), rr = r & 15, cc = c & 31, ob = rr * 64 + cc * 2; return st * 1024 + (ob ^ (((ob >> 9) & 1) << 5)); }
__host__ __device__ __forceinline__ void stage_rc(int b, int& R, int& C) { const int st = b / 1024, sb = b % 1024, swz = sb ^ (((sb >> 9) & 1) << 5); R = (st >> 1) * 16 + swz / 64; C = (st & 1) * 32 + (swz % 64) / 2; }
__host__ __device__ __forceinline__ int perm32(int rho) { const int n = rho >> 4, i = rho & 15; return 8 * (i >> 2) + 4 * n + (i & 3); }

struct Unit { int arow, brow, pm, pn, e, nvalid; };

struct StaticOrder {
    int nM, nN, nwg, G, c;
    __device__ void init(int M, int N, int G_, int c_) { nM = M / BM; nN = N / BM; nwg = nM * nN; G = G_; c = c_; }
    __device__ bool next(int i, Unit& u) const {
        const long L = (long)i * G + c; if (L >= nwg) return false;
        int wgid = (int)L; { const int q = nwg / NXCD, r = nwg % NXCD, xcd = wgid % NXCD, off = wgid / NXCD; wgid = (xcd < r ? xcd * (q + 1) : r * (q + 1) + (xcd - r) * q) + off; }
        const int nig = WGM * nN, gid = wgid / nig, fm = gid * WGM, gsz = (nM - fm) < WGM ? (nM - fm) : WGM;
        u.pm = fm + ((wgid % nig) % gsz); u.pn = (wgid % nig) / gsz; u.arow = u.pm * BM; u.brow = u.pn * BM; u.e = 0; u.nvalid = BM; return true;
    }
    __device__ __forceinline__ unsigned goff(const Unit&, int) const { return 0u; }
};

template <class Epi, class Sched, bool GATHER>
__device__ __forceinline__ void gemm_phase(LAS unsigned char* lds, const bf16_t* Ag, const bf16_t* Btg, const int K_, const Sched& S, const Epi& E) {
    int K = K_; asm volatile("" : "+s"(K));
    const int tid = otid(), wid = __builtin_amdgcn_readfirstlane(tid >> 6), lane = tid & 63, wr = wid >> 2, wc = wid & 3, fr = lane & 15, fq = lane >> 4;
    const int nt = K / BK;
    unsigned voffA[2], voffB[2];
#pragma unroll
    for (int i = 0; i < 2; ++i) { int R, C; stage_rc(tid * 16 + i * 8192, R, C); const int Rb = 64 * (R >> 5) + perm32(R & 31);
        voffA[i] = (unsigned)(R * K + C) * 2u; voffB[i] = (unsigned)(Rb * K + C) * 2u; }
    const size_t kstep = (size_t)(BK * 2);
    const size_t hstep = (size_t)HALF * K * 2;
    const size_t hstepB = (size_t)32 * K * 2;
    const unsigned ldsw = (unsigned)wid * 1024u;
    const int aoff = lds_byte(wr * 64 + fr, fq * 8), boff = lds_byte(wc * 32 + fr, fq * 8);
    unsigned vAc[2][2], vAn[2][2];
#define PG8_SA(b, h) (((b) * 2 + (h)) * HTB)
#define PG8_SB(b, h) ((4 + (b) * 2 + (h)) * HTB)
#define PG8_STAGE(bufoff, gbase, voff) do { _Pragma("unroll") for (int _i = 0; _i < 2; ++_i) \
        __builtin_amdgcn_global_load_lds((const unsigned*)((const char*)(gbase) + (voff)[_i]), (LAS unsigned*)(lds + (bufoff) + ldsw + _i * 8192), 16, 0, 0); } while (0)
#define PG8_STAGE_A(bufoff, base, h, nx) do { if constexpr (GATHER) { _Pragma("unroll") for (int _i = 0; _i < 2; ++_i) \
        __builtin_amdgcn_global_load_lds((const unsigned*)((const char*)(base) + ((nx) ? vAn[h][_i] : vAc[h][_i])), (LAS unsigned*)(lds + (bufoff) + ldsw + _i * 8192), 16, 0, 0); } \
        else { PG8_STAGE(bufoff, (const char*)(base) + (h) * hstep, voffA); } } while (0)
#define PG8_LDA(dst, b, h) do { _Pragma("unroll") for (int m = 0; m < 4; ++m) _Pragma("unroll") for (int k = 0; k < 2; ++k) dst[m][k] = *(const LAS bf16x8*)(lds + PG8_SA(b, h) + aoff + m * 2048 + k * 1024); } while (0)
#define PG8_LDB(dst, b, h) do { _Pragma("unroll") for (int n = 0; n < 2; ++n) _Pragma("unroll") for (int k = 0; k < 2; ++k) dst[n][k] = *(const LAS bf16x8*)(lds + PG8_SB(b, h) + boff + n * 2048 + k * 1024); } while (0)
#define PG8_MMA(ai, bj, At, Bt) do { __builtin_amdgcn_s_setprio(1); _Pragma("unroll") for (int m = 0; m < 4; ++m) _Pragma("unroll") for (int n = 0; n < 2; ++n) _Pragma("unroll") for (int k = 0; k < 2; ++k) \
        acc[ai][bj][m][n] = __builtin_amdgcn_mfma_f32_16x16x32_bf16(Bt[n][k], At[m][k], acc[ai][bj][m][n], 0, 0, 0); __builtin_amdgcn_s_setprio(0); } while (0)
#define PG8_WAIT_V(n) asm volatile("s_waitcnt vmcnt(" #n ")" ::: "memory")
#define PG8_WAIT_L(n) asm volatile("s_waitcnt lgkmcnt(" #n ")" ::: "memory")
#define PG8_BAR __builtin_amdgcn_s_barrier()
#define PG8_SCHED __builtin_amdgcn_sched_barrier(0)
#define PG8_GOFF(u, v) do { if constexpr (GATHER) { const int _t = otid(); _Pragma("unroll") for (int _i = 0; _i < 2; ++_i) { int _R, _C; stage_rc(_t * 16 + _i * 8192, _R, _C); \
        _Pragma("unroll") for (int _h = 0; _h < 2; ++_h) v[_h][_i] = (S.goff(u, _h * HALF + _R) + (unsigned)_C) * 2u; } } } while (0)
    Unit cur, nxt; int ui = 0;
    if (!S.next(0, cur)) return;
    f32x4 acc[2][2][4][2];
#pragma unroll
    for (int a = 0; a < 2; ++a)
#pragma unroll
        for (int b = 0; b < 2; ++b)
#pragma unroll
            for (int m = 0; m < 4; ++m)
#pragma unroll
                for (int n = 0; n < 2; ++n) acc[a][b][m][n] = (f32x4){0.f, 0.f, 0.f, 0.f};
    bf16x8 At[4][2], B0[2][2], B1[2][2];
    PG8_GOFF(cur, vAc);
#pragma unroll
    for (int _h = 0; _h < 2; ++_h)
#pragma unroll
        for (int _i = 0; _i < 2; ++_i) vAn[_h][_i] = vAc[_h][_i];
    const char* cA = GATHER ? (const char*)Ag : (const char*)Ag + (size_t)cur.arow * K * 2; const char* cB = (const char*)Btg + (size_t)cur.brow * K * 2;
    PG8_STAGE(PG8_SB(0, 0), cB, voffB); PG8_STAGE(PG8_SB(0, 1), cB + hstepB, voffB); PG8_STAGE_A(PG8_SA(0, 0), cA, 0, false); PG8_STAGE_A(PG8_SA(0, 1), cA, 1, false);
    if (wr == 1) PG8_BAR;
    PG8_WAIT_V(2); PG8_BAR;
    PG8_STAGE(PG8_SB(1, 0), cB + kstep, voffB); PG8_STAGE_A(PG8_SA(1, 0), cA + kstep, 0, false); PG8_STAGE(PG8_SB(1, 1), cB + hstepB + kstep, voffB);
    PG8_WAIT_V(6); PG8_BAR;
    for (;;) {
        const bool has_next = S.next(ui + 1, nxt);
        if (has_next) { PG8_GOFF(nxt, vAn); }
        const char* nA = GATHER ? (const char*)Ag : (has_next ? (const char*)Ag + (size_t)nxt.arow * K * 2 : cA); const char* nB = has_next ? (const char*)Btg + (size_t)nxt.brow * K * 2 : cB;
#pragma nounroll
        for (int t = 0; t < nt; t += 2) {
            const bool last = (t == nt - 2);
            const char* a1 = cA + (size_t)(t + 1) * kstep;
            const char* a2 = last ? nA : cA + (size_t)(t + 2) * kstep; const char* b2 = last ? nB : cB + (size_t)(t + 2) * kstep;
            const char* a3 = a2 + kstep; const char* b3 = b2 + kstep;
            PG8_LDB(B0, 0, 0); PG8_LDB(B1, 0, 1); PG8_SCHED; PG8_LDA(At, 0, 0); PG8_STAGE_A(PG8_SA(1, 1), a1, 1, false);
            PG8_WAIT_V(8); PG8_WAIT_L(0); PG8_BAR; PG8_MMA(0, 0, At, B0); PG8_MMA(0, 1, At, B1); PG8_BAR; PG8_SCHED;
            PG8_LDA(At, 0, 1); PG8_STAGE(PG8_SB(0, 0), b2, voffB); PG8_STAGE(PG8_SB(0, 1), b2 + hstepB, voffB); PG8_STAGE_A(PG8_SA(0, 0), a2, 0, last);
            PG8_WAIT_V(8); PG8_WAIT_L(0); PG8_BAR; PG8_MMA(1, 0, At, B0); PG8_MMA(1, 1, At, B1); PG8_BAR; PG8_SCHED;
            PG8_LDB(B0, 1, 0); PG8_LDB(B1, 1, 1); PG8_SCHED; PG8_LDA(At, 1, 0); PG8_STAGE_A(PG8_SA(0, 1), a2, 1, last);
            PG8_WAIT_V(8); PG8_WAIT_L(0); PG8_BAR; PG8_MMA(0, 0, At, B0); PG8_MMA(0, 1, At, B1); PG8_BAR; PG8_SCHED;
            PG8_LDA(At, 1, 1); PG8_STAGE(PG8_SB(1, 0), b3, voffB); PG8_STAGE(PG8_SB(1, 1), b3 + hstepB, voffB); PG8_STAGE_A(PG8_SA(1, 0), a3, 0, last);
            PG8_WAIT_V(8); PG8_WAIT_L(0); PG8_BAR; PG8_MMA(1, 0, At, B0); PG8_MMA(1, 1, At, B1); PG8_BAR; PG8_SCHED;
        }
        if (wr == 0) PG8_BAR;
        E(acc, cur, wr, wc, fr, fq);
        if (!has_next) break;
#pragma unroll
        for (int a = 0; a < 2; ++a)
#pragma unroll
            for (int b = 0; b < 2; ++b)
#pragma unroll
                for (int m = 0; m < 4; ++m)
#pragma unroll
                    for (int n = 0; n < 2; ++n) acc[a][b][m][n] = (f32x4){0.f, 0.f, 0.f, 0.f};
        cur = nxt; cA = nA; cB = nB; ++ui;
#pragma unroll
        for (int _h = 0; _h < 2; ++_h)
#pragma unroll
            for (int _i = 0; _i < 2; ++_i) vAc[_h][_i] = vAn[_h][_i];
        if (wr == 1) PG8_BAR;
    }
    PG8_WAIT_V(0);
    PG8_BAR;
#undef PG8_SA
#undef PG8_SB
#undef PG8_STAGE
#undef PG8_STAGE_A
#undef PG8_LDA
#undef PG8_LDB
#undef PG8_MMA
#undef PG8_WAIT_V
#undef PG8_WAIT_L
#undef PG8_BAR
#undef PG8_SCHED
#undef PG8_GOFF
}
}

using pg8::Unit;
__device__ __forceinline__ void st16(bf16_t* p, f32x4 v0, f32x4 v1) { u32x4 w; w.x = cvt_pk_bf16(v0[0], v0[1]); w.y = cvt_pk_bf16(v0[2], v0[3]); w.z = cvt_pk_bf16(v1[0], v1[1]); w.w = cvt_pk_bf16(v1[2], v1[3]); *(u32x4*)p = w; }
__device__ __forceinline__ void st8(bf16_t* p, f32x4 v) { u32x2 w; w.x = cvt_pk_bf16(v[0], v[1]); w.y = cvt_pk_bf16(v[2], v[3]); *(u32x2*)p = w; }

__device__ __forceinline__ unsigned ror8_u(unsigned x) { return (unsigned)__builtin_amdgcn_update_dpp(0, (int)x, 0x128, 0xF, 0xF, true); }
__device__ __forceinline__ u32x4 pk16(f32x4 v0, f32x4 v1) { u32x4 w; w.x = cvt_pk_bf16(v0[0], v0[1]); w.y = cvt_pk_bf16(v0[2], v0[3]); w.z = cvt_pk_bf16(v1[0], v1[1]); w.w = cvt_pk_bf16(v1[2], v1[3]); return w; }
template <bool PRED> __device__ __forceinline__ void st_pair(bf16_t* line, const bool ok, const int fr, const int c0, const int c1, const u32x4 d0, const u32x4 d1) {
    const unsigned long long p = (unsigned long long)line;
    const unsigned plo = ror8_u((unsigned)p), phi = ror8_u((unsigned)(p >> 32));
    const unsigned long long pp = ((unsigned long long)phi << 32) | plo;
    const bool okp = PRED ? (ror8_u(ok ? 1u : 0u) != 0u) : true;
    u32x4 x; x.x = ror8_u(d1.x); x.y = ror8_u(d1.y); x.z = ror8_u(d1.z); x.w = ror8_u(d1.w);
    const bool lo = fr < 8;
    const unsigned long long own = p + (unsigned)c0 * 16u, oth = pp + 64u + (unsigned)c1 * 16u;
    { const unsigned long long a = lo ? own : oth; const u32x4 d = lo ? d0 : x; if (!PRED || (lo ? ok : okp)) *(GAS u32x4*)a = d; }
    { const unsigned long long a = lo ? oth : own; const u32x4 d = lo ? x : d0; if (!PRED || (lo ? okp : ok)) *(GAS u32x4*)a = d; }
}
__device__ __forceinline__ u32x4 rot_piece(const f32x4 v0, const f32x4 v1) {
    const unsigned a0 = cvt_pk_bf16(v0[0], v0[1]), a1 = cvt_pk_bf16(v0[2], v0[3]), c0 = cvt_pk_bf16(v1[0], v1[1]), c1 = cvt_pk_bf16(v1[2], v1[3]);
    const auto s0 = __builtin_amdgcn_permlane16_swap(a0, c0, false, false), s1 = __builtin_amdgcn_permlane16_swap(a1, c1, false, false);
    return (u32x4){s0[0], s1[0], s0[1], s1[1]}; }
__device__ __forceinline__ int rot_chunk(const int fq) { return ((fq & 1) << 1) | (fq >> 1); }
__device__ __forceinline__ void rot4(f32x4& x1, f32x4& x2, const LAS float* rot, int row, int fq) {
    const int t = row & (SEQ - 1), pos = (fq < 2) ? (t >> 6) : (t & 63);
    const f32x4 c = *(const LAS f32x4*)(rot + pos * 8 + 4 * (fq & 1)), s = *(const LAS f32x4*)(rot + 512 + pos * 8 + 4 * (fq & 1));
    const f32x4 a = x1 * c - x2 * s, b = x1 * s + x2 * c; x1 = a; x2 = b;
}

__device__ __forceinline__ float grp_normsq_bound(float v) {
    v = fmaxf(v, dpp_f<0x128>(v)); v = fmaxf(v, dpp_f<0x124>(v)); v = fmaxf(v, dpp_f<0x122>(v)); v = fmaxf(v, dpp_f<0x121>(v));
    { auto rr = __builtin_amdgcn_permlane16_swap(__float_as_uint(v), __float_as_uint(v), false, false); v = __uint_as_float(rr[0]) + __uint_as_float(rr[1]); }
    { auto rr = __builtin_amdgcn_permlane32_swap(__float_as_uint(v), __float_as_uint(v), false, false); v = __uint_as_float(rr[0]) + __uint_as_float(rr[1]); }
    return v; }
__device__ __forceinline__ float ssq8(const f32x4 a, const f32x4 b) { return (a[0] * a[0] + a[1] * a[1]) + (a[2] * a[2] + a[3] * a[3]) + (b[0] * b[0] + b[1] * b[1]) + (b[2] * b[2] + b[3] * b[3]); }
struct EpiInProj {
    bf16_t *XL, *GG, *QD, *KD, *VD, *CQ, *CKV, *KR; float* ssq; const LAS float* rot; float* kmx;
    __device__ __forceinline__ void operator()(const f32x4 (&acc)[2][2][4][2], const Unit& u, int wr, int wc, int fr, int fq) const {
        const int g = u.pn * 8 + wc * 2;
        if (g >= 65) return;
        bf16_t* dst; int pitch, gl, kind = 0, sq = -1; float sc = 1.0f;
        if (g < 8) { dst = XL; pitch = 256; gl = g; }
        else if (g < 16) { dst = GG; pitch = 256; gl = g - 8; kind = 1; }
        else if (g < 28) { dst = QD; pitch = 384; gl = g - 16; kind = 2; sc = DA_QSCALE; }
        else if (g < 40) { dst = KD; pitch = 384; gl = g - 28; kind = 2; }
        else if (g < 52) { dst = VD; pitch = 384; gl = g - 40; }
        else if (g < 60) { dst = CQ; pitch = 256; gl = g - 52; sq = 0; }
        else if (g < 64) { dst = CKV; pitch = 128; gl = g - 60; sq = 1; }
        else { dst = KR; pitch = 32; gl = 0; kind = 2; }
        const bool keyg = (g >= 28 && g < 40) || g == 64;
#pragma unroll
        for (int ai = 0; ai < 2; ++ai) {
            float kq0 = 0.f, kq1 = 0.f;
#pragma unroll
            for (int m = 0; m < 4; ++m) {
                const int row = u.pm * 256 + ai * 128 + wr * 64 + m * 16 + fr;
                f32x4 a0 = acc[ai][0][m][0], a1 = acc[ai][0][m][1], b0 = acc[ai][1][m][0], b1 = acc[ai][1][m][1];
                bf16_t* line = dst + (size_t)row * pitch + gl * 32;
                if (g == 64) {
                    if (row < NLAT) rot4(a0, a1, rot, row, fq);
                    kq0 = fmaxf(kq0, ssq8(a0, a1));
                    *(u32x4*)(line + rot_chunk(fq) * 8) = rot_piece(a0, a1);
                } else if (kind == 2) {
                    if (row < NLAT) { rot4(a0, a1, rot, row, fq); rot4(b0, b1, rot, row, fq); }
                    a0 = a0 * sc; a1 = a1 * sc; b0 = b0 * sc; b1 = b1 * sc;
                    if (keyg) { kq0 = fmaxf(kq0, ssq8(a0, a1)); kq1 = fmaxf(kq1, ssq8(b0, b1)); }
                    st_pair<false>(line, true, fr, rot_chunk(fq), rot_chunk(fq), rot_piece(a0, a1), rot_piece(b0, b1));
                } else {
                    if (kind == 1) {
#pragma unroll
                        for (int j = 0; j < 4; ++j) { a0[j] = gelu_tanh(a0[j]); a1[j] = gelu_tanh(a1[j]); b0[j] = gelu_tanh(b0[j]); b1[j] = gelu_tanh(b1[j]); }
                    }
                    if (sq >= 0) {
                        float s0 = (a0[0] * a0[0] + a0[1] * a0[1]) + (a0[2] * a0[2] + a0[3] * a0[3]) + (a1[0] * a1[0] + a1[1] * a1[1]) + (a1[2] * a1[2] + a1[3] * a1[3]);
                        float s1 = (b0[0] * b0[0] + b0[1] * b0[1]) + (b0[2] * b0[2] + b0[3] * b0[3]) + (b1[0] * b1[0] + b1[1] * b1[1]) + (b1[2] * b1[2] + b1[3] * b1[3]);
                        { auto r0 = __builtin_amdgcn_permlane16_swap(__float_as_uint(s0), __float_as_uint(s0), false, false); s0 = __uint_as_float(r0[0]) + __uint_as_float(r0[1]);
                          auto r1 = __builtin_amdgcn_permlane16_swap(__float_as_uint(s1), __float_as_uint(s1), false, false); s1 = __uint_as_float(r1[0]) + __uint_as_float(r1[1]);
                          auto r2 = __builtin_amdgcn_permlane32_swap(__float_as_uint(s0), __float_as_uint(s0), false, false); s0 = __uint_as_float(r2[0]) + __uint_as_float(r2[1]);
                          auto r3 = __builtin_amdgcn_permlane32_swap(__float_as_uint(s1), __float_as_uint(s1), false, false); s1 = __uint_as_float(r3[0]) + __uint_as_float(r3[1]); }
                        if (fq == 0) *(f32x2*)(ssq + (size_t)row * 12 + (g - 52)) = (f32x2){s0, s1};
                    }
                    st_pair<false>(line, true, fr, fq, fq, pk16(a0, a1), pk16(b0, b1));
                }
            }
            if (keyg) {
                const float b0_ = grp_normsq_bound(kq0), b1_ = grp_normsq_bound(kq1);
                float* kp_ = kmx + (size_t)((u.pm * 256 + ai * 128 + wr * 64) >> 6) * 16;
                if (fr == 0 && fq == 0) { if (g == 64) kp_[12] = b0_; else { kp_[g - 28] = b0_; kp_[g - 27] = b1_; } }
            }
        }
    }
};

struct EpiExpQ {
    bf16_t* QM; const float* ssq; const LAS float* rot;
    __device__ __forceinline__ void operator()(const f32x4 (&acc)[2][2][4][2], const Unit& u, int wr, int wc, int fr, int fq) const {
        const int g = u.pn * 8 + wc * 2;
        if (g >= 18) return;
        const bool r0 = (g % 3) == 2, r1 = ((g + 1) % 3) == 2;
#pragma unroll
        for (int ai = 0; ai < 2; ++ai)
#pragma unroll
            for (int m = 0; m < 4; ++m) {
                const int row = u.pm * 256 + ai * 128 + wr * 64 + m * 16 + fr;
                const f32x4 pa_ = *(const f32x4*)(ssq + (size_t)row * 12), pb_ = *(const f32x4*)(ssq + (size_t)row * 12 + 4);
                const float rs = rsqrtf((((pa_[0] + pa_[1]) + (pa_[2] + pa_[3])) + ((pb_[0] + pb_[1]) + (pb_[2] + pb_[3]))) * (1.0f / 256.0f) + RMS_EPS) * MLA_QSCALE;
                f32x4 a0 = acc[ai][0][m][0] * rs, a1 = acc[ai][0][m][1] * rs, b0 = acc[ai][1][m][0] * rs, b1 = acc[ai][1][m][1] * rs;
                if (r0 && row < NLAT) rot4(a0, a1, rot, row, fq);
                if (r1 && row < NLAT) rot4(b0, b1, rot, row, fq);
                const u32x4 d0 = r0 ? rot_piece(a0, a1) : pk16(a0, a1), d1 = r1 ? rot_piece(b0, b1) : pk16(b0, b1);
                st_pair<false>(QM + (size_t)row * 576 + g * 32, true, fr, r0 ? rot_chunk(fq) : fq, r1 ? rot_chunk(fq) : fq, d0, d1);
            }
    }
};
struct EpiExpKV {
    bf16_t *KN, *VM; const float* ssq; float* kmn;
    __device__ __forceinline__ void operator()(const f32x4 (&acc)[2][2][4][2], const Unit& u, int wr, int wc, int fr, int fq) const {
        const int g = u.pn * 8 + wc * 2;
        const int head = g >> 2, part = g & 3;
        bf16_t* base = KN + (size_t)(part >> 1) * (size_t)(VM - KN) + head * 64;
#pragma unroll
        for (int ai = 0; ai < 2; ++ai) {
            float kq = 0.f;
#pragma unroll
            for (int m = 0; m < 4; ++m) {
                const int row = u.pm * 256 + ai * 128 + wr * 64 + m * 16 + fr;
                const f32x4 pc_ = *(const f32x4*)(ssq + (size_t)row * 12 + 8);
                const float rs = rsqrtf(((pc_[0] + pc_[1]) + (pc_[2] + pc_[3])) * (1.0f / 128.0f) + RMS_EPS);
                const f32x4 a0 = acc[ai][0][m][0] * rs, a1 = acc[ai][0][m][1] * rs, b0 = acc[ai][1][m][0] * rs, b1 = acc[ai][1][m][1] * rs;
                if (part == 0) kq = fmaxf(kq, ssq8(a0, a1) + ssq8(b0, b1));
                st_pair<false>(base + (size_t)row * 384, true, fr, fq, fq, pk16(a0, a1), pk16(b0, b1));
            }
            if (part == 0) { const float b_ = grp_normsq_bound(kq); if (fr == 0 && fq == 0) kmn[(size_t)((u.pm * 256 + ai * 128 + wr * 64) >> 6) * 8 + head] = b_; }
        }
    }
};
struct EpiPlain {
    bf16_t* O; int ldc;
    __device__ __forceinline__ void operator()(const f32x4 (&acc)[2][2][4][2], const Unit& u, int wr, int wc, int fr, int fq) const {
#pragma unroll
        for (int ai = 0; ai < 2; ++ai)
#pragma unroll
            for (int m = 0; m < 4; ++m) {
                bf16_t* line = O + (size_t)(u.pm * 256 + ai * 128 + wr * 64 + m * 16 + fr) * ldc + u.pn * 256 + wc * 64;
                st_pair<false>(line, true, fr, fq, fq, pk16(acc[ai][0][m][0], acc[ai][0][m][1]), pk16(acc[ai][1][m][0], acc[ai][1][m][1]));
            }
    }
};

struct MoeSched {
    const LAS int* tb;
    const unsigned* list;
    int G, c, ncol;
    __device__ bool next(int i, Unit& u) const {
        const int L = i * G + c, T = tb[33 + 16];
        if (L >= T * ncol) return false;
        const int tl = L / ncol; u.pn = L % ncol;
        int e = 0;
#pragma unroll
        for (int k = 1; k < 16; ++k) e += (tl >= tb[33 + k]) ? 1 : 0;
        e = __builtin_amdgcn_readfirstlane(e);
        u.e = e; u.pm = __builtin_amdgcn_readfirstlane(tl - tb[33 + e]); int nv = __builtin_amdgcn_readfirstlane(tb[e]) - u.pm * 256; if (nv > 256) nv = 256; u.nvalid = nv;
        u.arow = __builtin_amdgcn_readfirstlane(tb[16 + e]) + u.pm * 256; u.brow = (e * ncol + u.pn) * 256;
        return true;
    }
    __device__ __forceinline__ unsigned goff(const Unit& u, int r) const {
        const int rc = r < u.nvalid ? r : u.nvalid - 1; const unsigned ent = list[((size_t)u.e * NTOK + u.pm * 256 + rc) * 2];
        return (ent >> 1) * 1024u;
    }
};
struct EpiMoeUp {
    bf16_t* H;
    __device__ __forceinline__ void operator()(const f32x4 (&acc)[2][2][4][2], const Unit& u, int wr, int wc, int fr, int fq) const {
#pragma unroll
        for (int ai = 0; ai < 2; ++ai)
#pragma unroll
            for (int m = 0; m < 4; ++m) {
                const int r = ai * 128 + wr * 64 + m * 16 + fr;
                f32x4 h0, h1;
#pragma unroll
                for (int j = 0; j < 4; ++j) { h0[j] = acc[ai][0][m][0][j] * sigmoidf_(acc[ai][0][m][0][j]) * acc[ai][0][m][1][j]; h1[j] = acc[ai][1][m][0][j] * sigmoidf_(acc[ai][1][m][0][j]) * acc[ai][1][m][1][j]; }
                const u32x4 piece = rot_piece(h0, h1);
                if (r < u.nvalid) *(u32x4*)(H + (size_t)(u.arow + r) * 256 + (u.pn & 1) * 128 + wc * 32 + rot_chunk(fq) * 8) = piece;
            }
    }
};
struct EpiMoeDown {
    bf16_t *F0, *F1; const unsigned* list; const float* route;
    __device__ __forceinline__ void operator()(const f32x4 (&acc)[2][2][4][2], const Unit& u, int wr, int wc, int fr, int fq) const {
        const u32x2* lp = (const u32x2*)list + (size_t)u.e * NTOK + u.pm * 256;
#pragma unroll
        for (int ai = 0; ai < 2; ++ai) {
            u32x2 ew[4];
#pragma unroll
            for (int m = 0; m < 4; ++m) { const int r = ai * 128 + wr * 64 + m * 16 + fr; const int rc = r < u.nvalid ? r : u.nvalid - 1; ew[m] = lp[rc]; }
#pragma unroll
            for (int m = 0; m < 4; ++m) {
                const int r = ai * 128 + wr * 64 + m * 16 + fr;
                const unsigned tok = ew[m].x >> 1, kk = ew[m].x & 1u; const float ww = __uint_as_float(ew[m].y);
                bf16_t* line = F0 + (size_t)kk * (size_t)(F1 - F0) + (size_t)tok * 1024 + u.pn * 256 + wc * 64;
                st_pair<true>(line, r < u.nvalid, fr, fq, fq, pk16(acc[ai][0][m][0] * ww, acc[ai][0][m][1] * ww), pk16(acc[ai][1][m][0] * ww, acc[ai][1][m][1] * ww));
            }
            asm volatile("" ::: "memory");
        }
    }
};


__device__ __forceinline__ unsigned cvtpk_s(float lo, float hi) { f32x2_t v = {lo, hi}; bf16x2_t b = __builtin_convertvector(v, bf16x2_t); return __builtin_bit_cast(unsigned, b); }
__device__ __forceinline__ float max3f(float a, float b, float c) { float r; asm("v_max3_f32 %0, %1, %2, %3" : "=v"(r) : "v"(a), "v"(b), "v"(c)); return r; }
__device__ __forceinline__ float max2f(float a, float b) { float r; asm("v_max_f32_e32 %0, %1, %2" : "=v"(r) : "v"(a), "v"(b)); return r; }
__device__ __forceinline__ float mx2(float a, float b) { return __builtin_elementwise_maximum(a, b); }
__device__ __forceinline__ float rowmax32_fast(f32x16& p0, f32x16& p1) {
    float a = mx2(mx2(p0[0], p0[1]), p1[0]), b = mx2(mx2(p0[2], p0[3]), p1[1]); a = mx2(mx2(a, p1[2]), p1[3]);
#pragma unroll
    for (int r = 4; r < 16; r += 4) { a = mx2(mx2(a, p0[r]), p0[r + 1]); b = mx2(mx2(b, p0[r + 2]), p0[r + 3]); a = mx2(mx2(a, p1[r]), p1[r + 1]); b = mx2(mx2(b, p1[r + 2]), p1[r + 3]); }
    const float m = mx2(a, b);
    auto rr = __builtin_amdgcn_permlane32_swap(__float_as_uint(m), __float_as_uint(m), false, false);
    return mx2(__uint_as_float(rr[0]), __uint_as_float(rr[1]));
}
__device__ __forceinline__ bf16x8 pack8(const f32x16& p, const int b) { u32x4 w; w.x = cvtpk_s(p[b], p[b + 1]); w.y = cvtpk_s(p[b + 2], p[b + 3]); w.z = cvtpk_s(p[b + 4], p[b + 5]); w.w = cvtpk_s(p[b + 6], p[b + 7]); return __builtin_bit_cast(bf16x8, w); }
#define VTR_RD(dst, addr, off) asm volatile("ds_read_b64_tr_b16 %0, %1 offset:%c2" : "=&v"(dst) : "v"(addr), "i"(off) : "memory")
#define PV_BLOCK(vb_, db_, BODY) do { s16x4 lo_[4], hi_[4]; \
    _Pragma("unroll") for (int ks = 0; ks < 4; ++ks) { VTR_RD(lo_[ks], vb_, (db_) * 4096 + ks * 1024); VTR_RD(hi_[ks], vb_, (db_) * 4096 + ks * 1024 + 512); } \
    asm volatile("s_waitcnt lgkmcnt(0)" ::: "memory"); __builtin_amdgcn_sched_barrier(0); \
    _Pragma("unroll") for (int ks = 0; ks < 4; ++ks) { const bf16x8 vf = (bf16x8){lo_[ks][0], lo_[ks][1], lo_[ks][2], lo_[ks][3], hi_[ks][0], hi_[ks][1], hi_[ks][2], hi_[ks][3]}; BODY; } } while (0)
namespace attd {
typedef short v4i16_t __attribute__((ext_vector_type(4)));
constexpr float THR = 6.0f;
constexpr float LIM = 64.0f;
__device__ __forceinline__ float rowmax32(f32x16& p0, f32x16& p1) { return rowmax32_fast(p0, p1); }
struct Sm { float mhat, l; };
__device__ __forceinline__ void softmax_tile(f32x16& p0, f32x16& p1, Sm& st, f32x16 (&o)[2], const bool first, LAS float* wsf, const int r32, const int hi, bf16x8 (&pa)[4], f32x16& negm, const bool slow) {
    float rm = 0.f;
    if (slow) rm = rowmax32(p0, p1);
    if (slow && (first || __any(rm > THR))) {
        const float dl = first ? rm : fmaxf(rm, 0.f);
        st.mhat += dl;
#pragma unroll
        for (int r = 0; r < 16; ++r) { p0[r] -= dl; p1[r] -= dl; negm[r] = -st.mhat; }
        const float f = fminf(fast_exp2(-dl), 3.0e38f); st.l *= f;
        if (hi == 0) wsf[r32] = f;
        LDS_WAIT();
#pragma unroll
        for (int r = 0; r < 16; ++r) { const float fr_ = wsf[crow(r, hi)]; o[0][r] *= fr_; o[1][r] *= fr_; }
    }
    float s = 0.f;
#pragma unroll
    for (int r = 0; r < 16; ++r) { p0[r] = fast_exp2(p0[r]); p1[r] = fast_exp2(p1[r]); s = (s + p0[r]) + p1[r]; }
    st.l += s;
    pa[0] = pack8(p0, 0); pa[1] = pack8(p0, 8); pa[2] = pack8(p1, 0); pa[3] = pack8(p1, 8);
}
__device__ __forceinline__ void glds16(const bf16_t* src, LAS unsigned char* dst) { __builtin_amdgcn_global_load_lds((const unsigned*)src, (LAS unsigned*)dst, 16, 0, 0); }

#define KRD16(dst, addr, off) asm volatile("ds_read_b128 %0, %1 offset:%c2" : "=&v"(dst) : "v"(addr), "i"(off) : "memory")
#define MFMA_C(D, A, B, C) asm("v_mfma_f32_32x32x16_bf16 %0, %1, %2, %3" : "=&v"(D) : "v"(A), "v"(B), "v"(C))
struct Tens {
    const bf16_t* Q; int qpitch, qcol;
    const bf16_t* K; const bf16_t* KR; const bf16_t* V; int kvcol;
    bf16_t* O; int ocol;
    float lam, onem; const float* dn;
    const float* kmx;
};
template <int MODE>
__device__ __forceinline__ void attn_unit(LAS unsigned char* lds, const Tens& T, const int b, const bool ctxq, const int qb) {
    constexpr int NCH = MODE ? 12 : 8, KSLOT = NCH * 1024, SLOT = KSLOT + 8192, NSLOT = 6;
    constexpr int WS_OFF = NSLOT * SLOT, OST_OFF = 0, QS_OFF = WS_OFF + 8 * 512;
    static_assert((MODE == 1 ? WS_OFF + 8 * 512 : QS_OFF + 8 * 4096) <= RING_BYTES && 8 * 8192 <= WS_OFF, "attention LDS");
    const int tid = otid(), lane = tid & 63, r32 = lane & 31, hi = lane >> 5, wid = __builtin_amdgcn_readfirstlane(tid >> 6);
    const int NT = ctxq ? 4 : 68;
    const int krow_ctx = NLAT + b * CTXL, krow_lat = b * SEQ;
    const int qrow0 = (ctxq ? krow_ctx : krow_lat + qb * 256) + wid * 32;
    LAS float* wsf = (LAS float*)(lds + WS_OFF + wid * 512);
    LAS float* stg = (LAS float*)(lds + OST_OFF + wid * 8192);
    static_assert(MODE == 0, "attd: differential attention only");
    const int kswz = (4 * (wid & 1) + (lane >> 4)) & 7;
#define ATT_ISSUE(t_) do { const int kr_ = ((t_) < 4) ? krow_ctx + 64 * (t_) : krow_lat + 64 * ((t_) - 4); const int so_ = ((t_) % NSLOT) * SLOT; \
        glds16(T.K + (size_t)(kr_ + 8 * wid + (lane >> 3)) * 384 + T.kvcol + (((lane & 7) ^ kswz) << 3), lds + so_ + wid * 1024); \
        glds16(T.V + (size_t)(kr_ + 16 * (wid & 3) + (lane >> 2)) * 384 + T.kvcol + (wid >> 2) * 32 + (lane & 3) * 8, lds + so_ + KSLOT + wid * 1024); } while (0)
    constexpr int NQ = MODE ? 6 : 4;
    bf16x8 qr[NQ];
    float qn1 = 0.f, qn2 = 0.f;
    { const bf16_t* qp = T.Q + (size_t)(qrow0 + r32) * T.qpitch + T.qcol + hi * 8;
#pragma unroll
      for (int d0 = 0; d0 < NQ; ++d0) { const bf16x8 q = *(const bf16x8*)(qp + d0 * 16); if (MODE == 1) qr[d0] = q; else *(LAS bf16x8*)(lds + QS_OFF + wid * 4096 + d0 * 1024 + lane * 16) = q;
          float s_ = 0.f;
#pragma unroll
          for (int e = 0; e < 8; ++e) { const float f_ = bf2f((unsigned short)q[e]); s_ += f_ * f_; }
          if (d0 < 2) qn1 += s_; else qn2 += s_; }
      qn1 += __shfl_xor(qn1, 32); qn2 += __shfl_xor(qn2, 32);
      qn1 = __builtin_amdgcn_sqrtf(qn1) * 1.02f; qn2 = __builtin_amdgcn_sqrtf(qn2) * 1.02f; }
    constexpr int KT_OFF = QS_OFF + 8 * 4096;
    static_assert(KT_OFF + 68 * 8 <= RING_BYTES, "attention LDS");
    if (tid < NT) { const int ti = (tid < 4) ? (NLAT >> 6) + b * 4 + tid : b * 64 + (tid - 4); const float* kp_ = T.kmx + (size_t)ti * 16 + (T.kvcol >> 6) * 2;
        *(LAS f32x2*)(lds + KT_OFF + tid * 8) = (f32x2){__builtin_amdgcn_sqrtf(kp_[0]) * 1.02f, __builtin_amdgcn_sqrtf(kp_[1]) * 1.02f}; }
    const LAS unsigned char* ql = lds + QS_OFF + wid * 4096 + lane * 16;
    ATT_ISSUE(0); ATT_ISSUE(1); ATT_ISSUE(2); ATT_ISSUE(3);
    Sm st1{0.f, 0.f}, st2{0.f, 0.f};
    f32x16 o1[2], o2[2];
#pragma unroll
    for (int r = 0; r < 16; ++r) { o1[0][r] = 0.f; o1[1][r] = 0.f; o2[0][r] = 0.f; o2[1][r] = 0.f; }
    const int vlane = ((lane >> 4) & 1) * 32 + (lane & 3) * 8 + (4 * hi + ((lane & 15) >> 2)) * 64;
    f32x16 negm1, negm2;
#pragma unroll
    for (int r = 0; r < 16; ++r) { negm1[r] = 0.f; negm2[r] = 0.f; }
    for (int tp = 0; tp < NT; tp += 2) {
        if (tp + 2 < NT) { if (MODE == 1 && wid < 4) asm volatile("s_waitcnt vmcnt(6)" ::: "memory"); else asm volatile("s_waitcnt vmcnt(4)" ::: "memory"); }
        else asm volatile("s_waitcnt vmcnt(0)" ::: "memory");
        LDS_WAIT(); __builtin_amdgcn_s_barrier(); asm volatile("" ::: "memory");
        if (tp + 4 < NT) { ATT_ISSUE(tp + 4); ATT_ISSUE(tp + 5); }
#pragma unroll 1
      for (int t = tp; t < tp + 2; ++t) {
        const int s_cur = (t % NSLOT) * SLOT;
        const unsigned ka0 = (unsigned)(size_t)lds + s_cur + r32 * 128 + (((((r32 >> 1) & 7) ^ hi)) << 4);
        const unsigned vb = (unsigned)(size_t)(lds + s_cur + KSLOT + vlane);
        bf16x8 pa1[4], pa2[4];
        {
            f32x16 p10, p11, p20, p21; s16x4 vlo[4], vhi[4];
            f32x2 kb2;
            asm volatile("ds_read_b64 %0, %1" : "=&v"(kb2) : "v"((unsigned)(size_t)(lds + KT_OFF) + (unsigned)t * 8u) : "memory");
            { bf16x8 kf[8], qf[4]; const unsigned qb_ = (unsigned)(size_t)ql;
#pragma unroll
              for (int d0 = 0; d0 < 4; ++d0) { const unsigned kb_ = ka0 ^ (d0 << 5); KRD16(kf[2 * d0], kb_, 0); KRD16(kf[2 * d0 + 1], kb_, 4096); KRD16(qf[d0], qb_, d0 * 1024); }
              asm volatile("s_waitcnt lgkmcnt(6)" ::: "memory"); __builtin_amdgcn_sched_barrier(0);
              MFMA_C(p10, kf[0], qf[0], negm1); MFMA_C(p11, kf[1], qf[0], negm1); p10 = mfma32(kf[2], qf[1], p10); p11 = mfma32(kf[3], qf[1], p11);
              __builtin_amdgcn_sched_barrier(0);
#pragma unroll
              for (int ks = 0; ks < 4; ++ks) { VTR_RD(vlo[ks], vb, ks * 1024); VTR_RD(vhi[ks], vb, ks * 1024 + 512); }
              asm volatile("s_waitcnt lgkmcnt(8)" ::: "memory"); __builtin_amdgcn_sched_barrier(0);
              MFMA_C(p20, kf[4], qf[2], negm2); MFMA_C(p21, kf[5], qf[2], negm2); p20 = mfma32(kf[6], qf[3], p20); p21 = mfma32(kf[7], qf[3], p21);
              asm volatile("s_waitcnt lgkmcnt(0)" ::: "memory"); __builtin_amdgcn_sched_barrier(0); }
            const bool slow1 = (t == 0) || __any(qn1 * kb2[0] - st1.mhat > LIM), slow2 = (t == 0) || __any(qn2 * kb2[1] - st2.mhat > LIM);
            softmax_tile(p10, p11, st1, o1, t == 0, wsf, r32, hi, pa1, negm1, slow1);
            softmax_tile(p20, p21, st2, o2, t == 0, wsf + 32, r32, hi, pa2, negm2, slow2);
            __builtin_amdgcn_sched_barrier(0);
            { s16x4 wlo[4], whi[4];
#pragma unroll
              for (int ks = 0; ks < 4; ++ks) { VTR_RD(wlo[ks], vb, 4096 + ks * 1024); VTR_RD(whi[ks], vb, 4096 + ks * 1024 + 512); }
#pragma unroll
              for (int ks = 0; ks < 4; ++ks) { const bf16x8 vf = (bf16x8){vlo[ks][0], vlo[ks][1], vlo[ks][2], vlo[ks][3], vhi[ks][0], vhi[ks][1], vhi[ks][2], vhi[ks][3]};
                  o1[0] = mfma32(pa1[ks], vf, o1[0]); o2[0] = mfma32(pa2[ks], vf, o2[0]); }
              asm volatile("s_waitcnt lgkmcnt(0)" ::: "memory"); __builtin_amdgcn_sched_barrier(0);
#pragma unroll
              for (int ks = 0; ks < 4; ++ks) { const bf16x8 vf = (bf16x8){wlo[ks][0], wlo[ks][1], wlo[ks][2], wlo[ks][3], whi[ks][0], whi[ks][1], whi[ks][2], whi[ks][3]};
                  o1[1] = mfma32(pa1[ks], vf, o1[1]); o2[1] = mfma32(pa2[ks], vf, o2[1]); } }
        }
      }
    }
#undef ATT_ISSUE
    LDS_WAIT(); __builtin_amdgcn_s_barrier(); asm volatile("" ::: "memory");
    { const float l1 = st1.l + __shfl_xor(st1.l, 32), l2 = st2.l + __shfl_xor(st2.l, 32);
      if (hi == 0) { wsf[64 + r32] = l1; if (MODE == 0) wsf[96 + r32] = l2; }
      LDS_WAIT();
#pragma unroll
      for (int r = 0; r < 16; ++r) { const int q = crow(r, hi); const float rl1 = fast_rcp(wsf[64 + q]);
          if (MODE == 1) { stg[q * 64 + r32] = o1[0][r] * rl1; stg[q * 64 + 32 + r32] = o1[1][r] * rl1; }
          else { const float rl2 = T.lam * fast_rcp(wsf[96 + q]);
              stg[q * 64 + r32] = o1[0][r] * rl1 - o2[0][r] * rl2; stg[q * 64 + 32 + r32] = o1[1][r] * rl1 - o2[1][r] * rl2; } }
      LDS_WAIT();
      const int ch = lane & 7;
      f32x4 g0 = (f32x4){1.f, 1.f, 1.f, 1.f}, g1 = g0;
      if (MODE == 0) { g0 = *(const f32x4*)(T.dn + ch * 8) * T.onem; g1 = *(const f32x4*)(T.dn + ch * 8 + 4) * T.onem; }
#pragma unroll
      for (int i = 0; i < 4; ++i) { const int row = i * 8 + (lane >> 3);
          f32x4 a = *(const LAS f32x4*)(stg + row * 64 + ch * 8), c = *(const LAS f32x4*)(stg + row * 64 + ch * 8 + 4);
          if (MODE == 0) { float ss = (a[0] * a[0] + a[1] * a[1]) + (a[2] * a[2] + a[3] * a[3]) + (c[0] * c[0] + c[1] * c[1]) + (c[2] * c[2] + c[3] * c[3]);
              ss += dpp_f<0xB1>(ss); ss += dpp_f<0x4E>(ss); ss += dpp_f<0x141>(ss);
              const float rstd = rsqrtf(ss * (1.0f / 64.0f) + RMS_EPS); a = a * rstd * g0; c = c * rstd * g1; }
          st16(T.O + (size_t)(qrow0 + row) * 1024 + T.ocol + ch * 8, a, c); } }
    LDS_WAIT(); __builtin_amdgcn_s_barrier(); asm volatile("" ::: "memory");
}
}

namespace atts {
constexpr float THR = 6.0f;
constexpr float LIM = 64.0f;
#define SB0() __builtin_amdgcn_sched_barrier(0)
struct Sm { float mhat, l; };
__device__ __forceinline__ void exp_pack(f32x16& p0, f32x16& p1, Sm& st, bf16x8 (&pa)[4]) {
    float s = 0.f;
#pragma unroll
    for (int r = 0; r < 16; ++r) { p0[r] = fast_exp2(p0[r]); p1[r] = fast_exp2(p1[r]); s = (s + p0[r]) + p1[r]; }
    st.l += s;
    pa[0] = pack8(p0, 0); pa[1] = pack8(p0, 8); pa[2] = pack8(p1, 0); pa[3] = pack8(p1, 8);
}
__device__ __forceinline__ void exp_head(f32x16& p0, float& s) {
#pragma unroll
    for (int r = 0; r < 8; ++r) { p0[r] = fast_exp2(p0[r]); s += p0[r]; }
}
__device__ __forceinline__ void exp_tail(f32x16& p0, f32x16& p1, float& s, Sm& st, bf16x8 (&pa)[4]) {
#pragma unroll
    for (int r = 8; r < 16; ++r) { p0[r] = fast_exp2(p0[r]); s += p0[r]; }
#pragma unroll
    for (int r = 0; r < 16; ++r) { p1[r] = fast_exp2(p1[r]); s += p1[r]; }
    st.l += s;
    pa[0] = pack8(p0, 0); pa[1] = pack8(p0, 8); pa[2] = pack8(p1, 0); pa[3] = pack8(p1, 8);
}
__device__ __forceinline__ void rescale(f32x16& p0, f32x16& p1, Sm& st, f32x16 (&o)[2], const float rm, LAS float* wsf, const int r32, const int hi, f32x16& negm) {
    if (__any(rm > THR)) {
        const float dl = fmaxf(rm, 0.f);
        st.mhat += dl;
#pragma unroll
        for (int r = 0; r < 16; ++r) negm[r] = -st.mhat;
#pragma unroll
        for (int r = 0; r < 16; ++r) { p0[r] -= dl; p1[r] -= dl; }
        const float f = fast_exp2(-dl); st.l *= f;
        if (hi == 0) wsf[r32] = f;
        LDS_WAIT();
#pragma unroll
        for (int r = 0; r < 16; ++r) { const float fr_ = wsf[crow(r, hi)]; o[0][r] *= fr_; o[1][r] *= fr_; }
    }
}
__device__ __forceinline__ void glds16(const bf16_t* src, LAS unsigned char* dst) { __builtin_amdgcn_global_load_lds((const unsigned*)src, (LAS unsigned*)dst, 16, 0, 0); }
#ifndef KRD16
#define KRD16(dst, addr, off) asm volatile("ds_read_b128 %0, %1 offset:%c2" : "=&v"(dst) : "v"(addr), "i"(off) : "memory")
#endif
struct Src {
    const bf16_t* Q; int qpitch, qcol;
    const bf16_t* K; int kcol;
    const bf16_t* KR;
    const bf16_t* V; int vcol;
    const float* kmn; const float* kmx;
};
template <int KIND>
__device__ __forceinline__ void attn_pass(LAS unsigned char* lds, const Src& T, const int b, const bool ctxq, const int qb, f32x16 (&o1)[2], Sm& st1) {
    constexpr int NCH = KIND ? 12 : 4, NKW = KIND ? 8 : 4, ND = KIND ? 6 : 2, KSLOT = NCH * 1024, SLOT = KSLOT + 8192, NSLOT = 4;
    constexpr int WS_OFF = 90112;
    static_assert(NSLOT * SLOT <= WS_OFF && WS_OFF + 8 * 512 <= RING_BYTES, "attention LDS");
    const int tid = otid(), lane = tid & 63, r32 = lane & 31, hi = lane >> 5, wid = __builtin_amdgcn_readfirstlane(tid >> 6);
    const int NT = ctxq ? 4 : 68;
    const int krow_ctx = NLAT + b * CTXL, krow_lat = b * SEQ;
    const int qrow0 = (ctxq ? krow_ctx : krow_lat + qb * 256) + wid * 32;
    LAS float* wsf = (LAS float*)(lds + WS_OFF + wid * 512);
#define ATT_ISSUE(t_) do { const int kr_ = ((t_) < 4) ? krow_ctx + 64 * (t_) : krow_lat + 64 * ((t_) - 4); const int so_ = ((t_) & 3) * SLOT; \
        if (wid < NKW) glds16(T.K + (size_t)(kr_ + lane) * 384 + T.kcol + wid * 8, lds + so_ + wid * 1024); \
        if (KIND == 1 && wid < 4) glds16(T.KR + (size_t)(kr_ + lane) * 32 + wid * 8, lds + so_ + (8 + wid) * 1024); \
        glds16(T.V + (size_t)(kr_ + 16 * (wid & 3) + (lane >> 2)) * 384 + T.vcol + (wid >> 2) * 32 + (lane & 3) * 8, lds + so_ + KSLOT + wid * 1024); } while (0)
#define ATT_WAITN(n) do { const int np_ = (KIND == 1) ? (wid < 4 ? 3 : 2) : (wid < 4 ? 2 : 1); \
        if ((n) == 0) asm volatile("s_waitcnt vmcnt(0)" ::: "memory"); \
        else if (np_ * (n) == 1) asm volatile("s_waitcnt vmcnt(1)" ::: "memory"); else if (np_ * (n) == 2) asm volatile("s_waitcnt vmcnt(2)" ::: "memory"); \
        else if (np_ * (n) == 3) asm volatile("s_waitcnt vmcnt(3)" ::: "memory"); else if (np_ * (n) == 4) asm volatile("s_waitcnt vmcnt(4)" ::: "memory"); \
        else asm volatile("s_waitcnt vmcnt(6)" ::: "memory"); } while (0)
#define ATT_BAR() do { LDS_WAIT(); __builtin_amdgcn_s_barrier(); asm volatile("" ::: "memory"); } while (0)
    bf16x8 qr[ND];
    float qn = 0.f;
    { const bf16_t* qp = T.Q + (size_t)(qrow0 + r32) * T.qpitch + T.qcol + hi * 8;
#pragma unroll
      for (int d0 = 0; d0 < ND; ++d0) { qr[d0] = *(const bf16x8*)(qp + d0 * 16);
#pragma unroll
          for (int e = 0; e < 8; ++e) { const float f_ = bf2f((unsigned short)qr[d0][e]); qn += f_ * f_; } }
      qn += __shfl_xor(qn, 32); qn = __builtin_amdgcn_sqrtf(qn) * 1.02f; }
    constexpr int KT_OFF = WS_OFF + 8 * 512;
    static_assert(KT_OFF + 68 * 4 <= RING_BYTES, "attention LDS");
    if (tid < NT) { const int ti = (tid < 4) ? (NLAT >> 6) + b * 4 + tid : b * 64 + (tid - 4);
        ((LAS float*)(lds + KT_OFF))[tid] = __builtin_amdgcn_sqrtf(T.kmn[(size_t)ti * 8 + (T.kcol >> 6)] + T.kmx[(size_t)ti * 16 + 12]) * 1.02f; }
    ATT_ISSUE(0); ATT_ISSUE(1); ATT_ISSUE(2);
    st1.mhat = 0.f; st1.l = 0.f;
#pragma unroll
    for (int r = 0; r < 16; ++r) { o1[0][r] = 0.f; o1[1][r] = 0.f; }
    const unsigned klane = (unsigned)(size_t)lds + hi * 1024 + r32 * 16;
    const unsigned vlane = (unsigned)(size_t)lds + KSLOT + ((lane >> 4) & 1) * 32 + (lane & 3) * 8 + (4 * hi + ((lane & 15) >> 2)) * 64;
    f32x16 a0, a1, n0, n1, negm1;
#define ATT_KRD(t_, kf) do { const unsigned kb_ = klane + ((t_) & 3) * SLOT; \
        _Pragma("unroll") for (int d = 0; d < ND; ++d) { KRD16(kf[2 * d], kb_, d * 2048); KRD16(kf[2 * d + 1], kb_, d * 2048 + 512); } } while (0)
#define ATT_MM(kf, P0, P1) do { asm volatile("s_waitcnt lgkmcnt(0)" ::: "memory"); SB0(); \
        P0 = mfma32(kf[0], qr[0], negm1); P1 = mfma32(kf[1], qr[0], negm1); \
        _Pragma("unroll") for (int d = 1; d < ND; ++d) { P0 = mfma32(kf[2 * d], qr[d], P0); P1 = mfma32(kf[2 * d + 1], qr[d], P1); } } while (0)
#define ATT_QK(t_, P0, P1) do { bf16x8 kf_[2 * ND]; ATT_KRD(t_, kf_); ATT_MM(kf_, P0, P1); } while (0)
#pragma unroll
    for (int r = 0; r < 16; ++r) negm1[r] = 0.f;
    ATT_WAITN(2); ATT_BAR();
    ATT_QK(0, a0, a1);
    { const float rm = rowmax32_fast(a0, a1); st1.mhat = rm;
#pragma unroll
      for (int r = 0; r < 16; ++r) { a0[r] -= rm; a1[r] -= rm; negm1[r] = -rm; } }
#define ATT_STEP(t_, A0, A1, N0, N1) do { const int tt = (t_); \
        if (tt + 2 < NT) ATT_WAITN(1); else ATT_WAITN(0); \
        ATT_BAR();                                                  \
        if (tt + 3 < NT) ATT_ISSUE(tt + 3); \
        const unsigned vb_ = vlane + (tt & 3) * SLOT; \
        bf16x8 pa1[4]; bf16x8 kf_[2 * ND]; float es_ = 0.f; float kb_n; \
        asm volatile("ds_read_b32 %0, %1" : "=&v"(kb_n) : "v"((unsigned)(size_t)(lds + KT_OFF) + (unsigned)(tt + 1) * 4u) : "memory");     \
        ATT_KRD(tt + 1, kf_); SB0(); \
        exp_head(A0, es_); SB0();                                    \
        ATT_MM(kf_, N0, N1); \
        exp_tail(A0, A1, es_, st1, pa1); \
        _Pragma("unroll") for (int sg = 0; sg < 2 * ND; ++sg) { __builtin_amdgcn_sched_group_barrier(0x8, 1, 0); __builtin_amdgcn_sched_group_barrier(0x2, KIND ? 6 : 16, 0); } \
        SB0(); \
        PV_BLOCK(vb_, 0, o1[0] = mfma32(pa1[ks], vf, o1[0])); PV_BLOCK(vb_, 1, o1[1] = mfma32(pa1[ks], vf, o1[1])); \
        SB0(); \
        if (__any(qn * kb_n - st1.mhat > LIM)) {                    \
            const float rm1 = rowmax32_fast(N0, N1); \
            rescale(N0, N1, st1, o1, rm1, wsf, r32, hi, negm1); } } while (0)
    for (int t = 0; t < NT - 2; t += 2) {
        ATT_STEP(t, a0, a1, n0, n1);
        ATT_STEP(t + 1, n0, n1, a0, a1);
    }
    ATT_STEP(NT - 2, a0, a1, n0, n1);
    { bf16x8 pa1[4]; const unsigned vb_ = vlane + ((NT - 1) & 3) * SLOT;
      exp_pack(n0, n1, st1, pa1);
      PV_BLOCK(vb_, 0, o1[0] = mfma32(pa1[ks], vf, o1[0])); PV_BLOCK(vb_, 1, o1[1] = mfma32(pa1[ks], vf, o1[1])); }
    ATT_BAR();
#undef ATT_STEP
#undef ATT_QK
#undef ATT_ISSUE
#undef ATT_WAITN
}
template <bool DIFF>
__device__ __forceinline__ void attn_store(LAS unsigned char* lds, const f32x16 (&o1)[2], const Sm& st1, const f32x16 (&o2)[2], const Sm& st2, const float lam, const float onem, const float* dn,
        bf16_t* O, const int ocol, const int b, const bool ctxq, const int qb) {
    const int tid = otid(), lane = tid & 63, r32 = lane & 31, hi = lane >> 5, wid = __builtin_amdgcn_readfirstlane(tid >> 6);
    const int qrow0 = (ctxq ? NLAT + b * CTXL : b * SEQ + qb * 256) + wid * 32;
    LAS float* wsf = (LAS float*)(lds + 90112 + wid * 512);
    LAS float* stg = (LAS float*)(lds + wid * 8192);
    const float l1 = st1.l + __shfl_xor(st1.l, 32), l2 = DIFF ? st2.l + __shfl_xor(st2.l, 32) : 1.f;
    if (hi == 0) { wsf[64 + r32] = l1; if (DIFF) wsf[96 + r32] = l2; }
    LDS_WAIT();
#pragma unroll
    for (int r = 0; r < 16; ++r) { const int q = crow(r, hi); const float rl1 = fast_rcp(wsf[64 + q]);
        if (!DIFF) { stg[q * 64 + r32] = o1[0][r] * rl1; stg[q * 64 + 32 + r32] = o1[1][r] * rl1; }
        else { const float rl2 = lam * fast_rcp(wsf[96 + q]);
            stg[q * 64 + r32] = o1[0][r] * rl1 - o2[0][r] * rl2; stg[q * 64 + 32 + r32] = o1[1][r] * rl1 - o2[1][r] * rl2; } }
    LDS_WAIT();
    const int ch = lane & 7;
    f32x4 g0 = (f32x4){1.f, 1.f, 1.f, 1.f}, g1 = g0;
    if (DIFF) { g0 = *(const f32x4*)(dn + ch * 8) * onem; g1 = *(const f32x4*)(dn + ch * 8 + 4) * onem; }
#pragma unroll
    for (int i = 0; i < 4; ++i) { const int row = i * 8 + (lane >> 3);
        f32x4 a = *(const LAS f32x4*)(stg + row * 64 + ch * 8), c = *(const LAS f32x4*)(stg + row * 64 + ch * 8 + 4);
        if (DIFF) { float ss = (a[0] * a[0] + a[1] * a[1]) + (a[2] * a[2] + a[3] * a[3]) + (c[0] * c[0] + c[1] * c[1]) + (c[2] * c[2] + c[3] * c[3]);
            ss += dpp_f<0xB1>(ss); ss += dpp_f<0x4E>(ss); ss += dpp_f<0x141>(ss);
            const float rstd = rsqrtf(ss * (1.0f / 64.0f) + RMS_EPS); a = a * rstd * g0; c = c * rstd * g1; }
        st16(O + (size_t)(qrow0 + row) * 1024 + ocol + ch * 8, a, c); }
    LDS_WAIT(); __builtin_amdgcn_s_barrier(); asm volatile("" ::: "memory");
}
#undef ATT_BAR
#undef SB0
}

namespace attp {
typedef short v4i16_t __attribute__((ext_vector_type(4)));
constexpr float THR = 6.0f;
#define SB0() __builtin_amdgcn_sched_barrier(0)
__device__ __forceinline__ float rowmax32(f32x16& p0, f32x16& p1) { return rowmax32_fast(p0, p1); }
struct Sm { float mhat, l; };
__device__ __forceinline__ void exp_pack(f32x16& p0, f32x16& p1, Sm& st, bf16x8 (&pa)[4]) {
    float s = 0.f;
#pragma unroll
    for (int r = 0; r < 16; ++r) { p0[r] = fast_exp2(p0[r]); p1[r] = fast_exp2(p1[r]); s = (s + p0[r]) + p1[r]; }
    st.l += s;
    pa[0] = pack8(p0, 0); pa[1] = pack8(p0, 8); pa[2] = pack8(p1, 0); pa[3] = pack8(p1, 8);
}
__device__ __forceinline__ void rescale(f32x16& p0, f32x16& p1, Sm& st, f32x16 (&o)[2], const float rm, LAS float* wsf, const int r32, const int hi, f32x16& negm) {
    if (__any(rm > THR)) {
        const float dl = fmaxf(rm, 0.f);
        st.mhat += dl;
#pragma unroll
        for (int r = 0; r < 16; ++r) negm[r] = -st.mhat;
#pragma unroll
        for (int r = 0; r < 16; ++r) { p0[r] -= dl; p1[r] -= dl; }
        const float f = fast_exp2(-dl); st.l *= f;
        if (hi == 0) wsf[r32] = f;
        LDS_WAIT();
#pragma unroll
        for (int r = 0; r < 16; ++r) { const float fr_ = wsf[crow(r, hi)]; o[0][r] *= fr_; o[1][r] *= fr_; }
    }
}
__device__ __forceinline__ void glds16(const bf16_t* src, LAS unsigned char* dst) { __builtin_amdgcn_global_load_lds((const unsigned*)src, (LAS unsigned*)dst, 16, 0, 0); }

#define KRD16(dst, addr, off) asm volatile("ds_read_b128 %0, %1 offset:%c2" : "=&v"(dst) : "v"(addr), "i"(off) : "memory")
struct Tens {
    const bf16_t* Q; int qpitch, qcol;
    const bf16_t* K; const bf16_t* KR; const bf16_t* V; int kvcol;
    bf16_t* O; int ocol;
    float lam, onem; const float* dn;
};
template <int D0, int ND>
__device__ __forceinline__ void qk_tile(f32x16& p0, f32x16& p1, const LAS unsigned char* kp, const bf16x8* qr, const float mhat) {
    f32x16 c;
#pragma unroll
    for (int r = 0; r < 16; ++r) c[r] = -mhat;
#pragma unroll
    for (int d = 0; d < ND; ++d) { const bf16x8 k0 = *(const LAS bf16x8*)(kp + (D0 + d) * 2048), k1 = *(const LAS bf16x8*)(kp + (D0 + d) * 2048 + 512);
        if (d == 0) { p0 = mfma32(k0, qr[D0], c); p1 = mfma32(k1, qr[D0], c); } else { p0 = mfma32(k0, qr[D0 + d], p0); p1 = mfma32(k1, qr[D0 + d], p1); } }
}
template <int D0, int ND>
__device__ __forceinline__ void qk_tile_l(f32x16& p0, f32x16& p1, const LAS unsigned char* kp, const LAS unsigned char* ql, const float mhat) {
#pragma unroll
    for (int r = 0; r < 16; ++r) { p0[r] = -mhat; p1[r] = -mhat; }
#pragma unroll
    for (int d = 0; d < ND; ++d) { const bf16x8 k0 = *(const LAS bf16x8*)(kp + (D0 + d) * 2048), k1 = *(const LAS bf16x8*)(kp + (D0 + d) * 2048 + 512);
        const bf16x8 q = *(const LAS bf16x8*)(ql + (D0 + d) * 1024);
        p0 = mfma32(k0, q, p0); p1 = mfma32(k1, q, p1); }
}
template <int MODE>
__device__ __forceinline__ void attn_unit(LAS unsigned char* lds, const Tens& T, const int b, const bool ctxq, const int qb) {
    constexpr int NCH = MODE ? 12 : 8, KSLOT = NCH * 1024, SLOT = KSLOT + 8192, NSLOT = 4;
    constexpr int WS_OFF = NSLOT * SLOT, OST_OFF = 0, QS_OFF = WS_OFF + 8 * 512;
    static_assert(QS_OFF + 8 * 4096 <= RING_BYTES && 8 * 8192 <= WS_OFF, "attention LDS");
    const int tid = otid(), lane = tid & 63, r32 = lane & 31, hi = lane >> 5, wid = __builtin_amdgcn_readfirstlane(tid >> 6);
    const int NT = ctxq ? 4 : 68;
    const int krow_ctx = NLAT + b * CTXL, krow_lat = b * SEQ;
    const int qrow0 = (ctxq ? krow_ctx : krow_lat + qb * 256) + wid * 32;
    LAS float* wsf = (LAS float*)(lds + WS_OFF + wid * 512);
    LAS float* stg = (LAS float*)(lds + OST_OFF + wid * 8192);
#define ATT_ISSUE(t_) do { const int kr_ = ((t_) < 4) ? krow_ctx + 64 * (t_) : krow_lat + 64 * ((t_) - 4); const int so_ = ((t_) & 3) * SLOT; \
        glds16(T.K + (size_t)(kr_ + lane) * 384 + T.kvcol + wid * 8, lds + so_ + wid * 1024); \
        if (MODE == 1 && wid < 4) glds16(T.KR + (size_t)(kr_ + lane) * 32 + wid * 8, lds + so_ + (8 + wid) * 1024); \
        glds16(T.V + (size_t)(kr_ + 16 * (wid & 3) + (lane >> 2)) * 384 + T.kvcol + (wid >> 2) * 32 + (lane & 3) * 8, lds + so_ + KSLOT + wid * 1024); } while (0)
#define ATT_WAIT(n2, n3) do { if (MODE == 1 && wid < 4) asm volatile("s_waitcnt vmcnt(" #n3 ")" ::: "memory"); else asm volatile("s_waitcnt vmcnt(" #n2 ")" ::: "memory"); } while (0)
#define ATT_BAR() do { LDS_WAIT(); __builtin_amdgcn_s_barrier(); asm volatile("" ::: "memory"); } while (0)
    constexpr int NQ = MODE ? 6 : 4;
    bf16x8 qr[NQ];
    const LAS unsigned char* ql = lds + QS_OFF + wid * 4096 + lane * 16;
    { const bf16_t* qp = T.Q + (size_t)(qrow0 + r32) * T.qpitch + T.qcol + hi * 8;
#pragma unroll
      for (int d0 = 0; d0 < NQ; ++d0) { const bf16x8 q = *(const bf16x8*)(qp + d0 * 16); if (MODE == 1) qr[d0] = q; else *(LAS bf16x8*)(lds + QS_OFF + wid * 4096 + d0 * 1024 + lane * 16) = q; } }
    ATT_ISSUE(0); ATT_ISSUE(1); ATT_ISSUE(2);
    Sm st1{0.f, 0.f}, st2{0.f, 0.f};
    f32x16 o1[2], o2[2];
#pragma unroll
    for (int r = 0; r < 16; ++r) { o1[0][r] = 0.f; o1[1][r] = 0.f; o2[0][r] = 0.f; o2[1][r] = 0.f; }
    const int klane = hi * 1024 + r32 * 16;
    const int vlane = KSLOT + ((lane >> 4) & 1) * 32 + (lane & 3) * 8 + (4 * hi + ((lane & 15) >> 2)) * 64;
    f32x16 a0, a1, c0, c1;
    ATT_WAIT(4, 6); ATT_BAR();
    { const LAS unsigned char* kp = lds + klane;
      if (MODE == 1) { qk_tile<0, 6>(a0, a1, kp, qr, 0.f); }
      else { qk_tile_l<0, 2>(a0, a1, kp, ql, 0.f); qk_tile_l<2, 2>(c0, c1, kp, ql, 0.f); }
      { const float rm = rowmax32(a0, a1); st1.mhat = rm;
#pragma unroll
        for (int r = 0; r < 16; ++r) { a0[r] -= rm; a1[r] -= rm; } }
      if (MODE == 0) { const float rm = rowmax32(c0, c1); st2.mhat = rm;
#pragma unroll
        for (int r = 0; r < 16; ++r) { c0[r] -= rm; c1[r] -= rm; } } }
    f32x16 n0, n1, m0, m1;
    f32x16 negm1, negm2;
#pragma unroll
    for (int r = 0; r < 16; ++r) { negm1[r] = -st1.mhat; negm2[r] = -st2.mhat; }
#define ATT_PV1(vb_) do { PV_BLOCK(vb_, 0, o1[0] = mfma32(pa1[ks], vf, o1[0])); PV_BLOCK(vb_, 1, o1[1] = mfma32(pa1[ks], vf, o1[1])); } while (0)
#define ATT_PV2(vb_) do { PV_BLOCK(vb_, 0, o1[0] = mfma32(pa1[ks], vf, o1[0]); o2[0] = mfma32(pa2[ks], vf, o2[0])); PV_BLOCK(vb_, 1, o1[1] = mfma32(pa1[ks], vf, o1[1]); o2[1] = mfma32(pa2[ks], vf, o2[1])); } while (0)
#define ATT_STEP(t_, A0, A1, C0, C1, N0, N1, M0, M1) do { const int tt = (t_); \
        if (tt + 2 < NT) ATT_WAIT(2, 3); else asm volatile("s_waitcnt vmcnt(0)" ::: "memory"); \
        ATT_BAR();                                                  \
        if (tt + 3 < NT) ATT_ISSUE(tt + 3); \
        const LAS unsigned char* kpn = lds + ((tt + 1) & 3) * SLOT + klane; \
        const unsigned vp = (unsigned)(size_t)(lds + (tt & 3) * SLOT + vlane); \
        bf16x8 pa1[4], pa2[4]; \
        if (MODE == 1) { \
            { const unsigned kb_ = (unsigned)(size_t)kpn; bf16x8 kf[12]; \
              _Pragma("unroll") for (int d = 0; d < 6; ++d) { KRD16(kf[2 * d], kb_, d * 2048); KRD16(kf[2 * d + 1], kb_, d * 2048 + 512); } \
              asm volatile("s_waitcnt lgkmcnt(0)" ::: "memory"); SB0(); \
              N0 = mfma32(kf[0], qr[0], negm1); N1 = mfma32(kf[1], qr[0], negm1); \
              _Pragma("unroll") for (int d = 1; d < 6; ++d) { N0 = mfma32(kf[2 * d], qr[d], N0); N1 = mfma32(kf[2 * d + 1], qr[d], N1); } } \
            exp_pack(A0, A1, st1, pa1); \
            _Pragma("unroll") for (int sg = 0; sg < 12; ++sg) { __builtin_amdgcn_sched_group_barrier(0x8, 1, 0); __builtin_amdgcn_sched_group_barrier(0x2, 7, 0); } \
            SB0(); \
            const float rm1 = rowmax32(N0, N1); \
            ATT_PV1(vp); \
            SB0(); \
            rescale(N0, N1, st1, o1, rm1, wsf, r32, hi, negm1); \
        } else { \
            qk_tile_l<0, 2>(N0, N1, kpn, ql, st1.mhat); \
            exp_pack(A0, A1, st1, pa1); \
            SB0(); \
            qk_tile_l<2, 2>(M0, M1, kpn, ql, st2.mhat); \
            exp_pack(C0, C1, st2, pa2); \
            SB0(); \
            const float rm1 = rowmax32(N0, N1), rm2 = rowmax32(M0, M1); \
            ATT_PV2(vp); \
            SB0(); \
            rescale(N0, N1, st1, o1, rm1, wsf, r32, hi, negm1); rescale(M0, M1, st2, o2, rm2, wsf + 32, r32, hi, negm2); \
        } } while (0)
    for (int t = 0; t < NT - 2; t += 2) {
        ATT_STEP(t, a0, a1, c0, c1, n0, n1, m0, m1);
        ATT_STEP(t + 1, n0, n1, m0, m1, a0, a1, c0, c1);
    }
    ATT_STEP(NT - 2, a0, a1, c0, c1, n0, n1, m0, m1);
    { bf16x8 pa1[4], pa2[4]; const unsigned vp = (unsigned)(size_t)(lds + ((NT - 1) & 3) * SLOT + vlane);
      exp_pack(n0, n1, st1, pa1);
      if (MODE == 1) { ATT_PV1(vp); } else { exp_pack(m0, m1, st2, pa2); ATT_PV2(vp); } }
#undef ATT_PV1
#undef ATT_PV2
#undef ATT_STEP
#undef ATT_ISSUE
#undef ATT_WAIT
    ATT_BAR();
    { const float l1 = st1.l + __shfl_xor(st1.l, 32), l2 = st2.l + __shfl_xor(st2.l, 32);
      if (hi == 0) { wsf[64 + r32] = l1; if (MODE == 0) wsf[96 + r32] = l2; }
      LDS_WAIT();
#pragma unroll
      for (int r = 0; r < 16; ++r) { const int q = crow(r, hi); const float rl1 = fast_rcp(wsf[64 + q]);
          if (MODE == 1) { stg[q * 64 + r32] = o1[0][r] * rl1; stg[q * 64 + 32 + r32] = o1[1][r] * rl1; }
          else { const float rl2 = T.lam * fast_rcp(wsf[96 + q]);
              stg[q * 64 + r32] = o1[0][r] * rl1 - o2[0][r] * rl2; stg[q * 64 + 32 + r32] = o1[1][r] * rl1 - o2[1][r] * rl2; } }
      LDS_WAIT();
      const int ch = lane & 7;
      f32x4 g0 = (f32x4){1.f, 1.f, 1.f, 1.f}, g1 = g0;
      if (MODE == 0) { g0 = *(const f32x4*)(T.dn + ch * 8) * T.onem; g1 = *(const f32x4*)(T.dn + ch * 8 + 4) * T.onem; }
#pragma unroll
      for (int i = 0; i < 4; ++i) { const int row = i * 8 + (lane >> 3);
          f32x4 a = *(const LAS f32x4*)(stg + row * 64 + ch * 8), c = *(const LAS f32x4*)(stg + row * 64 + ch * 8 + 4);
          if (MODE == 0) { float ss = (a[0] * a[0] + a[1] * a[1]) + (a[2] * a[2] + a[3] * a[3]) + (c[0] * c[0] + c[1] * c[1]) + (c[2] * c[2] + c[3] * c[3]);
              ss += dpp_f<0xB1>(ss); ss += dpp_f<0x4E>(ss); ss += dpp_f<0x141>(ss);
              const float rstd = rsqrtf(ss * (1.0f / 64.0f) + RMS_EPS); a = a * rstd * g0; c = c * rstd * g1; }
          st16(T.O + (size_t)(qrow0 + row) * 1024 + T.ocol + ch * 8, a, c); } }
    ATT_BAR();
#undef ATT_BAR
#undef SB0
}
}

namespace lru {
constexpr int YP = 264;
constexpr int YBUF = 32 * YP * 2;
struct WaveCtx { bf16x8 wf[2][2][4]; float ba[2], bi[2], c8[2]; float cw[4], cb; };

__device__ __forceinline__ void load_ctx(WaveCtx& W, const int l, const bf16_t* WG, const float* conv_w, const float* conv_b, const float* lba, const float* lbi, const float* llam) {
    const int tid = otid(), lane = tid & 63, r32 = lane & 31, hi = lane >> 5, wid = __builtin_amdgcn_readfirstlane(tid >> 6);
    const int hb = wid & 3, half = wid >> 2, c2 = 64 * hb + 32 * half + r32;
#pragma unroll
    for (int d = 0; d < 2; ++d)
#pragma unroll
        for (int gt = 0; gt < 2; ++gt)
#pragma unroll
            for (int ks = 0; ks < 4; ++ks)
                W.wf[d][gt][ks] = *(const bf16x8*)(WG + ((size_t)(l * 1024 + hb * 256 + d * 128 + gt * 64 + 32 * half + r32)) * 64 + 16 * ks + 8 * hi);
#pragma unroll
    for (int d = 0; d < 2; ++d) { W.ba[d] = lba[(l * 2 + d) * 256 + c2]; W.bi[d] = lbi[(l * 2 + d) * 256 + c2];
        const float lam = llam[(l * 2 + d) * 256 + c2]; W.c8[d] = -8.0f * LOG2E * log1pf(expf(-lam)); }
    const int c = tid & 255;
#pragma unroll
    for (int k = 0; k < 4; ++k) W.cw[k] = conv_w[(l * 4 + k) * 256 + c];
    W.cb = conv_b[l * 256 + c];
}

__device__ __forceinline__ float bcast_lo(const float v) { auto rr = __builtin_amdgcn_permlane32_swap(__float_as_uint(v), __float_as_uint(v), false, false); return __uint_as_float(rr[0]); }
__device__ __forceinline__ float bcast_hi(const float v) { auto rr = __builtin_amdgcn_permlane32_swap(__float_as_uint(v), __float_as_uint(v), false, false); return __uint_as_float(rr[1]); }
struct ChunkPos { int seqbase, seqlen, tl0; };
__device__ __forceinline__ ChunkPos chunk_pos(const int cid) { ChunkPos p;
    if (cid < NCHUNK_LAT) { p.seqbase = (cid >> 7) * SEQ; p.seqlen = SEQ; p.tl0 = (cid & 127) * 32; }
    else { const int cc = cid - NCHUNK_LAT; p.seqbase = NLAT + (cc >> 3) * CTXL; p.seqlen = CTXL; p.tl0 = (cc & 7) * 32; }
    return p; }
__device__ __forceinline__ void conv_load(unsigned (&xr)[19], const int cid, const bf16_t* XL, const int tid) {
    const ChunkPos p = chunk_pos(cid); const int c = tid & 255, th = tid >> 8;
#pragma unroll
    for (int k = 0; k < 19; ++k) { int tl = p.tl0 + th * 16 - 2 + k; tl = tl < 0 ? 0 : (tl >= p.seqlen ? p.seqlen - 1 : tl); xr[k] = XL[(size_t)(p.seqbase + tl) * 256 + c]; }
}
__device__ __forceinline__ void conv_store(const unsigned (&xr)[19], const int cid, const WaveCtx& W, LAS bf16_t* Y, const int tid) {
    const ChunkPos p = chunk_pos(cid); const int c = tid & 255, th = tid >> 8; float xv[19];
#pragma unroll
    for (int k = 0; k < 19; ++k) { const int tl = p.tl0 + th * 16 - 2 + k; xv[k] = (tl >= 0 && tl < p.seqlen) ? bf2f(xr[k]) : 0.f; }
#pragma unroll
    for (int i = 0; i < 16; ++i) { const float y = W.cb + W.cw[0] * xv[i] + W.cw[1] * xv[i + 1] + W.cw[2] * xv[i + 2] + W.cw[3] * xv[i + 3]; Y[(th * 16 + i) * YP + c] = (bf16_t)f2bf(y); }
}
template <bool FINAL>
__device__ __forceinline__ void chunk(LAS unsigned char* ybuf, LAS unsigned char* ynbuf, const WaveCtx& W, const int cid, const int ncid, const bf16_t* XL, const bf16_t* GG, float* LSUM, const float* LCAR, bf16_t* MIX) {
    const int tid = otid(), lane = tid & 63, r32 = lane & 31, hi = lane >> 5, wid = __builtin_amdgcn_readfirstlane(tid >> 6);
    const int hb = wid & 3, half = wid >> 2, c2 = 64 * hb + 32 * half + r32;
    const ChunkPos p = chunk_pos(cid); const int seqbase = p.seqbase, tl0 = p.tl0;
    LAS bf16_t* Y = (LAS bf16_t*)ybuf;
    float hc[2] = {0.f, 0.f}; unsigned gr[16];
    if (FINAL) { hc[0] = LCAR[((size_t)cid * 2 + 0) * 256 + c2]; hc[1] = LCAR[((size_t)cid * 2 + 1) * 256 + c2];
#pragma unroll
        for (int r = 0; r < 16; ++r) gr[r] = GG[(size_t)(seqbase + tl0 + crow(r, hi)) * 256 + c2]; }
    unsigned xr[19];
    conv_load(xr, ncid >= 0 ? ncid : cid, XL, tid);
    float yv[16], hsum[16];
#pragma unroll
    for (int r = 0; r < 16; ++r) { yv[r] = bf2f(Y[crow(r, hi) * YP + c2]); hsum[r] = 0.f; }
#pragma unroll
    for (int d = 0; d < 2; ++d) {
        f32x16 acc[2];
#pragma unroll
        for (int r = 0; r < 16; ++r) { acc[0][r] = 0.f; acc[1][r] = 0.f; }
#pragma unroll
        for (int ks = 0; ks < 4; ++ks) { const bf16x8 a = *(const LAS bf16x8*)(Y + r32 * YP + 64 * hb + 16 * ks + 8 * hi);
            acc[0] = mfma32(a, W.wf[d][0][ks], acc[0]); acc[1] = mfma32(a, W.wf[d][1][ks], acc[1]); }
        float ca[16], hl[16];
#pragma unroll
        for (int r = 0; r < 16; ++r) { const float rg = sigmoidf_(acc[0][r] + W.ba[d]), ig = sigmoidf_(acc[1][r] + W.bi[d]);
            const float a = fast_exp2(W.c8[d] * rg); ca[r] = a; hl[r] = __builtin_amdgcn_sqrtf(fmaxf(1.0f - a * a, 0.f)) * (ig * yv[r]); }
        float sA[4], sH[4];
        if (d == 0) {
#pragma unroll
            for (int q = 0; q < 4; ++q) {
#pragma unroll
                for (int j = 1; j < 4; ++j) { hl[4 * q + j] = ca[4 * q + j] * hl[4 * q + j - 1] + hl[4 * q + j]; ca[4 * q + j] = ca[4 * q + j] * ca[4 * q + j - 1]; }
                sA[q] = ca[4 * q + 3]; sH[q] = hl[4 * q + 3]; }
        } else {
#pragma unroll
            for (int q = 0; q < 4; ++q) {
#pragma unroll
                for (int j = 2; j >= 0; --j) { hl[4 * q + j] = ca[4 * q + j] * hl[4 * q + j + 1] + hl[4 * q + j]; ca[4 * q + j] = ca[4 * q + j] * ca[4 * q + j + 1]; }
                sA[q] = ca[4 * q]; sH[q] = hl[4 * q]; }
        }
        float h = FINAL ? hc[d] : 0.f;
        float hbef[4];
        if (d == 0) {
#pragma unroll
            for (int q = 0; q < 4; ++q) { const float hb0 = h; const float t0 = sA[q] * h + sH[q]; const float hm = bcast_lo(t0); const float t1 = sA[q] * hm + sH[q]; h = bcast_hi(t1); hbef[q] = hi ? hm : hb0; }
        } else {
#pragma unroll
            for (int q = 3; q >= 0; --q) { const float hb1 = h; const float t1 = sA[q] * h + sH[q]; const float hm = bcast_hi(t1); const float t0 = sA[q] * hm + sH[q]; h = bcast_lo(t0); hbef[q] = hi ? hb1 : hm; }
        }
        if (!FINAL) {
            float at = (sA[0] * sA[1]) * (sA[2] * sA[3]); { auto rr = __builtin_amdgcn_permlane32_swap(__float_as_uint(at), __float_as_uint(at), false, false); at = __uint_as_float(rr[0]) * __uint_as_float(rr[1]); }
            if (hi == 0) *(f32x2*)(LSUM + (((size_t)cid * 2 + d) * 256 + c2) * 2) = (f32x2){at, h};
        } else {
#pragma unroll
            for (int r = 0; r < 16; ++r) hsum[r] += ca[r] * hbef[r >> 2] + hl[r];
        }
    }
    if (FINAL) {
#pragma unroll
        for (int r = 0; r < 16; ++r) { const size_t row = (size_t)(seqbase + tl0 + crow(r, hi)); MIX[row * 1024 + c2] = (bf16_t)f2bf(hsum[r] * bf2f(gr[r])); }
    }
    if (ncid >= 0) conv_store(xr, ncid, W, (LAS bf16_t*)ynbuf, tid);
}
template <bool FINAL>
__device__ __forceinline__ void run_chunks(LAS unsigned char* lds, const WaveCtx& W, const int first, const int stride, const int nch, const bf16_t* XL, const bf16_t* GG, float* LSUM, const float* LCAR, bf16_t* MIX) {
    if (first < nch) { unsigned xr[19]; const int tid = otid(); conv_load(xr, first, XL, tid); conv_store(xr, first, W, (LAS bf16_t*)lds, tid); }
    int it = 0;
    for (int cid = first; cid < nch; cid += stride, ++it) {
        __syncthreads();
        const int ncid = (cid + stride < nch) ? cid + stride : -1;
        chunk<FINAL>(lds + (it & 1) * YBUF, lds + ((it + 1) & 1) * YBUF, W, cid, ncid, XL, GG, LSUM, LCAR, MIX);
    }
}

__device__ __forceinline__ void carry(const float* LSUM, float* LCAR) {
    if (blockIdx.x < NBATCH) {
        const int tid_ = otid(); const int b = blockIdx.x, d = tid_ >> 8, c = tid_ & 255;
        float h = 0.f;
#pragma unroll 8
        for (int n = 0; n < 136; ++n) {
            int cid;
            if (d == 0) cid = (n < 8) ? NCHUNK_LAT + b * 8 + n : b * 128 + (n - 8);
            else cid = (n < 8) ? NCHUNK_LAT + b * 8 + (7 - n) : b * 128 + (135 - n);
            const f32x2 ah = *(const f32x2*)(LSUM + (((size_t)cid * 2 + d) * 256 + c) * 2);
            LCAR[((size_t)cid * 2 + d) * 256 + c] = h;
            h = ah.x * h + ah.y;
        }
    }
}
}

namespace lnp {
struct Vec { f32x4 v[4]; };
__device__ __forceinline__ Vec ldv(const float* p, int lane) { Vec r;
#pragma unroll
    for (int j = 0; j < 4; ++j) r.v[j] = *(const f32x4*)(p + 4 * lane + 256 * j);
    return r; }
__device__ __forceinline__ Vec ldbf(const bf16_t* p, int lane) { Vec r;
#pragma unroll
    for (int j = 0; j < 4; ++j) { const u32x2 w = *(const u32x2*)(p + 4 * lane + 256 * j); r.v[j] = (f32x4){bflo(w.x), bfhi(w.x), bflo(w.y), bfhi(w.y)}; }
    return r; }
__device__ __forceinline__ void stf(float* p, int lane, const Vec& a) {
#pragma unroll
    for (int j = 0; j < 4; ++j) *(f32x4*)(p + 4 * lane + 256 * j) = a.v[j]; }
__device__ __forceinline__ void stbf(bf16_t* p, int lane, const Vec& a) {
#pragma unroll
    for (int j = 0; j < 4; ++j) st8(p + 4 * lane + 256 * j, a.v[j]); }
__device__ __forceinline__ void normalize(Vec& y) {
    float s = 0.f;
#pragma unroll
    for (int j = 0; j < 4; ++j) s += (y.v[j][0] + y.v[j][1]) + (y.v[j][2] + y.v[j][3]);
    const float mean = wave_sum(s) * (1.0f / DM); float q = 0.f;
#pragma unroll
    for (int j = 0; j < 4; ++j) { y.v[j] = y.v[j] - mean; q += (y.v[j][0] * y.v[j][0] + y.v[j][1] * y.v[j][1]) + (y.v[j][2] * y.v[j][2] + y.v[j][3] * y.v[j][3]); }
    const float rstd = rsqrtf(wave_sum(q) * (1.0f / DM) + LN_EPS);
#pragma unroll
    for (int j = 0; j < 4; ++j) y.v[j] = y.v[j] * rstd;
}

constexpr int LG_OFF = 65536, CNT_OFF = 86016, BASE_OFF = 86080;
__device__ __forceinline__ f32x4 cvt4u(const u32x2 w) { return (f32x4){bflo(w.x), bfhi(w.x), bflo(w.y), bfhi(w.y)}; }
__device__ __forceinline__ f32x4 cvt4b(const f32x4 r) { const unsigned a = __float_as_uint(r[0]), b = __float_as_uint(r[1]); return (f32x4){bflo(a), bfhi(a), bflo(b), bfhi(b)}; }
struct Raw2 { f32x4 x[4]; u32x2 o[4]; };
struct Ln1Par { Vec gate, gg, bb, m4, m3; int cur_bi; };
__device__ __forceinline__ float swap32_sum(const float x, const float y) { auto rr = __builtin_amdgcn_permlane32_swap(__float_as_uint(x), __float_as_uint(y), false, false); return __uint_as_float(rr[0]) + __uint_as_float(rr[1]); }
__device__ __forceinline__ float swap16_sum(const float x, const float y) { auto rr = __builtin_amdgcn_permlane16_swap(__float_as_uint(x), __float_as_uint(y), false, false); return __uint_as_float(rr[0]) + __uint_as_float(rr[1]); }
__device__ __forceinline__ void ln1_ld(Raw2& R, const int l, const int r_, const int rl, const float* xin_lat, const float* xin_ctx, const bf16_t* XB, const bf16_t* O, const int lane) {
    const int rr = (r_ < rl) ? r_ : rl;
    if (l == 0) { const float* xp = (rr < NLAT ? xin_lat + (size_t)rr * 1024 : xin_ctx + (size_t)(rr - NLAT) * 1024) + 4 * lane;
#pragma unroll
        for (int j = 0; j < 4; ++j) R.x[j] = *(const f32x4*)(xp + 256 * j); }
    else { const bf16_t* xp = XB + (size_t)rr * 1024 + 4 * lane;
#pragma unroll
        for (int j = 0; j < 4; ++j) { const u32x2 w = *(const u32x2*)(xp + 256 * j); R.x[j][0] = __uint_as_float(w.x); R.x[j][1] = __uint_as_float(w.y); } }
    const bf16_t* op = O + (size_t)rr * 1024 + 4 * lane;
#pragma unroll
    for (int j = 0; j < 4; ++j) R.o[j] = *(const u32x2*)(op + 256 * j);
}
__device__ __forceinline__ Vec ln1_norm(const Raw2& R, Ln1Par& P, const int l, const int row, bf16_t* XB, const float* mod, const float* g1, const float* b1, bf16_t* V, const int lane) {
    const bool lat = row < NLAT; const int bi = lat ? (row >> 12) : 16;
    if (bi != P.cur_bi) { P.cur_bi = bi; const float* mb = mod + ((size_t)(l * 17 + bi) * 6) * 1024;
        P.gate = ldv(mb + 2 * 1024, lane); P.m3 = ldv(mb + 3 * 1024, lane); P.m4 = ldv(mb + 4 * 1024, lane); P.gg = ldv(g1 + l * 1024, lane); P.bb = ldv(b1 + l * 1024, lane);
#pragma unroll
        for (int j = 0; j < 4; ++j) P.m4.v[j] = P.m4.v[j] + 1.0f;
        __builtin_amdgcn_s_waitcnt(0x0F70); }
    Vec y;
#pragma unroll
    for (int j = 0; j < 4; ++j) y.v[j] = ((l == 0) ? R.x[j] : cvt4b(R.x[j])) * DN_ALPHA + P.gate.v[j] * cvt4u(R.o[j]);
    normalize(y);
    Vec v;
#pragma unroll
    for (int j = 0; j < 4; ++j) { y.v[j] = y.v[j] * P.gg.v[j] + P.bb.v[j]; v.v[j] = y.v[j] * P.m4.v[j] + P.m3.v[j]; }
    stbf(XB + (size_t)row * 1024, lane, y); stbf(V + (size_t)row * 1024, lane, v);
    return v;
}
__device__ __forceinline__ void router_finish(const float (&r8)[8], const int i, LAS float* lg, const int lane) {
    float r4[4], r2[2], r1;
#pragma unroll
    for (int k = 0; k < 4; ++k) r4[k] = swap16_sum(r8[k], r8[4 + k]);
    { const bool up = lane & 2;
#pragma unroll
      for (int k = 0; k < 2; ++k) { const float mine = up ? r4[2 + k] : r4[k], theirs = up ? r4[k] : r4[2 + k]; r2[k] = mine + dpp_f<0x4E>(theirs); } }
    { const bool up = lane & 1; const float mine = up ? r2[1] : r2[0], theirs = up ? r2[0] : r2[1]; r1 = mine + dpp_f<0xB1>(theirs); }
    r1 += dpp_f<0x124>(r1); r1 += dpp_f<0x128>(r1);
    if ((lane & 12) == 0) lg[i * 16 + (((lane >> 4) << 2) | (lane & 3))] = r1;
}
__device__ __forceinline__ void router2(const Vec& va, const Vec& vb, const int i, const LAS float* Wl, LAS float* lg, const int lane) {
    float ra[8], rb[8];
#pragma unroll
    for (int h = 0; h < 2; ++h) {
        f32x4 a0 = (f32x4){0.f, 0.f, 0.f, 0.f}, a2 = a0, b0 = a0, b2 = a0;
#pragma unroll
        for (int j = 0; j < 4; ++j)
#pragma unroll
            for (int e4 = 0; e4 < 4; ++e4) { const float vv = va.v[j][e4], ww = vb.v[j][e4]; const int jj = j * 4 + e4;
                const f32x4 w0 = *(const LAS f32x4*)(Wl + (((jj * 4 + h) * 64 + lane) << 2)), w2 = *(const LAS f32x4*)(Wl + (((jj * 4 + h + 2) * 64 + lane) << 2));
                a0 += vv * w0; a2 += vv * w2; b0 += ww * w0; b2 += ww * w2; }
#pragma unroll
        for (int k = 0; k < 4; ++k) { ra[4 * h + k] = swap32_sum(a0[k], a2[k]); rb[4 * h + k] = swap32_sum(b0[k], b2[k]); }
    }
    router_finish(ra, i, lg, lane); router_finish(rb, i + 1, lg, lane);
}
__device__ __forceinline__ void ln1_router(LAS unsigned char* lds, const int l, const int nrows, const float* xin_lat, const float* xin_ctx, bf16_t* XB, const bf16_t* O,
        const float* mod, const float* g1, const float* b1, const float* router_w, const float* router_b, bf16_t* V, float* route, unsigned* list, unsigned* gcnt) {
    const int tid = otid(), lane = tid & 63, wid = __builtin_amdgcn_readfirstlane(tid >> 6);
    LAS float* Wl = (LAS float*)lds; LAS float* lg = (LAS float*)(lds + LG_OFF) + wid * (34 * 16);
    LAS unsigned* cnt = (LAS unsigned*)(lds + CNT_OFF); LAS unsigned* base = (LAS unsigned*)(lds + BASE_OFF);
    for (int i = tid; i < 1024 * 16; i += NTHREADS) { const int k = i >> 4, e = i & 15, ln = (k & 255) >> 2, jj = (k >> 8) * 4 + (k & 3);
        Wl[(((jj * 4 + (e >> 2)) * 64 + ln) << 2) + (e & 3)] = router_w[i]; }
    if (tid < 16) cnt[tid] = 0u;
    __syncthreads();
    const int rpw = nrows / 256, rpv = rpw / 8;
    const int row0 = blockIdx.x * rpw + wid * rpv, rl = row0 + rpv - 1;
    Ln1Par P; P.cur_bi = -1;
    Raw2 RA, RB, RC;
    ln1_ld(RA, l, row0, rl, xin_lat, xin_ctx, XB, O, lane); ln1_ld(RB, l, row0 + 1, rl, xin_lat, xin_ctx, XB, O, lane);
    Vec vp;
#define LN1_LD(R_, k_) ln1_ld(R_, l, row0 + i + (k_), rl, xin_lat, xin_ctx, XB, O, lane)
#define LN1_EVEN(R_, k_) vp = ln1_norm(R_, P, l, row0 + i + (k_), XB, mod, g1, b1, V, lane)
#define LN1_ODD(R_, k_) do { const Vec vq = ln1_norm(R_, P, l, row0 + i + (k_), XB, mod, g1, b1, V, lane); router2(vp, vq, i + (k_) - 1, Wl, lg, lane); } while (0)
    for (int i = 0; i < rpv; i += 6) {
        LN1_LD(RC, 2); LN1_EVEN(RA, 0);
        LN1_LD(RA, 3); LN1_ODD(RB, 1);
        if (i + 2 >= rpv) break;
        LN1_LD(RB, 4); LN1_EVEN(RC, 2);
        LN1_LD(RC, 5); LN1_ODD(RA, 3);
        if (i + 4 >= rpv) break;
        LN1_LD(RA, 6); LN1_EVEN(RB, 4);
        LN1_LD(RB, 7); LN1_ODD(RC, 5);
    }
#undef LN1_LD
#undef LN1_EVEN
#undef LN1_ODD
    LDS_WAIT();
    int e0 = 0, e1 = 0; float w0 = 0.f, w1 = 0.f; unsigned lp0 = 0, lp1 = 0;
    if (lane < rpv) {
        float sc[16], sel[16];
#pragma unroll
        for (int e = 0; e < 16; ++e) { sc[e] = 1.0f / (1.0f + __expf(-lg[lane * 16 + e])); sel[e] = sc[e] + router_b[e]; }
        float gs[4];
#pragma unroll
        for (int g = 0; g < 4; ++g) { const float s0 = sel[4 * g], s1 = sel[4 * g + 1], s2 = sel[4 * g + 2], s3 = sel[4 * g + 3];
            gs[g] = fmaxf(fmaxf(fmaxf(s0 + s1, s0 + s2), fmaxf(s0 + s3, s1 + s2)), fmaxf(s1 + s3, s2 + s3)); }
        int best = 0; float bv = gs[0];
#pragma unroll
        for (int g = 1; g < 4; ++g) if (gs[g] > bv) { bv = gs[g]; best = g; }
        float a4[4], c4[4];
#pragma unroll
        for (int k = 0; k < 4; ++k) { a4[k] = sel[k]; c4[k] = sc[k]; }
#pragma unroll
        for (int g = 1; g < 4; ++g) if (best == g) {
#pragma unroll
            for (int k = 0; k < 4; ++k) { a4[k] = sel[4 * g + k]; c4[k] = sc[4 * g + k]; } }
        int i0 = 0; float v0 = a4[0], s0 = c4[0];
#pragma unroll
        for (int k = 1; k < 4; ++k) if (a4[k] > v0) { v0 = a4[k]; i0 = k; s0 = c4[k]; }
        int i1 = -1; float v1 = 0.f, s1 = 0.f;
#pragma unroll
        for (int k = 0; k < 4; ++k) if (k != i0 && (i1 < 0 || a4[k] > v1)) { v1 = a4[k]; i1 = k; s1 = c4[k]; }
        e0 = best * 4 + i0; e1 = best * 4 + i1; const float inv = 1.0f / (s0 + s1); w0 = s0 * inv; w1 = s1 * inv;
        lp0 = atomicAdd((unsigned*)(cnt + e0), 1u); lp1 = atomicAdd((unsigned*)(cnt + e1), 1u);
    }
    __syncthreads();
    if (tid < 16) base[tid] = atomicAdd(gcnt + tid, cnt[tid]);
    __syncthreads();
    if (lane < rpv) { const int row = row0 + lane;
        ((u32x2*)list)[(size_t)e0 * NTOK + base[e0] + lp0] = (u32x2){(unsigned)row * 2u, __float_as_uint(w0)}; ((u32x2*)list)[(size_t)e1 * NTOK + base[e1] + lp1] = (u32x2){(unsigned)row * 2u + 1u, __float_as_uint(w1)};
        *(f32x4*)(route + (size_t)row * 4) = (f32x4){__int_as_float(e0), __int_as_float(e1), w0, w1}; }
    __syncthreads();
}

struct Raw3 { u32x2 x[4], f0[4], f1[4]; };
__device__ __forceinline__ void ld_raw3(Raw3& r, const bf16_t* XB, const bf16_t* F0, const bf16_t* F1, const int row, const int lane) {
    const size_t o = (size_t)row * 1024 + 4 * lane;
#pragma unroll
    for (int j = 0; j < 4; ++j) { r.x[j] = *(const u32x2*)(XB + o + 256 * j); r.f0[j] = *(const u32x2*)(F0 + o + 256 * j); r.f1[j] = *(const u32x2*)(F1 + o + 256 * j); } }
__device__ __forceinline__ f32x4 cvt4(const u32x2 w) { return (f32x4){bflo(w.x), bfhi(w.x), bflo(w.y), bfhi(w.y)}; }
struct Ln2Par { Vec gate, gg, bb, s1, s0; int cur_bi; };
__device__ __forceinline__ void ln2_row(const Raw3& R, Ln2Par& P, const int l, const int row, float* out_lat, bf16_t* XB, const float* mod, const float* g2, const float* b2, bf16_t* U, const int lane) {
    const bool lat = row < NLAT; const int bi = lat ? (row >> 12) : 16;
    if (bi != P.cur_bi) { P.cur_bi = bi; const float* mb = mod + ((size_t)(l * 17 + bi) * 6) * 1024;
        P.gate = ldv(mb + 5 * 1024, lane); P.gg = ldv(g2 + l * 1024, lane); P.bb = ldv(b2 + l * 1024, lane);
        if (l + 1 < DEPTH) { const float* mn = mod + ((size_t)((l + 1) * 17 + bi) * 6) * 1024; P.s0 = ldv(mn, lane); P.s1 = ldv(mn + 1024, lane);
#pragma unroll
            for (int j = 0; j < 4; ++j) P.s1.v[j] = P.s1.v[j] + 1.0f; }
        __builtin_amdgcn_s_waitcnt(0x0F70); }
    Vec y;
#pragma unroll
    for (int j = 0; j < 4; ++j) y.v[j] = cvt4(R.x[j]) * DN_ALPHA + P.gate.v[j] * (cvt4(R.f0[j]) + cvt4(R.f1[j]));
    normalize(y);
#pragma unroll
    for (int j = 0; j < 4; ++j) y.v[j] = y.v[j] * P.gg.v[j] + P.bb.v[j];
    if (l + 1 < DEPTH) stbf(XB + (size_t)row * 1024, lane, y); else stf(out_lat + (size_t)row * 1024, lane, y);
    if (l + 1 < DEPTH) { Vec u;
#pragma unroll
        for (int j = 0; j < 4; ++j) u.v[j] = y.v[j] * P.s1.v[j] + P.s0.v[j];
        stbf(U + (size_t)row * 1024, lane, u); }
}
__device__ __forceinline__ void ln2(const int l, const int nrows, float* out_lat, bf16_t* XB, const bf16_t* F0, const bf16_t* F1, const float* mod, const float* g2, const float* b2, bf16_t* U, const int gw, const int ngw) {
    const int lane = otid() & 63;
    const int per = (nrows + ngw - 1) / ngw;
    const int r0 = gw * per, rend = (r0 + per < nrows) ? r0 + per : nrows;
    Ln2Par P; P.cur_bi = -1;
    if (r0 >= rend) return;
    const int rl = rend - 1;
    Raw3 A, B, C;
    ld_raw3(A, XB, F0, F1, r0, lane);
    ld_raw3(B, XB, F0, F1, (r0 + 1 < rl) ? r0 + 1 : rl, lane);
    for (int row = r0; row < rend; row += 3) {
        ld_raw3(C, XB, F0, F1, (row + 2 < rl) ? row + 2 : rl, lane);
        ln2_row(A, P, l, row, out_lat, XB, mod, g2, b2, U, lane);
        if (row + 1 >= rend) break;
        ld_raw3(A, XB, F0, F1, (row + 3 < rl) ? row + 3 : rl, lane);
        ln2_row(B, P, l, row + 1, out_lat, XB, mod, g2, b2, U, lane);
        if (row + 2 >= rend) break;
        ld_raw3(B, XB, F0, F1, (row + 4 < rl) ? row + 4 : rl, lane);
        ln2_row(C, P, l, row + 2, out_lat, XB, mod, g2, b2, U, lane);
    }
}
}

namespace pro {
template <class Src>
__device__ __forceinline__ void tr_item(const Src& src, bf16_t* WT, const int K, const int n0, const int k0, LAS float* scr, const int lane) {
    float tv[32];
#pragma unroll
    for (int i = 0; i < 32; ++i) tv[i] = src(n0 + (lane & 31), k0 + 2 * i + (lane >> 5));
#pragma unroll
    for (int i = 0; i < 32; ++i) { const int kk = 2 * i + (lane >> 5); scr[kk * 33 + (lane & 31)] = tv[i]; }
    LDS_WAIT(); asm volatile("" ::: "memory");
    const int c = lane & 7;
#pragma unroll
    for (int j = 0; j < 4; ++j) { const int n = (lane >> 3) + 8 * j; const LAS float* s = scr + (8 * c) * 33 + n;
        u32x4 o; o.x = pk2(s[0 * 33], s[1 * 33]); o.y = pk2(s[2 * 33], s[3 * 33]); o.z = pk2(s[4 * 33], s[5 * 33]); o.w = pk2(s[6 * 33], s[7 * 33]);
        *(u32x4*)(WT + (size_t)(n0 + n) * K + k0 + 8 * c) = o; }
    LDS_WAIT(); asm volatile("" ::: "memory");
}
__device__ __forceinline__ int rotperm(int p) { return 16 * ((p >> 2) & 1) + 4 * (p >> 3) + (p & 3); }
struct SrcIn { const float* w; __device__ float operator()(int n, int k) const { if (n >= D_IN) return 0.f; const int g = n >> 5; const bool rt = (g >= 16 && g < 40) || g == 64;
    const int col = rt ? (g * 32 + rotperm(n & 31)) : n; return w[(size_t)k * D_IN + col]; } };
struct SrcOut { const float* w; __device__ float operator()(int n, int k) const { return w[(size_t)k * 1024 + n]; } };
struct Src13 { const float* w1; const float* w3; __device__ float operator()(int n, int k) const { const int g = n >> 5, p = n & 31, col = 16 * g + 4 * (p >> 3) + (p & 3);
    const float a = w1[(size_t)k * 256 + col], b = w3[(size_t)k * 256 + col]; return ((p >> 2) & 1) ? b : a; } };
struct Src2 { const float* w; __device__ float operator()(int n, int k) const { return w[(size_t)k * 1024 + n]; } };
struct SrcUQ { const float* w; const float* g; __device__ float operator()(int n, int k) const { if (n >= 576) return 0.f; const int gr = n >> 5, head = gr / 3, part = gr % 3;
    const int col = head * 96 + part * 32 + (part == 2 ? rotperm(n & 31) : (n & 31)); return g[k] * w[(size_t)k * 576 + col]; } };
struct SrcUKV { const float* w; const float* g; __device__ float operator()(int n, int k) const { return g[k] * w[(size_t)k * 768 + n]; } };
struct SrcG { const float* wa; const float* wi; __device__ float operator()(int n, int k) const { const int hb = n >> 8, o = n & 255, d = o >> 7, gt = (o >> 6) & 1, ch = o & 63;
    const size_t ix = (((size_t)d * 4 + hb) * 64 + k) * 64 + ch; const float a = wa[ix], b = wi[ix]; return gt ? b : a; } };
}


struct Args { const float* in[30]; float* out; unsigned char* ws; int ph_lo, ph_hi; };
constexpr int NPHASE = 2 + 9 * DEPTH;
typedef __attribute__((address_space(4))) const Args CArgs;
__device__ __forceinline__ CArgs* kargs() { CArgs* p = (CArgs*)__builtin_amdgcn_kernarg_segment_ptr(); asm volatile("" : "+s"(p)); return p; }
#define WSP(T, off) ((T*)(ws + (off)))
#ifndef PHMASK
#define PHMASK 0xFFFFFFFFu
#endif
#define PHON(j) ((PHMASK >> (j)) & 1u)

__global__ void __launch_bounds__(NTHREADS, 2) fwd_kernel(Args args_unused) {
    extern __shared__ __attribute__((aligned(16))) unsigned char lds_raw[];
    LAS unsigned char* lds = (LAS unsigned char*)lds_raw;
    const int tid = threadIdx.x;
    const int G = gridDim.x, bx = blockIdx.x; const int vcu = (G % 8 == 0) ? (bx % 8) * (G / 8) + bx / 8 : bx;
    static_assert(WIDTAB_OFF == MISC_OFF + 512 && WIDTAB_OFF + 256 <= LDS_BYTES, "wave-id table");
    for (int u = tid; u < (LDS_BYTES - MISC_OFF) / 4; u += NTHREADS) ((LAS unsigned*)(lds + MISC_OFF))[u] = 0u;
    __syncthreads();
    if ((tid & 63) == 0) { const unsigned hw = (unsigned)__builtin_amdgcn_s_getreg((5 << 11) | (0 << 6) | 4) & 63u; ((LAS int*)(lds + WIDTAB_OFF))[hw] = tid >> 6; }
    __syncthreads();
    int lo, hi;
    XcdBarrier bar;
    { CArgs* A = kargs(); lo = A->ph_lo; hi = A->ph_hi; unsigned* bw = (unsigned*)(A->ws + WS_CTL) + CW_BAR;
      bar.bar = bw; bar.x = 0; bar.st = nullptr;
      if (hi - lo > 1) bar = xcd_barrier_post(bw, (volatile LAS unsigned*)(lds + MISC_OFF) + 8); }
#define IN(k) (lo <= (k) && (k) < hi)
#define SEAM(k) do { if (IN(k) && IN((k) + 1)) xcd_barrier(bar); } while (0)

    if (PHON(0) && IN(0)) {
        CArgs* A = kargs(); unsigned char* ws = A->ws;
        const int lane = tid & 63, wave = __builtin_amdgcn_readfirstlane(tid >> 6); const int gw = vcu * NWAVES + wave, NGW = G * NWAVES;
        if (bx == G - 1) {
            float* ROT = WSP(float, WS_ROT); const float* diff_lambda = A->in[15];
            for (int i = tid; i < 512; i += NTHREADS) { const int pos = i >> 3, f = i & 7; const float inv = exp2f(-(float)f * (13.287712379549449f / 8.0f)); const float ang = (float)pos * inv;
                ROT[i] = __cosf(ang); ROT[512 + i] = __sinf(ang); }
            if (tid < DEPTH) { const float* lv = diff_lambda + tid * 128; float s01 = 0.f, s23 = 0.f; for (int k = 0; k < 32; ++k) { s01 += lv[k] * lv[32 + k]; s23 += lv[64 + k] * lv[96 + k]; }
                ROT[1024 + tid] = expf(s01) - expf(s23) + (0.8f - 0.6f * expf(-0.3f * (float)tid)); }
        }
        if (bx < 192) {
            const float* c_in = A->in[1]; const float* cctx_in = A->in[3]; const float* w_mod = A->in[4]; const float* b_mod = A->in[5]; float* MOD = WSP(float, WS_MOD);
            LAS float* S = (LAS float*)lds;
            LAS float* red = (LAS float*)(lds + 81920);
            for (int i = tid; i < 17 * 1024; i += NTHREADS) { const int bi = i >> 10, k = i & 1023; const float cv = (bi < 16) ? c_in[bi * 1024 + k] : cctx_in[k]; S[k * 20 + bi] = cv / (1.0f + __expf(-cv)); }
            __syncthreads();
            for (int item = bx; item < 192; item += G) {
                const int l = item / 48, n0 = (item % 48) * 128, kg = tid >> 7, cl = tid & 127;
                float acc[17];
#pragma unroll
                for (int b = 0; b < 17; ++b) acc[b] = 0.f;
                const float* wp = w_mod + ((size_t)l * 1024 + kg * 256) * 6144 + n0 + cl;
#pragma unroll 16
                for (int k = 0; k < 256; ++k) { const float w = wp[(size_t)k * 6144]; const LAS float* sp = S + (kg * 256 + k) * 20;
                    const f32x4 s0 = *(const LAS f32x4*)sp, s1 = *(const LAS f32x4*)(sp + 4), s2 = *(const LAS f32x4*)(sp + 8), s3 = *(const LAS f32x4*)(sp + 12); const float s4 = sp[16];
#pragma unroll
                    for (int b = 0; b < 4; ++b) { acc[b] += s0[b] * w; acc[4 + b] += s1[b] * w; acc[8 + b] += s2[b] * w; acc[12 + b] += s3[b] * w; }
                    acc[16] += s4 * w; }
#pragma unroll
                for (int b = 0; b < 17; ++b) red[(kg * 17 + b) * 128 + cl] = acc[b];
                __syncthreads();
                for (int i = tid; i < 17 * 128; i += NTHREADS) { const int b = i >> 7, c = i & 127; const float v = red[(0 * 17 + b) * 128 + c] + red[(1 * 17 + b) * 128 + c] + red[(2 * 17 + b) * 128 + c] + red[(3 * 17 + b) * 128 + c];
                    const int n = n0 + c, j = n >> 10, col = n & 1023; MOD[((size_t)(l * 17 + b) * 6 + j) * 1024 + col] = v + b_mod[l * 6144 + n]; }
                __syncthreads();
            }
        }
        __syncthreads();
        { LAS float* scr = (LAS float*)(lds + wave * 8448);
          constexpr int I_IN = 72 * 16, I_OUT = 32 * 16, I_13 = 16 * 16, I_2 = 32 * 4, I_UQ = 24 * 4, I_UKV = 24 * 2, I_G = 32;
          constexpr int T_IN = DEPTH * I_IN, T_OUT = DEPTH * I_OUT, T_13 = DEPTH * NEXP * I_13, T_2 = DEPTH * NEXP * I_2, T_UQ = DEPTH * I_UQ, T_UKV = DEPTH * I_UKV, T_G = DEPTH * I_G;
          constexpr int NITEMS = T_IN + T_OUT + T_13 + T_2 + T_UQ + T_UKV + T_G;
          for (int it = gw; it < NITEMS; it += NGW) {
              int r = it;
              if (r < T_IN) { const int l = r / I_IN, q = r % I_IN; pro::tr_item(pro::SrcIn{A->in[6] + (size_t)l * 1024 * D_IN}, WSP(bf16_t, WS_WIN) + (size_t)l * NIN_PAD * 1024, 1024, (q >> 4) * 32, (q & 15) * 64, scr, lane); continue; } r -= T_IN;
              if (r < T_OUT) { const int l = r / I_OUT, q = r % I_OUT; pro::tr_item(pro::SrcOut{A->in[7] + (size_t)l * 1024 * 1024}, WSP(bf16_t, WS_WOUT) + (size_t)l * 1024 * 1024, 1024, (q >> 4) * 32, (q & 15) * 64, scr, lane); continue; } r -= T_OUT;
              if (r < T_13) { const int le = r / I_13, q = r % I_13; pro::tr_item(pro::Src13{A->in[27] + (size_t)le * 1024 * 256, A->in[28] + (size_t)le * 1024 * 256}, WSP(bf16_t, WS_W13) + (size_t)le * 512 * 1024, 1024, (q >> 4) * 32, (q & 15) * 64, scr, lane); continue; } r -= T_13;
              if (r < T_2) { const int le = r / I_2, q = r % I_2; pro::tr_item(pro::Src2{A->in[29] + (size_t)le * 256 * 1024}, WSP(bf16_t, WS_W2) + (size_t)le * 1024 * 256, 256, (q >> 2) * 32, (q & 3) * 64, scr, lane); continue; } r -= T_2;
              if (r < T_UQ) { const int l = r / I_UQ, q = r % I_UQ; pro::tr_item(pro::SrcUQ{A->in[19] + (size_t)l * 256 * 576, A->in[17] + l * 256}, WSP(bf16_t, WS_WUQ) + (size_t)l * 768 * 256, 256, (q >> 2) * 32, (q & 3) * 64, scr, lane); continue; } r -= T_UQ;
              if (r < T_UKV) { const int l = r / I_UKV, q = r % I_UKV; pro::tr_item(pro::SrcUKV{A->in[20] + (size_t)l * 128 * 768, A->in[18] + l * 128}, WSP(bf16_t, WS_WUKV) + (size_t)l * 768 * 128, 128, (q >> 1) * 32, (q & 1) * 64, scr, lane); continue; } r -= T_UKV;
              { const int l = r / I_G, q = r % I_G; pro::tr_item(pro::SrcG{A->in[10] + (size_t)l * 2 * 4 * 64 * 64, A->in[12] + (size_t)l * 2 * 4 * 64 * 64}, WSP(bf16_t, WS_WG) + (size_t)l * 1024 * 64, 64, q * 32, 0, scr, lane); }
          } }
        __syncthreads();
    }
    SEAM(0);
    if (PHON(1) && IN(1)) {
        CArgs* A = kargs(); unsigned char* ws = A->ws; const float* x_in = A->in[0]; const float* ctx_in = A->in[2]; const float* MOD = WSP(float, WS_MOD); bf16_t* U = WSP(bf16_t, WS_U);
        const int lane = tid & 63, wave = __builtin_amdgcn_readfirstlane(tid >> 6); const int gw = vcu * NWAVES + wave, NGW = G * NWAVES;
        const int per = NTOK / NGW;
        int cur_bi = -1; lnp::Vec s0, s1;
        const int r0 = gw * per, rl = r0 + per - 1;
#define PB_LD(R, r_) do { const int rr_ = ((r_) < rl) ? (r_) : rl; R = lnp::ldv(rr_ < NLAT ? x_in + (size_t)rr_ * 1024 : ctx_in + (size_t)(rr_ - NLAT) * 1024, lane); } while (0)
#define PB_ROW(R, row_) do { const int row = (row_); const bool lat = row < NLAT; const int bi = lat ? (row >> 12) : 16; \
            if (bi != cur_bi) { cur_bi = bi; const float* mb = MOD + ((size_t)bi * 6) * 1024; s0 = lnp::ldv(mb, lane); s1 = lnp::ldv(mb + 1024, lane); \
                _Pragma("unroll") for (int j = 0; j < 4; ++j) s1.v[j] = s1.v[j] + 1.0f; \
                __builtin_amdgcn_s_waitcnt(0x0F70); } \
            lnp::Vec xv; _Pragma("unroll") for (int j = 0; j < 4; ++j) xv.v[j] = R.v[j] * s1.v[j] + s0.v[j]; \
            lnp::stbf(U + (size_t)row * 1024, lane, xv); } while (0)
        lnp::Vec RA, RB, RC; PB_LD(RA, r0); PB_LD(RB, r0 + 1);
        for (int i = 0; i < per; i += 3) {
            PB_LD(RC, r0 + i + 2); PB_ROW(RA, r0 + i);
            if (i + 1 >= per) break;
            PB_LD(RA, r0 + i + 3); PB_ROW(RB, r0 + i + 1);
            if (i + 2 >= per) break;
            PB_LD(RB, r0 + i + 4); PB_ROW(RC, r0 + i + 2);
        }
#undef PB_LD
#undef PB_ROW
    }
    SEAM(1);

    for (int l = 0; l < DEPTH; ++l) {
        const int pb = 2 + 9 * l;
        const bool need_ctx = l < DEPTH - 1;
        const int mrows = need_ctx ? NTOK : NLAT;
        if (PHON(2) && IN(pb)) {
            CArgs* A = kargs(); unsigned char* ws = A->ws;
            { const float* ROT = WSP(float, WS_ROT); for (int i = otid(); i < 1024; i += NTHREADS) ((LAS float*)(lds + ROT_OFF))[i] = ROT[i]; }
            __syncthreads();
            pg8::StaticOrder S; S.init(NTOK, NIN_PAD, G, bx);
            EpiInProj E{WSP(bf16_t, WS_XL), WSP(bf16_t, WS_GG), WSP(bf16_t, WS_QD), WSP(bf16_t, WS_KD), WSP(bf16_t, WS_VD), WSP(bf16_t, WS_CQ), WSP(bf16_t, WS_CKV), WSP(bf16_t, WS_KR),
                        WSP(float, WS_SSP), (const LAS float*)(lds + ROT_OFF), WSP(float, WS_KMX)};
            pg8::gemm_phase<EpiInProj, pg8::StaticOrder, false>(lds, WSP(bf16_t, WS_U), WSP(bf16_t, WS_WIN) + (size_t)l * NIN_PAD * 1024, 1024, S, E);
        }
        SEAM(pb);
        if (PHON(3) && IN(pb + 1)) {
            { CArgs* A = kargs(); unsigned char* ws = A->ws;
              { const float* ROT = WSP(float, WS_ROT); for (int i = otid(); i < 1024; i += NTHREADS) ((LAS float*)(lds + ROT_OFF))[i] = ROT[i]; }
              __syncthreads();
              pg8::StaticOrder S; S.init(NTOK, 768, G, bx); EpiExpQ E{WSP(bf16_t, WS_QM), WSP(float, WS_SSP), (const LAS float*)(lds + ROT_OFF)};
              pg8::gemm_phase<EpiExpQ, pg8::StaticOrder, false>(lds, WSP(bf16_t, WS_CQ), WSP(bf16_t, WS_WUQ) + (size_t)l * 768 * 256, 256, S, E); }
            __syncthreads(); asm volatile("" ::: "memory");
            { CArgs* A = kargs(); unsigned char* ws = A->ws;
              pg8::StaticOrder S; S.init(NTOK, 768, G, (bx + G / 2) % G); EpiExpKV E{
              WSP(bf16_t, WS_KN), WSP(bf16_t, WS_VM), WSP(float, WS_SSP), WSP(float, WS_KMN)};
              pg8::gemm_phase<EpiExpKV, pg8::StaticOrder, false>(lds, WSP(bf16_t, WS_CKV), WSP(bf16_t, WS_WUKV) + (size_t)l * 768 * 128, 128, S, E); }
            __syncthreads(); asm volatile("" ::: "memory");
            { CArgs* A = kargs(); unsigned char* ws = A->ws;
              lru::WaveCtx W; lru::load_ctx(W, l, WSP(bf16_t, WS_WG), A->in[8], A->in[9], A->in[11], A->in[13], A->in[14]);
              lru::run_chunks<false>(lds, W, vcu, G, NCHUNK, WSP(bf16_t, WS_XL), WSP(bf16_t, WS_GG), WSP(float, WS_LSUM), WSP(float, WS_LCAR), WSP(bf16_t, WS_MIX));
              __syncthreads(); }
        }
        SEAM(pb + 1);
        if (PHON(4) && IN(pb + 2)) { CArgs* A = kargs(); unsigned char* ws = A->ws; lru::carry(WSP(float, WS_LSUM), WSP(float, WS_LCAR)); }
        SEAM(pb + 2);
        if (PHON(5) && IN(pb + 3)) {
            { CArgs* A = kargs(); unsigned char* ws = A->ws;
              lru::WaveCtx W; lru::load_ctx(W, l, WSP(bf16_t, WS_WG), A->in[8], A->in[9], A->in[11], A->in[13], A->in[14]);
              const int nch = need_ctx ? NCHUNK : NCHUNK_LAT;
              lru::run_chunks<true>(lds, W, vcu, G, nch, WSP(bf16_t, WS_XL), WSP(bf16_t, WS_GG), WSP(float, WS_LSUM), WSP(float, WS_LCAR), WSP(bf16_t, WS_MIX));
              __syncthreads(); }
            asm volatile("" ::: "memory");
            for (int ph_ = 0; ph_ < 2; ++ph_) {
            const bool mla_now = ((ph_ ^ (vcu >> 5)) & 1) != 0;
            asm volatile("" ::: "memory");
            if (!mla_now)
            { CArgs* A = kargs(); unsigned char* ws = A->ws;
              const float lam_init = 0.8f - 0.6f * expf(-0.3f * (float)l);
              attd::Tens T{WSP(bf16_t, WS_QD), 384, 0, WSP(bf16_t, WS_KD), nullptr, WSP(bf16_t, WS_VD), 0, WSP(bf16_t, WS_MIX), 256, WSP(float, WS_ROT)[1024 + l], 1.0f - lam_init, A->in[16] + l * 64, WSP(float, WS_KMX)};
              for (int i = 0; i < 6; ++i) { const int uidx = vcu + 256 * i; if (uidx < 1536) { const int bh = uidx >> 4, qb = uidx & 15, b = bh / 6, h = bh % 6;
                  T.qcol = h * 64; T.kvcol = h * 64; T.ocol = 256 + h * 64; attd::attn_unit<0>(lds, T, b, false, qb); } }
              if (need_ctx && vcu < 96) { const int b = vcu / 6, h = vcu % 6; T.qcol = h * 64; T.kvcol = h * 64; T.ocol = 256 + h * 64; attd::attn_unit<0>(lds, T, b, true, 0); } }
            else
            { CArgs* A = kargs(); unsigned char* ws = A->ws;
              atts::Src S1{WSP(bf16_t, WS_QM), 576, 0, WSP(bf16_t, WS_KN), 0, WSP(bf16_t, WS_KR), WSP(bf16_t, WS_VM), 0, WSP(float, WS_KMN), WSP(float, WS_KMX)};
              for (int i = 0; i < 7; ++i) {
                  const bool cx = (i == 6); if (cx && !(need_ctx && vcu >= 96 && vcu < 192)) break;
                  const int uidx = vcu + 256 * i; const int bh = cx ? vcu - 96 : (uidx >> 4), qb = cx ? 0 : (uidx & 15), b = bh / 6, h = bh % 6;
                  f32x16 oa[2]; atts::Sm sa;
                  S1.qcol = h * 96; S1.kcol = h * 64; S1.vcol = h * 64;
                  atts::attn_pass<1>(lds, S1, b, cx, qb, oa, sa);
                  atts::attn_store<false>(lds, oa, sa, oa, sa, 0.f, 0.f, nullptr, WSP(bf16_t, WS_MIX), 640 + h * 64, b, cx, qb);
              } }
            }
        }
        SEAM(pb + 3);
        if (PHON(6) && IN(pb + 4)) {
            CArgs* A = kargs(); unsigned char* ws = A->ws;
            pg8::StaticOrder S; S.init(mrows, 1024, G, bx); EpiPlain E{WSP(bf16_t, WS_O), 1024};
            pg8::gemm_phase<EpiPlain, pg8::StaticOrder, false>(lds, WSP(bf16_t, WS_MIX), WSP(bf16_t, WS_WOUT) + (size_t)l * 1024 * 1024, 1024, S, E);
        }
        SEAM(pb + 4);
        if (PHON(7) && IN(pb + 5)) {
            CArgs* A = kargs(); unsigned char* ws = A->ws;
            lnp::ln1_router(lds, l, mrows, A->in[0], A->in[2], WSP(bf16_t, WS_XB), WSP(bf16_t, WS_O), WSP(float, WS_MOD), A->in[21], A->in[22], A->in[25], A->in[26],
                            WSP(bf16_t, WS_V), WSP(float, WS_ROUTE), WSP(unsigned, WS_LIST), WSP(unsigned, WS_CTL) + CW_CNT + 64 * l);
        }
        SEAM(pb + 5);
        if (PHON(8) && (IN(pb + 6) || IN(pb + 7))) {
            CArgs* A = kargs(); unsigned char* ws = A->ws;
            LAS int* tb = (LAS int*)(lds + MISC_OFF + 256);
            __syncthreads();
            if (otid() == 0) { gu32* gcnt = (gu32*)WSP(unsigned, WS_CTL) + CW_CNT + 64 * l; int off = 0, toff = 0;
                for (int e = 0; e < 16; ++e) { const int c = (int)__hip_atomic_load(gcnt + e, __ATOMIC_RELAXED, __HIP_MEMORY_SCOPE_AGENT); tb[e] = c; tb[16 + e] = off; tb[33 + e] = toff; off += c; toff += (c + 255) >> 8; }
                tb[32] = off; tb[49] = toff; }
            __syncthreads();
            if (IN(pb + 6)) {
                MoeSched S{tb, WSP(unsigned, WS_LIST), G, bx, 2}; EpiMoeUp E{WSP(bf16_t, WS_H)};
                pg8::gemm_phase<EpiMoeUp, MoeSched, true>(lds, WSP(bf16_t, WS_V), WSP(bf16_t, WS_W13) + (size_t)l * NEXP * 512 * 1024, 1024, S, E);
            }
        }
        SEAM(pb + 6);
        if (PHON(9) && IN(pb + 7)) {
            CArgs* A = kargs(); unsigned char* ws = A->ws;
            LAS int* tb = (LAS int*)(lds + MISC_OFF + 256);
            MoeSched S{tb, WSP(unsigned, WS_LIST), G, bx, 4}; EpiMoeDown E{WSP(bf16_t, WS_F0), WSP(bf16_t, WS_F1), WSP(unsigned, WS_LIST), WSP(float, WS_ROUTE)};
            pg8::gemm_phase<EpiMoeDown, MoeSched, false>(lds, WSP(bf16_t, WS_H), WSP(bf16_t, WS_W2) + (size_t)l * NEXP * 1024 * 256, 256, S, E);
        }
        SEAM(pb + 7);
        if (PHON(10) && IN(pb + 8)) {
            CArgs* A = kargs(); unsigned char* ws = A->ws; const int wave = __builtin_amdgcn_readfirstlane(otid() >> 6);
            lnp::ln2(l, mrows, A->out, WSP(bf16_t, WS_XB), WSP(bf16_t, WS_F0), WSP(bf16_t, WS_F1), WSP(float, WS_MOD), A->in[23], A->in[24], WSP(bf16_t, WS_U), vcu * NWAVES + wave, G * NWAVES);
        }
        SEAM(pb + 8);
    }
#undef IN
#undef SEAM
}

#ifndef MK_SPLIT
#define MK_SPLIT 0
#endif
extern "C" void kernel_launch(void* const* d_in, const int* in_sizes, int n_in, void* d_out, int out_size, void* d_ws, size_t ws_size, hipStream_t stream) {
    static int grid = 0;
    if (grid == 0) {
        if (n_in != 30 || out_size != NLAT * DM || ws_size < WS_END) { fprintf(stderr, "kernel_launch: unexpected problem (n_in %d out %d ws %zu)\n", n_in, out_size, ws_size); grid = -1; return; }
        int dev = 0, cus = 0;
        if (hipGetDevice(&dev) != hipSuccess || hipDeviceGetAttribute(&cus, hipDeviceAttributeMultiprocessorCount, dev) != hipSuccess) { grid = -1; return; }
        if (hipFuncSetAttribute((const void*)fwd_kernel, hipFuncAttributeMaxDynamicSharedMemorySize, LDS_BYTES) != hipSuccess) { fprintf(stderr, "kernel_launch: hipFuncSetAttribute failed\n"); grid = -1; return; }
        int per_cu = 0;
        if (hipOccupancyMaxActiveBlocksPerMultiprocessor(&per_cu, (const void*)fwd_kernel, NTHREADS, LDS_BYTES) != hipSuccess || per_cu < 1) fprintf(stderr, "kernel_launch: occupancy query says %d\n", per_cu);
        (void)hipGetLastError();
        grid = cus;
        if (grid != 256) { fprintf(stderr, "kernel_launch: built for 256 CUs, device has %d\n", cus); grid = -1; return; }
    }
    if (grid < 0) return;
    if (hipMemsetAsync((char*)d_ws + WS_CTL, 0, CTL_ZERO_BYTES, stream) != hipSuccess) return;
    Args a{};
    for (int i = 0; i < 30; ++i) a.in[i] = (const float*)d_in[i];
    a.out = (float*)d_out; a.ws = (unsigned char*)d_ws;
#if MK_SPLIT
    for (int p = 0; p < NPHASE; ++p) { a.ph_lo = p; a.ph_hi = p + 1; hipLaunchKernelGGL(fwd_kernel, dim3(grid), dim3(NTHREADS), LDS_BYTES, stream, a); }
#else
    a.ph_lo = 0; a.ph_hi = NPHASE; hipLaunchKernelGGL(fwd_kernel, dim3(grid), dim3(NTHREADS), LDS_BYTES, stream, a);
#endif
}
```
